# Optimizing an MI355X kernel written in HIP

```python
import jax, jax.numpy as jnp
from jax import lax
import numpy as np

D_MODEL = 2048
BATCH = 4
SEQ = 2048
DEPTH = 1
DEC_BATCH = 128
DEC_SEQ = 4
PAST_LEN = 16384
PAGE_SIZE = 128

MEM_LEN = 256
EPS = 1e-6
CONV_WIDTH = 3
D_CONV = D_MODEL // 2
D_GLA = D_MODEL - D_CONV
GLA_HEADS = 4
GLA_DV = D_GLA // GLA_HEADS
GLA_DK = GLA_DV // 2
GLA_RANK = 16
GLA_TAU = 16.0
GLA_CHUNK = 64
X_HEADS = 4
X_HD = D_MODEL // X_HEADS
D_FF = 5632
SIZES_IN = (D_CONV, D_CONV, D_CONV, GLA_HEADS * GLA_DK, GLA_HEADS * GLA_DK,
            GLA_HEADS * GLA_DV, GLA_HEADS * GLA_DV, GLA_RANK)
N_IN = sum(SIZES_IN)

kernel_name = "hymba_conv_gla_memxattn_convffn_step"


def rmsnorm(x, g):
    xf = x.astype(jnp.float32)
    y = xf * lax.rsqrt(jnp.mean(xf * xf, axis=-1, keepdims=True) + EPS)
    return (y * g.astype(jnp.float32)).astype(x.dtype)


def causal_conv(u, prev, w):
    t = u.shape[1]
    full = jnp.concatenate([prev.astype(u.dtype), u], axis=1)
    y = sum(w[i] * full[:, i:i + t] for i in range(CONV_WIDTH))
    return y, full[:, -(CONV_WIDTH - 1):]


def gla_chunked(q, k, v, logf, s0):
    b, t, h, _ = q.shape
    dv = v.shape[-1]
    c = min(GLA_CHUNK, t)
    pad = (-t) % c
    n = (t + pad) // c

    def blocks(a):
        a = jnp.pad(a.astype(jnp.float32), ((0, 0), (0, pad), (0, 0), (0, 0)))
        return a.reshape(b, n, c, h, a.shape[-1]).transpose(1, 0, 3, 2, 4)

    qb, kb, vb, gb = blocks(q), blocks(k), blocks(v), blocks(logf)
    mask = jnp.tril(jnp.ones((c, c), bool))

    def step(s, inp):
        qc, kc, vc, gc = inp
        cum = jnp.cumsum(gc, axis=2)
        diff = cum[:, :, :, None, :] - cum[:, :, None, :, :]
        decay = jnp.exp(jnp.where(mask[:, :, None], diff, -jnp.inf))
        a = jnp.einsum('bhid,bhjd,bhijd->bhij', qc, kc, decay)
        o = (jnp.einsum('bhij,bhjv->bhiv', a, vc)
             + jnp.einsum('bhid,bhdv->bhiv', qc * jnp.exp(cum), s))
        last = cum[:, :, -1:, :]
        s = (jnp.exp(last[:, :, 0, :])[..., None] * s
             + jnp.einsum('bhjd,bhjv->bhdv', kc * jnp.exp(last - cum), vc))
        return s, o

    s, o = lax.scan(step, s0.astype(jnp.float32), (qb, kb, vb, gb))
    o = o.transpose(1, 0, 3, 2, 4).reshape(b, n * c, h, dv)[:, :t]
    return o, s


def mixer(xn, conv_prev, s0, w_in, conv_w, w_gate2, b_gate, gla_norm, w_out):
    b, t, _ = xn.shape
    proj = xn @ w_in
    offs = [0]
    for sz in SIZES_IN:
        offs.append(offs[-1] + sz)
    bg, cg, vc, q, k, v, r, g1 = [proj[..., offs[i]:offs[i + 1]] for i in range(len(SIZES_IN))]
    yc, conv_new = causal_conv(cg * vc, conv_prev, conv_w)
    conv_out = bg * yc
    q = q.reshape(b, t, GLA_HEADS, GLA_DK) * (GLA_DK ** -0.5)
    k = k.reshape(b, t, GLA_HEADS, GLA_DK)
    v = v.reshape(b, t, GLA_HEADS, GLA_DV)
    z = (g1 @ w_gate2 + b_gate).astype(jnp.float32)
    logf = (jax.nn.log_sigmoid(z) / GLA_TAU).reshape(b, t, GLA_HEADS, GLA_DK)
    o, s_new = gla_chunked(q, k, v, logf, s0)
    o = rmsnorm(o.astype(xn.dtype), gla_norm.reshape(GLA_HEADS, GLA_DV)).reshape(b, t, D_GLA)
    o = o * jax.nn.silu(r)
    out = jnp.concatenate([conv_out, o], axis=-1) @ w_out
    return out, conv_new, s_new.astype(s0.dtype)


def cross_attn(hn, mk, mv, w_q, w_o):
    b, t, _ = hn.shape
    q = (hn @ w_q).reshape(b, t, X_HEADS, X_HD)
    s = jnp.einsum('bthd,bmhd->bhtm', q, mk).astype(jnp.float32) * (X_HD ** -0.5)
    p = jax.nn.softmax(s, axis=-1).astype(mv.dtype)
    o = jnp.einsum('bhtm,bmhd->bthd', p, mv).reshape(b, t, D_MODEL)
    return o @ w_o


def conv_ffn(hn, prev, w_g, w_u, c_w, c_b, w_d):
    gc, new_prev = causal_conv(hn @ w_g, prev, c_w)
    return (jax.nn.silu(gc + c_b) * (hn @ w_u)) @ w_d, new_prev


def layer(x, conv_prev, s0, ffn_prev, mk, mv, nm, w_in, conv_w, w_gate2, b_gate, gla_norm,
          w_out, nx, w_xq, w_xo, nf, w_fg, w_fu, fc_w, fc_b, w_fd):
    m, conv_new, s_new = mixer(rmsnorm(x, nm), conv_prev, s0, w_in, conv_w, w_gate2, b_gate,
                               gla_norm, w_out)
    h = x + m
    h = h + cross_attn(rmsnorm(h, nx), mk, mv, w_xq, w_xo)
    f, ffn_new = conv_ffn(rmsnorm(h, nf), ffn_prev, w_fg, w_fu, fc_w, fc_b, w_fd)
    return h + f, conv_new, s_new, ffn_new


def setup_inputs(seed: int = 0) -> dict:
    key = jax.random.key(seed)
    ks = iter(jax.random.split(key, 40))

    def nrm(shape, scale):
        return jax.random.normal(next(ks), shape, jnp.float32) * scale

    def gain(shape):
        return 1.0 + nrm(shape, 0.02)

    L = DEPTH
    return {
        "x_prompt": nrm((BATCH, SEQ, D_MODEL), 1.0),
        "x_sample": nrm((DEC_BATCH, DEC_SEQ, D_MODEL), 1.0),
        "mem_prompt": nrm((BATCH, MEM_LEN, D_MODEL), 1.0),
        "cache_conv": nrm((L, DEC_BATCH, CONV_WIDTH - 1, D_CONV), 0.5),
        "state_gla": nrm((L, DEC_BATCH, GLA_HEADS, GLA_DK, GLA_DV), 0.3),
        "cache_ffn": nrm((L, DEC_BATCH, CONV_WIDTH - 1, D_FF), 1.0),
        "cache_mem_k": nrm((L, DEC_BATCH, MEM_LEN, X_HEADS, X_HD), 1.0),
        "cache_mem_v": nrm((L, DEC_BATCH, MEM_LEN, X_HEADS, X_HD), 1.0),
        "norm_mix": gain((L, D_MODEL)),
        "w_in": nrm((L, D_MODEL, N_IN), D_MODEL ** -0.5),
        "conv_w": nrm((L, CONV_WIDTH, D_CONV), CONV_WIDTH ** -0.5),
        "w_gate2": nrm((L, GLA_RANK, GLA_HEADS * GLA_DK), GLA_RANK ** -0.5),
        "b_gate": nrm((L, GLA_HEADS * GLA_DK), 0.1),
        "gla_norm": gain((L, D_GLA)),
        "w_out": nrm((L, D_MODEL, D_MODEL), D_MODEL ** -0.5),
        "norm_x": gain((L, D_MODEL)),
        "norm_mem": gain((L, D_MODEL)),
        "w_xq": nrm((L, D_MODEL, D_MODEL), D_MODEL ** -0.5),
        "w_xk": nrm((L, D_MODEL, D_MODEL), D_MODEL ** -0.5),
        "w_xv": nrm((L, D_MODEL, D_MODEL), D_MODEL ** -0.5),
        "w_xo": nrm((L, D_MODEL, D_MODEL), D_MODEL ** -0.5),
        "norm_ffn": gain((L, D_MODEL)),
        "w_ffn_gate": nrm((L, D_MODEL, D_FF), D_MODEL ** -0.5),
        "w_ffn_up": nrm((L, D_MODEL, D_FF), D_MODEL ** -0.5),
        "ffn_conv_w": nrm((L, CONV_WIDTH, D_FF), CONV_WIDTH ** -0.5),
        "ffn_conv_b": nrm((L, D_FF), 0.02),
        "w_ffn_down": nrm((L, D_FF, D_MODEL), D_FF ** -0.5),
        "norm_final": gain((D_MODEL,)),
    }


def reference(x_prompt, x_sample, mem_prompt, cache_conv, state_gla, cache_ffn, cache_mem_k,
              cache_mem_v, norm_mix, w_in, conv_w, w_gate2, b_gate, gla_norm, w_out, norm_x,
              norm_mem, w_xq, w_xk, w_xv, w_xo, norm_ffn, w_ffn_gate, w_ffn_up, ffn_conv_w,
              ffn_conv_b, w_ffn_down, norm_final):
    hp, hs = x_prompt, x_sample
    conv_p, gla_p, ffn_p, mk_p, mv_p = [], [], [], [], []
    conv_s, gla_s, ffn_s = [], [], []
    for l in range(DEPTH):
        shared = (norm_mix[l], w_in[l], conv_w[l], w_gate2[l], b_gate[l], gla_norm[l], w_out[l],
                  norm_x[l], w_xq[l], w_xo[l], norm_ffn[l], w_ffn_gate[l], w_ffn_up[l],
                  ffn_conv_w[l], ffn_conv_b[l], w_ffn_down[l])
        memn = rmsnorm(mem_prompt, norm_mem[l])
        mk = (memn @ w_xk[l]).reshape(BATCH, MEM_LEN, X_HEADS, X_HD)
        mv = (memn @ w_xv[l]).reshape(BATCH, MEM_LEN, X_HEADS, X_HD)
        z_conv = jnp.zeros((BATCH, CONV_WIDTH - 1, D_CONV), hp.dtype)
        z_gla = jnp.zeros((BATCH, GLA_HEADS, GLA_DK, GLA_DV), hp.dtype)
        z_ffn = jnp.zeros((BATCH, CONV_WIDTH - 1, D_FF), hp.dtype)
        hp, c1, s1, f1 = layer(hp, z_conv, z_gla, z_ffn, mk, mv, *shared)
        conv_p.append(c1); gla_p.append(s1); ffn_p.append(f1); mk_p.append(mk); mv_p.append(mv)
        hs, c2, s2, f2 = layer(hs, cache_conv[l], state_gla[l], cache_ffn[l], cache_mem_k[l],
                               cache_mem_v[l], *shared)
        conv_s.append(c2); gla_s.append(s2); ffn_s.append(f2)
    y_prompt = rmsnorm(hp, norm_final)
    y_sample = rmsnorm(hs, norm_final)
    return (y_prompt, y_sample, jnp.stack(conv_p), jnp.stack(gla_p), jnp.stack(ffn_p),
            jnp.stack(mk_p), jnp.stack(mv_p), jnp.stack(conv_s), jnp.stack(gla_s),
            jnp.stack(ffn_s))
```

```cpp
#include <hip/hip_runtime.h>
#include <hip/hip_cooperative_groups.h>
#include <cstdio>
namespace cg = cooperative_groups;

namespace pg8 {
#define PG8_LAS __attribute__((address_space(3)))
typedef unsigned short bf16_t;
typedef short bf16x8 __attribute__((ext_vector_type(8)));
typedef float f32x4 __attribute__((ext_vector_type(4)));
typedef unsigned u32x4 __attribute__((ext_vector_type(4)));
constexpr int BM = 256, BK = 64, HALF = 128, HTB = HALF * BK * 2  , STAGE_BYTES = 8 * HTB, NXCD = 8, WGM = 8;

__host__ __device__ __forceinline__ int lds_byte(int r, int c) { const int st = (r >> 4) * 2 + (c >> 5), rr = r & 15, cc = c & 31, ob = rr * 64 + cc * 2; return st * 1024 + (ob ^ (((ob >> 9) & 1) << 5)); }
__host__ __device__ __forceinline__ void stage_rc(int b, int& R, int& C) { const int st = b / 1024, sb = b % 1024, swz = sb ^ (((sb >> 9) & 1) << 5); R = (st >> 1) * 16 + swz / 64; C = (st & 1) * 32 + (swz % 64) / 2; }
__host__ __device__ __forceinline__ int perm32(int rho) { const int n = rho >> 4, i = rho & 15; return 8 * (i >> 2) + 4 * n + (i & 3); }

struct Unit { int pm, pn; };
struct Gemm { const bf16_t* A; const bf16_t* Bt; int M, N, K; };

struct StaticOrder {
    int nM, nN, nwg, G, c;
    __host__ __device__ void init(int M, int N, int G_, int c_) { nM = M / BM; nN = N / BM; nwg = nM * nN; G = G_; c = c_; }
    __host__ __device__ bool next(int i, Unit& u) const {
        const long L = (long)i * G + c; if (L >= nwg) return false;
        int wgid = (int)L; { const int q = nwg / NXCD, r = nwg % NXCD, xcd = wgid % NXCD, off = wgid / NXCD; wgid = (xcd < r ? xcd * (q + 1) : r * (q + 1) + (xcd - r) * q) + off; }
        const int nig = WGM * nN, gid = wgid / nig, fm = gid * WGM, gsz = (nM - fm) < WGM ? (nM - fm) : WGM;
        u.pm = fm + ((wgid % nig) % gsz); u.pn = (wgid % nig) / gsz; return true;
    }
    __device__ __forceinline__ void a_ready(const Unit&) const {}
    __device__ __forceinline__ void done(const Unit&) const {}
};
typedef unsigned u32x2 __attribute__((ext_vector_type(2)));
__device__ __forceinline__ unsigned cvt_pk_bf16(float lo, float hi) { unsigned r; asm volatile("v_cvt_pk_bf16_f32 %0, %1, %2" : "=v"(r) : "v"(lo), "v"(hi)); return r; }
__device__ __forceinline__ u32x4 pack8(const f32x4 v0, const f32x4 v1) { u32x4 w; w.x = cvt_pk_bf16(v0[0], v0[1]); w.y = cvt_pk_bf16(v0[2], v0[3]); w.z = cvt_pk_bf16(v1[0], v1[1]); w.w = cvt_pk_bf16(v1[2], v1[3]); return w; }

struct EpiProj {
    static constexpr bool PERM = true, AFTER_DRAIN = false;
    bf16_t* O; int ldc;
    __device__ __forceinline__ void operator()(const f32x4 (&acc)[2][2][4][2], const Unit& u, int wr, int wc, int fr, int fq) const {
        const int row0 = u.pm * BM + wr * 64 + fr, col0 = u.pn * BM + wc * 32 + 8 * fq;
#pragma unroll
        for (int ai = 0; ai < 2; ++ai)
#pragma unroll
            for (int m = 0; m < 4; ++m) { bf16_t* rowp = O + (size_t)(row0 + ai * HALF + m * 16) * ldc + col0;
#pragma unroll
                for (int bj = 0; bj < 2; ++bj) *(u32x4*)(rowp + bj * HALF) = pack8(acc[ai][bj][m][0], acc[ai][bj][m][1]); }
    }
};

struct EpiKV {
    static constexpr bool PERM = false, AFTER_DRAIN = false;
    float* outk; float* outv; bf16_t* mkb; bf16_t* mvt;
    __device__ __forceinline__ void operator()(const f32x4 (&acc)[2][2][4][2], const Unit& u, int wr, int wc, int fr, int fq) const {
        const int row0 = u.pm * BM + wr * 64 + fr, col0 = (u.pn & 7) * BM + wc * 32 + 4 * fq;
        const bool isv = u.pn >= 8;
#pragma unroll
        for (int ai = 0; ai < 2; ++ai)
#pragma unroll
            for (int m = 0; m < 4; ++m) { const int r = row0 + ai * HALF + m * 16;
                const int bb = r >> 8, key = r & 255, pos = (key & ~31) + 8 * ((key >> 2) & 3) + 4 * ((key >> 4) & 1) + (key & 3);
#pragma unroll
                for (int bj = 0; bj < 2; ++bj)
#pragma unroll
                    for (int n = 0; n < 2; ++n) { const int c = col0 + bj * HALF + n * 16; const f32x4 v = acc[ai][bj][m][n];
                        if (!isv) { *(f32x4*)(outk + (size_t)r * 2048 + c) = v; u32x2 w; w.x = cvt_pk_bf16(v[0], v[1]); w.y = cvt_pk_bf16(v[2], v[3]); *(u32x2*)(mkb + (size_t)r * 2048 + c) = w; }
                        else { *(f32x4*)(outv + (size_t)r * 2048 + c) = v; const unsigned w0 = cvt_pk_bf16(v[0], v[1]), w1 = cvt_pk_bf16(v[2], v[3]);
                            bf16_t* tp = mvt + ((size_t)(bb * 2048 + c)) * 256 + pos;
                            tp[0] = (bf16_t)(w0 & 0xffffu); tp[256] = (bf16_t)(w0 >> 16); tp[512] = (bf16_t)(w1 & 0xffffu); tp[768] = (bf16_t)(w1 >> 16); } } }
    }
};

template <bool HG> struct EpiRes {
    static constexpr bool PERM = true, AFTER_DRAIN = false;
    const float* res0; const float* res1; int split; float* hout; bf16_t* hg; const float* gain; float* ssq;
    __device__ __forceinline__ void operator()(const f32x4 (&acc)[2][2][4][2], const Unit& u, int wr, int wc, int fr, int fq) const {
        const int row0 = u.pm * BM + wr * 64 + fr, col0 = u.pn * BM + wc * 32 + 8 * fq;
        f32x4 g[2][2];
        if (HG) {
#pragma unroll
            for (int bj = 0; bj < 2; ++bj) { g[bj][0] = *(const f32x4*)(gain + col0 + bj * HALF); g[bj][1] = *(const f32x4*)(gain + col0 + bj * HALF + 4); } }
#pragma unroll
        for (int ai = 0; ai < 2; ++ai)
#pragma unroll
            for (int m = 0; m < 4; ++m) { const int r = row0 + ai * HALF + m * 16;
                const float* rp = (r < split ? res0 + (size_t)r * 2048 : res1 + (size_t)(r - split) * 2048) + col0;
                float* hp = hout + (size_t)r * 2048 + col0; float ss = 0.f;
#pragma unroll
                for (int bj = 0; bj < 2; ++bj) {
                    const f32x4 h0 = *(const f32x4*)(rp + bj * HALF) + acc[ai][bj][m][0], h1 = *(const f32x4*)(rp + bj * HALF + 4) + acc[ai][bj][m][1];
                    *(f32x4*)(hp + bj * HALF) = h0; *(f32x4*)(hp + bj * HALF + 4) = h1;
                    ss += (h0[0] * h0[0] + h0[1] * h0[1]) + (h0[2] * h0[2] + h0[3] * h0[3]) + (h1[0] * h1[0] + h1[1] * h1[1]) + (h1[2] * h1[2] + h1[3] * h1[3]);
                    if (HG) *(u32x4*)(hg + (size_t)r * 2048 + col0 + bj * HALF) = pack8(h0 * g[bj][0], h1 * g[bj][1]); }
                ss += __shfl_xor(ss, 16); ss += __shfl_xor(ss, 32);
                if (fq == 0) ssq[(size_t)r * 32 + u.pn * 4 + wc] = ss; }
    }
};

template <bool FFN> struct EpiScale {
    static constexpr bool PERM = true, AFTER_DRAIN = false;
    bf16_t* O; int ldc; const float* ssq; float scale; float* ffn_p; float* ffn_s;
    __device__ __forceinline__ void operator()(const f32x4 (&acc)[2][2][4][2], const Unit& u, int wr, int wc, int fr, int fq) const {
        const int row0 = u.pm * BM + wr * 64 + fr, col0 = u.pn * BM + wc * 32 + 8 * fq;
#pragma unroll
        for (int ai = 0; ai < 2; ++ai)
#pragma unroll
            for (int m = 0; m < 4; ++m) { const int r = row0 + ai * HALF + m * 16;
                const f32x4* sp = (const f32x4*)(ssq + (size_t)r * 32); float s = 0.f;
#pragma unroll
                for (int i = 0; i < 8; ++i) { const f32x4 v = sp[i]; s += (v[0] + v[1]) + (v[2] + v[3]); }
                const float rs = rsqrtf(s * (1.0f / 2048.0f) + 1e-6f) * scale;
                bf16_t* rowp = O + (size_t)r * ldc + col0;
                float* dst = nullptr;
                if (FFN && u.pn < 22) {
                    if (r < 8192) { const int t = r & 2047; if (t >= 2046) dst = ffn_p + (size_t)((r >> 11) * 2 + (t - 2046)) * 5632; }
                    else { const int rr = r - 8192, t = rr & 3; if (t >= 2) dst = ffn_s + (size_t)((rr >> 2) * 2 + (t - 2)) * 5632; } }
#pragma unroll
                for (int bj = 0; bj < 2; ++bj) { const f32x4 v0 = acc[ai][bj][m][0] * rs, v1 = acc[ai][bj][m][1] * rs;
                    *(u32x4*)(rowp + bj * HALF) = pack8(v0, v1);
                    if (FFN) { if (dst) { *(f32x4*)(dst + col0 + bj * HALF) = v0; *(f32x4*)(dst + col0 + bj * HALF + 4) = v1; } } } }
    }
};

template <class Epi, class Sched, bool STAMP = false>
__device__ __forceinline__ void gemm_phase(PG8_LAS unsigned char* lds, const Gemm g, const Sched& S, const Epi& E, unsigned long long* stamps) {
    const int tid = threadIdx.x, wid = __builtin_amdgcn_readfirstlane(tid >> 6), lane = tid & 63, wr = wid >> 2, wc = wid & 3, fr = lane & 15, fq = lane >> 4;
    const int K = g.K, nt = K / BK;
    int ts_lo = 0, ts_hi = 0, nts = 0; const unsigned long long rt_entry = STAMP ? (unsigned long long)wall_clock64() : 0ull;
#define PG8_STAMP() do { if (STAMP && wid == 0 && nts < 64) { const unsigned long long _c = (unsigned long long)clock64(); \
        ts_lo = (lane == nts) ? (int)(unsigned)_c : ts_lo; ts_hi = (lane == nts) ? (int)(unsigned)(_c >> 32) : ts_hi; ++nts; } } while (0)
    PG8_STAMP();
    unsigned voffA[2], voffB[2];
#pragma unroll
    for (int i = 0; i < 2; ++i) { int R, C; stage_rc(tid * 16 + i * 8192, R, C); const int Rb = Epi::PERM ? ((R & ~31) + perm32(R & 31)) : R;
        voffA[i] = (unsigned)(R * K + C) * 2u; voffB[i] = (unsigned)(Rb * K + C) * 2u; }
    const size_t kstep = (size_t)(BK * 2);
    const size_t hstep = (size_t)HALF * K * 2;
    const size_t tstep = 2 * hstep;
    const unsigned ldsw = (unsigned)wid * 1024u;
    const int aoff = lds_byte(wr * 64 + fr, fq * 8), boff = lds_byte(wc * 32 + fr, fq * 8);
#define PG8_SA(b, h) (((b) * 2 + (h)) * HTB)
#define PG8_SB(b, h) ((4 + (b) * 2 + (h)) * HTB)
#define PG8_STAGE(bufoff, gbase, voff) do { _Pragma("unroll") for (int _i = 0; _i < 2; ++_i) \
        __builtin_amdgcn_global_load_lds((const unsigned*)((const char*)(gbase) + (voff)[_i]), (PG8_LAS unsigned*)(lds + (bufoff) + ldsw + _i * 8192), 16, 0, 0); } while (0)
#define PG8_LDA(dst, b, h) do { _Pragma("unroll") for (int m = 0; m < 4; ++m) _Pragma("unroll") for (int k = 0; k < 2; ++k) dst[m][k] = *(const PG8_LAS bf16x8*)(lds + PG8_SA(b, h) + aoff + m * 2048 + k * 1024); } while (0)
#define PG8_LDB(dst, b, h) do { _Pragma("unroll") for (int n = 0; n < 2; ++n) _Pragma("unroll") for (int k = 0; k < 2; ++k) dst[n][k] = *(const PG8_LAS bf16x8*)(lds + PG8_SB(b, h) + boff + n * 2048 + k * 1024); } while (0)
#define PG8_MMA(ai, bj, At, Bt) do { __builtin_amdgcn_s_setprio(1); _Pragma("unroll") for (int m = 0; m < 4; ++m) _Pragma("unroll") for (int n = 0; n < 2; ++n) _Pragma("unroll") for (int k = 0; k < 2; ++k) \
        acc[ai][bj][m][n] = __builtin_amdgcn_mfma_f32_16x16x32_bf16(Bt[n][k], At[m][k], acc[ai][bj][m][n], 0, 0, 0); __builtin_amdgcn_s_setprio(0); } while (0)
#define PG8_WAIT_V(n) asm volatile("s_waitcnt vmcnt(" #n ")" ::: "memory")
#define PG8_WAIT_L(n) asm volatile("s_waitcnt lgkmcnt(" #n ")" ::: "memory")
#define PG8_BAR __builtin_amdgcn_s_barrier()
#define PG8_SCHED __builtin_amdgcn_sched_barrier(0)
    Unit cur, nxt; int ui = 0;
    if (!S.next(0, cur)) return;
    f32x4 acc[2][2][4][2];
#pragma unroll
    for (int a = 0; a < 2; ++a)
#pragma unroll
        for (int b = 0; b < 2; ++b)
#pragma unroll
            for (int m = 0; m < 4; ++m)
#pragma unroll
                for (int n = 0; n < 2; ++n) acc[a][b][m][n] = (f32x4){0.f, 0.f, 0.f, 0.f};
    bf16x8 At[4][2], B0[2][2], B1[2][2];
    const char* cA = (const char*)g.A + (size_t)cur.pm * tstep; const char* cB = (const char*)g.Bt + (size_t)cur.pn * tstep;
    S.a_ready(cur);
    PG8_STAGE(PG8_SB(0, 0), cB, voffB); PG8_STAGE(PG8_SA(0, 0), cA, voffA); PG8_STAGE(PG8_SB(0, 1), cB + hstep, voffB); PG8_STAGE(PG8_SA(0, 1), cA + hstep, voffA);
    if (wr == 1) PG8_BAR;
    PG8_WAIT_V(4); PG8_BAR;
    PG8_STAGE(PG8_SB(1, 0), cB + kstep, voffB); PG8_STAGE(PG8_SA(1, 0), cA + kstep, voffA); PG8_STAGE(PG8_SB(1, 1), cB + hstep + kstep, voffB);
    PG8_WAIT_V(6); PG8_BAR;
    PG8_STAMP();
    for (;;) {
        const bool has_next = S.next(ui + 1, nxt);
        const char* nA = has_next ? (const char*)g.A + (size_t)nxt.pm * tstep : cA; const char* nB = has_next ? (const char*)g.Bt + (size_t)nxt.pn * tstep : cB;
        for (int t = 0; t < nt; t += 2) {
            const bool last = (t == nt - 2);
            const char* a1 = cA + (size_t)(t + 1) * kstep;
            const char* a2 = last ? nA : cA + (size_t)(t + 2) * kstep; const char* b2 = last ? nB : cB + (size_t)(t + 2) * kstep;
            const char* a3 = a2 + kstep; const char* b3 = b2 + kstep;
            if (last && has_next) S.a_ready(nxt);
            PG8_LDB(B0, 0, 0); PG8_SCHED; PG8_LDA(At, 0, 0); PG8_STAGE(PG8_SA(1, 1), a1 + hstep, voffA);
            PG8_WAIT_L(8); PG8_BAR; PG8_WAIT_L(0); PG8_MMA(0, 0, At, B0); PG8_BAR; PG8_SCHED;
            PG8_LDB(B1, 0, 1); PG8_STAGE(PG8_SB(0, 0), b2, voffB);
            PG8_BAR; PG8_WAIT_L(0); PG8_MMA(0, 1, At, B1); PG8_BAR;
            PG8_LDA(At, 0, 1); PG8_STAGE(PG8_SA(0, 0), a2, voffA);
            PG8_BAR; PG8_WAIT_L(0); PG8_MMA(1, 0, At, B0); PG8_BAR; PG8_SCHED;
            PG8_STAGE(PG8_SB(0, 1), b2 + hstep, voffB);
            PG8_WAIT_V(6); PG8_BAR; PG8_MMA(1, 1, At, B1); PG8_BAR;
            PG8_LDB(B0, 1, 0); PG8_SCHED; PG8_LDA(At, 1, 0); PG8_STAGE(PG8_SA(0, 1), a2 + hstep, voffA);
            PG8_WAIT_L(8); PG8_BAR; PG8_WAIT_L(0); PG8_MMA(0, 0, At, B0); PG8_BAR; PG8_SCHED;
            PG8_LDB(B1, 1, 1); PG8_STAGE(PG8_SB(1, 0), b3, voffB);
            PG8_BAR; PG8_WAIT_L(0); PG8_MMA(0, 1, At, B1); PG8_BAR;
            PG8_LDA(At, 1, 1); PG8_STAGE(PG8_SA(1, 0), a3, voffA);
            PG8_BAR; PG8_WAIT_L(0); PG8_MMA(1, 0, At, B0); PG8_BAR; PG8_SCHED;
            PG8_STAGE(PG8_SB(1, 1), b3 + hstep, voffB);
            PG8_WAIT_V(6); PG8_BAR; PG8_MMA(1, 1, At, B1); PG8_BAR;
        }
        PG8_STAMP();
        if constexpr (!Epi::AFTER_DRAIN) { E(acc, cur, wr, wc, fr, fq); S.done(cur); }
        PG8_STAMP();
        if (!has_next) break;
#pragma unroll
        for (int a = 0; a < 2; ++a)
#pragma unroll
            for (int b = 0; b < 2; ++b)
#pragma unroll
                for (int m = 0; m < 4; ++m)
#pragma unroll
                    for (int n = 0; n < 2; ++n) acc[a][b][m][n] = (f32x4){0.f, 0.f, 0.f, 0.f};
        cur = nxt; cA = nA; cB = nB; ++ui;
    }
    PG8_WAIT_V(0);
    if (wr == 0) PG8_BAR;
    PG8_BAR;
    if constexpr (Epi::AFTER_DRAIN) { E.fused(acc, cur, wr, wc, fr, fq, lds, wid, lane); S.done(cur); }
    PG8_STAMP();
    if (STAMP && wid == 0) { stamps[lane] = lane < nts ? (((unsigned long long)(unsigned)ts_hi << 32) | (unsigned)ts_lo) : 0ull;
        if (lane == 62) stamps[62] = rt_entry; if (lane == 63) stamps[63] = (unsigned long long)wall_clock64(); }
#undef PG8_STAMP
#undef PG8_SA
#undef PG8_SB
#undef PG8_STAGE
#undef PG8_LDA
#undef PG8_LDB
#undef PG8_MMA
#undef PG8_WAIT_V
#undef PG8_WAIT_L
#undef PG8_BAR
#undef PG8_SCHED
}
}
using pg8::bf16_t; using pg8::f32x4; using pg8::u32x4; using pg8::u32x2; using pg8::bf16x8;
constexpr int D = 2048, MP = 8192, MSAMP = 512, MROWS = 8704, NINP = 6400, NIN = 6160, DFF = 5632;
constexpr int C_BG = 0, C_CG = 1024, C_VC = 2048, C_Q = 3072, C_K = 3584, C_V = 4096, C_R = 5120, C_G1 = 6144;
constexpr size_t al256(size_t x) { return (x + 255) & ~(size_t)255; }
constexpr size_t WS_WT_IN = 0;
constexpr size_t WS_WT_OUT = WS_WT_IN + al256((size_t)NINP * D * 2);
constexpr size_t WS_WT_XQ = WS_WT_OUT + al256((size_t)D * D * 2);
constexpr size_t WS_WT_XO = WS_WT_XQ + al256((size_t)D * D * 2);
constexpr size_t WS_WT_XKV = WS_WT_XO + al256((size_t)D * D * 2);
constexpr size_t WS_WT_FGU = WS_WT_XKV + al256((size_t)2 * D * D * 2);
constexpr size_t WS_WT_FD = WS_WT_FGU + al256((size_t)2 * DFF * D * 2);
constexpr size_t WS_XN = WS_WT_FD + al256((size_t)D * DFF * 2);
constexpr size_t WS_MEMN = WS_XN + al256((size_t)MROWS * D * 2);
constexpr size_t WS_PROJ = WS_MEMN + al256((size_t)1024 * D * 2);
constexpr size_t WS_MIXIN = WS_PROJ + al256((size_t)MROWS * NINP * 2);
constexpr size_t WS_H = WS_MIXIN + al256((size_t)MROWS * D * 2);
constexpr size_t WS_HG = WS_H + al256((size_t)MROWS * D * 4);
constexpr size_t WS_MKB = WS_HG + al256((size_t)MROWS * D * 2);
constexpr size_t WS_MVT = WS_MKB + al256((size_t)1024 * D * 2);
constexpr size_t WS_OG = WS_MVT + al256((size_t)1024 * D * 2);
constexpr size_t WS_GU = WS_OG + al256((size_t)MP * 1024 * 4);
constexpr size_t WS_SSQ1 = WS_GU + al256((size_t)MROWS * 2 * DFF * 2);
constexpr size_t WS_SSQ2 = WS_SSQ1 + al256((size_t)MROWS * 32 * 4);
constexpr size_t WS_SSQ3 = WS_SSQ2 + al256((size_t)MROWS * 32 * 4);
constexpr size_t WS_END = WS_SSQ3 + al256((size_t)MROWS * 32 * 4);
constexpr size_t O_Y = 0, O_CONV_P = 17825792, O_GLA_P = 17833984, O_FFN_P = 18358272, O_MK = 18403328, O_MV = 20500480, O_CONV_S = 22597632, O_GLA_S = 22859776, O_FFN_S = 39636992;
constexpr int LDS_BYTES = 147456;

struct Args { const float* in[28]; float* out; unsigned char* ws; };
enum { I_XP = 0, I_XS, I_MEM, I_CCONV, I_SGLA, I_CFFN, I_CMK, I_CMV, I_NMIX, I_WIN, I_CONVW, I_WG2, I_BG, I_GLAN, I_WOUT, I_NX, I_NMEM, I_WXQ, I_WXK, I_WXV, I_WXO, I_NF, I_WFG, I_WFU, I_FCW, I_FCB, I_WFD, I_NFIN };

__device__ __forceinline__ float bflo(unsigned w) { return __uint_as_float(w << 16); }
__device__ __forceinline__ float bfhi(unsigned w) { return __uint_as_float(w & 0xffff0000u); }
__device__ __forceinline__ float bf2f(bf16_t b) { return __uint_as_float(((unsigned)b) << 16); }
__device__ __forceinline__ bf16_t f2bf(float f) { unsigned u = __float_as_uint(f); u += 0x7FFFu + ((u >> 16) & 1u); return (bf16_t)(u >> 16); }
__device__ __forceinline__ float silu_f(float x) { return x / (1.0f + __expf(-x)); }
__device__ __forceinline__ float wave_sum(float v) {
#pragma unroll
    for (int o = 32; o >= 1; o >>= 1) v += __shfl_xor(v, o);
    return v; }
__device__ __forceinline__ float wave_max(float v) {
#pragma unroll
    for (int o = 32; o >= 1; o >>= 1) v = fmaxf(v, __shfl_xor(v, o));
    return v; }
__device__ __forceinline__ void unpack8(const u32x4 w, float (&f)[8]) { f[0] = bflo(w.x); f[1] = bfhi(w.x); f[2] = bflo(w.y); f[3] = bfhi(w.y); f[4] = bflo(w.z); f[5] = bfhi(w.z); f[6] = bflo(w.w); f[7] = bfhi(w.w); }

__device__ __forceinline__ void transpose_job(const float* __restrict__ src, bf16_t* __restrict__ dst, int K, int N, int Npad, float* tile) {
    const int tid = threadIdx.x, nkt = K >> 6, ntile = nkt * (Npad >> 6);
    for (int ti = blockIdx.x; ti < ntile; ti += gridDim.x) {
        const int kt = ti % nkt, nt = ti / nkt, k0 = kt * 64, n0 = nt * 64;
        const int r = tid >> 4, c4 = (tid & 15) * 4;
#pragma unroll
        for (int i = 0; i < 2; ++i) { const int k = k0 + r + 32 * i, n = n0 + c4;
            f32x4 v = (f32x4){0.f, 0.f, 0.f, 0.f}; if (n < N) v = *(const f32x4*)(src + (size_t)k * N + n);
            float* tp = tile + (r + 32 * i) * 65 + c4; tp[0] = v[0]; tp[1] = v[1]; tp[2] = v[2]; tp[3] = v[3]; }
        __syncthreads();
        { const int n = tid >> 3, kk = (tid & 7) * 8; float f[8];
#pragma unroll
            for (int j = 0; j < 8; ++j) f[j] = tile[(kk + j) * 65 + n];
            u32x4 w; w.x = pg8::cvt_pk_bf16(f[0], f[1]); w.y = pg8::cvt_pk_bf16(f[2], f[3]); w.z = pg8::cvt_pk_bf16(f[4], f[5]); w.w = pg8::cvt_pk_bf16(f[6], f[7]);
            *(u32x4*)(dst + (size_t)(n0 + n) * K + k0 + kk) = w; }
        __syncthreads();
    }
}
__device__ __forceinline__ void rms_row_bf16(const float* __restrict__ x, const float* __restrict__ gain, bf16_t* __restrict__ o, int lane) {
    f32x4 v[8]; float ss = 0.f;
#pragma unroll
    for (int i = 0; i < 8; ++i) { v[i] = *(const f32x4*)(x + (i * 64 + lane) * 4); ss += (v[i][0] * v[i][0] + v[i][1] * v[i][1]) + (v[i][2] * v[i][2] + v[i][3] * v[i][3]); }
    ss = wave_sum(ss); const float rs = rsqrtf(ss * (1.0f / 2048.0f) + 1e-6f);
#pragma unroll
    for (int i = 0; i < 8; ++i) { const f32x4 g = *(const f32x4*)(gain + (i * 64 + lane) * 4); u32x2 w; w.x = pg8::cvt_pk_bf16(v[i][0] * rs * g[0], v[i][1] * rs * g[1]); w.y = pg8::cvt_pk_bf16(v[i][2] * rs * g[2], v[i][3] * rs * g[3]);
        *(u32x2*)(o + (i * 64 + lane) * 4) = w; }
}
__device__ __forceinline__ void phase_prep(const Args& a, float* lds) {
    unsigned char* ws = a.ws;
    transpose_job(a.in[I_WIN], (bf16_t*)(ws + WS_WT_IN), D, NIN, NINP, lds);
    transpose_job(a.in[I_WOUT], (bf16_t*)(ws + WS_WT_OUT), D, D, D, lds);
    transpose_job(a.in[I_WXQ], (bf16_t*)(ws + WS_WT_XQ), D, D, D, lds);
    transpose_job(a.in[I_WXO], (bf16_t*)(ws + WS_WT_XO), D, D, D, lds);
    transpose_job(a.in[I_WXK], (bf16_t*)(ws + WS_WT_XKV), D, D, D, lds);
    transpose_job(a.in[I_WXV], (bf16_t*)(ws + WS_WT_XKV) + (size_t)D * D, D, D, D, lds);
    transpose_job(a.in[I_WFG], (bf16_t*)(ws + WS_WT_FGU), D, DFF, DFF, lds);
    transpose_job(a.in[I_WFU], (bf16_t*)(ws + WS_WT_FGU) + (size_t)DFF * D, D, DFF, DFF, lds);
    transpose_job(a.in[I_WFD], (bf16_t*)(ws + WS_WT_FD), DFF, D, D, lds);
    const int lane = threadIdx.x & 63, gw = blockIdx.x * 8 + (threadIdx.x >> 6), nw = gridDim.x * 8;
    for (int row = gw; row < MROWS + 1024; row += nw) {
        if (row < MP) rms_row_bf16(a.in[I_XP] + (size_t)row * D, a.in[I_NMIX], (bf16_t*)(ws + WS_XN) + (size_t)row * D, lane);
        else if (row < MROWS) rms_row_bf16(a.in[I_XS] + (size_t)(row - MP) * D, a.in[I_NMIX], (bf16_t*)(ws + WS_XN) + (size_t)row * D, lane);
        else rms_row_bf16(a.in[I_MEM] + (size_t)(row - MROWS) * D, a.in[I_NMEM], (bf16_t*)(ws + WS_MEMN) + (size_t)(row - MROWS) * D, lane);
    }
}

__device__ __forceinline__ float forget_gate(float z) { const float ls = fminf(z, 0.f) - log1pf(__expf(-fabsf(z))); return __expf(ls * 0.0625f); }

__device__ __forceinline__ void gla_prompt_item(const Args& a, int item, float* lds) {
    const int tid = threadIdx.x, b = item >> 6, h = (item >> 4) & 3, sl = item & 15;
    float* qs = lds; float* ks = qs + 4096; float* fs = ks + 4096; float* vs = fs + 4096; float* w2s = vs + 512; float* bsm = w2s + 2048; float* opart = bsm + 128;
    for (int i = tid; i < 2048; i += 512) w2s[i] = a.in[I_WG2][(i >> 7) * 512 + h * 128 + (i & 127)];
    if (tid < 128) bsm[tid] = a.in[I_BG][h * 128 + tid];
    __syncthreads();
    const bf16_t* proj = (const bf16_t*)(a.ws + WS_PROJ) + (size_t)(b * 2048) * NINP;
    float* og = (float*)(a.ws + WS_OG);
    const int tt = tid >> 4, sub = tid & 15;
    const int dv = tid & 15, dkg = tid >> 4;
    float s0 = 0.f, s1 = 0.f, s2 = 0.f, s3 = 0.f;
    u32x4 rq, rk, rg0, rg1; bf16_t rv;
    { const bf16_t* row = proj + (size_t)tt * NINP; rq = *(const u32x4*)(row + C_Q + h * 128 + sub * 8); rk = *(const u32x4*)(row + C_K + h * 128 + sub * 8); rg0 = *(const u32x4*)(row + C_G1); rg1 = *(const u32x4*)(row + C_G1 + 8); rv = row[C_V + h * 256 + sl * 16 + sub]; }
    for (int n = 0; n < 64; ++n) {
        { float g1[16], z[8], qf[8], kf[8];
            { float t8[8]; unpack8(rg0, t8);
#pragma unroll
                for (int j = 0; j < 8; ++j) g1[j] = t8[j];
                unpack8(rg1, t8);
#pragma unroll
                for (int j = 0; j < 8; ++j) g1[8 + j] = t8[j]; }
            unpack8(rq, qf); unpack8(rk, kf);
#pragma unroll
            for (int j = 0; j < 8; ++j) z[j] = bsm[sub * 8 + j];
#pragma unroll
            for (int r = 0; r < 16; ++r) { const f32x4 wa = *(const f32x4*)(w2s + r * 128 + sub * 8), wb = *(const f32x4*)(w2s + r * 128 + sub * 8 + 4);
#pragma unroll
                for (int j = 0; j < 4; ++j) { z[j] += g1[r] * wa[j]; z[4 + j] += g1[r] * wb[j]; } }
            float* fp = fs + tt * 128 + sub * 8; float* qp = qs + tt * 128 + sub * 8; float* kp = ks + tt * 128 + sub * 8;
#pragma unroll
            for (int j = 0; j < 8; ++j) { fp[j] = forget_gate(z[j]); qp[j] = qf[j] * 0.08838834764831845f; kp[j] = kf[j]; }
            vs[tt * 16 + sub] = bf2f(rv); }
        __syncthreads();
        if (n + 1 < 64) { const bf16_t* row = proj + (size_t)((n + 1) * 32 + tt) * NINP; rq = *(const u32x4*)(row + C_Q + h * 128 + sub * 8); rk = *(const u32x4*)(row + C_K + h * 128 + sub * 8); rg0 = *(const u32x4*)(row + C_G1); rg1 = *(const u32x4*)(row + C_G1 + 8); rv = row[C_V + h * 256 + sl * 16 + sub]; }
#pragma unroll 8
        for (int t = 0; t < 32; ++t) {
            const f32x4 f4 = *(const f32x4*)(fs + t * 128 + dkg * 4), k4 = *(const f32x4*)(ks + t * 128 + dkg * 4), q4 = *(const f32x4*)(qs + t * 128 + dkg * 4); const float v = vs[t * 16 + dv];
            s0 = f4[0] * s0 + k4[0] * v; s1 = f4[1] * s1 + k4[1] * v; s2 = f4[2] * s2 + k4[2] * v; s3 = f4[3] * s3 + k4[3] * v;
            opart[dkg * 528 + t * 16 + dv] = (q4[0] * s0 + q4[1] * s1) + (q4[2] * s2 + q4[3] * s3); }
        __syncthreads();
        { float o = 0.f;
#pragma unroll 8
            for (int g = 0; g < 32; ++g) o += opart[g * 528 + tid];
            og[(size_t)(b * 2048 + n * 32 + (tid >> 4)) * 1024 + h * 256 + sl * 16 + (tid & 15)] = o; }
    }
    float* so = a.out + O_GLA_P + ((size_t)((b * 4 + h) * 128 + dkg * 4)) * 256 + sl * 16 + dv;
    so[0] = s0; so[256] = s1; so[512] = s2; so[768] = s3;
    __syncthreads();
}

__device__ __forceinline__ void gla_sample_item(const Args& a, int it, float* lds) {
    const int tid = threadIdx.x, b = it >> 2, h = it & 3, lane = tid & 63, wid = tid >> 6;
    float* qs = lds; float* ks = qs + 512; float* fs = ks + 512; float* vs = fs + 512; float* red = vs + 1024; float* rsum = red + 512;
    const bf16_t* proj = (const bf16_t*)(a.ws + WS_PROJ) + (size_t)(MP + b * 4) * NINP;
    { const int t = tid >> 7, dk = tid & 127; const bf16_t* row = proj + (size_t)t * NINP; float z = a.in[I_BG][h * 128 + dk];
#pragma unroll
        for (int r = 0; r < 16; ++r) z += bf2f(row[C_G1 + r]) * a.in[I_WG2][r * 512 + h * 128 + dk];
        fs[tid] = forget_gate(z); qs[tid] = bf2f(row[C_Q + h * 128 + dk]) * 0.08838834764831845f; ks[tid] = bf2f(row[C_K + h * 128 + dk]); }
#pragma unroll
    for (int i = 0; i < 2; ++i) { const int idx = tid + i * 512, t = idx >> 8, d = idx & 255; vs[idx] = bf2f(proj[(size_t)t * NINP + C_V + h * 256 + d]); }
    const int dv = tid & 255, half = tid >> 8;
    float s[64];
    const float* sp = a.in[I_SGLA] + ((size_t)((b * 4 + h) * 128 + half * 64)) * 256 + dv;
#pragma unroll
    for (int j = 0; j < 64; ++j) s[j] = sp[(size_t)j * 256];
    __syncthreads();
    float ov[4];
#pragma unroll
    for (int t = 0; t < 4; ++t) { const float v = vs[t * 256 + dv]; float po = 0.f;
#pragma unroll
        for (int j = 0; j < 64; j += 4) { const f32x4 f4 = *(const f32x4*)(fs + t * 128 + half * 64 + j), k4 = *(const f32x4*)(ks + t * 128 + half * 64 + j), q4 = *(const f32x4*)(qs + t * 128 + half * 64 + j);
#pragma unroll
            for (int e = 0; e < 4; ++e) { s[j + e] = f4[e] * s[j + e] + k4[e] * v; po += q4[e] * s[j + e]; } }
        red[t * 512 + half * 256 + dv] = po; ov[t] = po; }
    float* so = a.out + O_GLA_S + ((size_t)((b * 4 + h) * 128 + half * 64)) * 256 + dv;
#pragma unroll
    for (int j = 0; j < 64; ++j) so[(size_t)j * 256] = s[j];
    __syncthreads();
    float* rs2 = red + 2048;
#pragma unroll
    for (int t = 0; t < 4; ++t) { const float o = red[t * 512 + dv] + red[t * 512 + 256 + dv]; ov[t] = o; const float ss = wave_sum(o * o); if (lane == 0) rs2[t * 8 + wid] = ss; }
    __syncthreads();
    if (half == 0) {
#pragma unroll
        for (int t = 0; t < 4; ++t) { const float tot = (rs2[t * 8] + rs2[t * 8 + 1]) + (rs2[t * 8 + 2] + rs2[t * 8 + 3]); const float rstd = rsqrtf(tot * (1.0f / 256.0f) + 1e-6f);
            const float rg = bf2f(proj[(size_t)t * NINP + C_R + h * 256 + dv]);
            ((bf16_t*)(a.ws + WS_MIXIN))[(size_t)(MP + b * 4 + t) * D + 1024 + h * 256 + dv] = f2bf(ov[t] * rstd * a.in[I_GLAN][h * 256 + dv] * silu_f(rg)); } }
    __syncthreads();
}

__device__ __forceinline__ void phase_mix_rows(const Args& a) {
    const int lane = threadIdx.x & 63, gw = blockIdx.x * 8 + (threadIdx.x >> 6), nw = gridDim.x * 8;
    const bf16_t* projb = (const bf16_t*)(a.ws + WS_PROJ); bf16_t* mix = (bf16_t*)(a.ws + WS_MIXIN);
    const float* cw = a.in[I_CONVW];
    for (int row = gw; row < MROWS; row += nw) {
        const bool samp = row >= MP; const int t = samp ? ((row - MP) & 3) : (row & 2047), bi = samp ? ((row - MP) >> 2) : (row >> 11);
        const bf16_t* pr = projb + (size_t)row * NINP;
#pragma unroll
        for (int i = 0; i < 2; ++i) { const int c = i * 512 + lane * 8;
            float bg[8], cgv[8], vcv[8], u2[8], u1[8], u0[8];
            unpack8(*(const u32x4*)(pr + C_BG + c), bg); unpack8(*(const u32x4*)(pr + C_CG + c), cgv); unpack8(*(const u32x4*)(pr + C_VC + c), vcv);
#pragma unroll
            for (int j = 0; j < 8; ++j) u2[j] = cgv[j] * vcv[j];
            if (t >= 1) { unpack8(*(const u32x4*)(pr - NINP + C_CG + c), cgv); unpack8(*(const u32x4*)(pr - NINP + C_VC + c), vcv);
#pragma unroll
                for (int j = 0; j < 8; ++j) u1[j] = cgv[j] * vcv[j]; }
            else if (samp) { const float* cp = a.in[I_CCONV] + (size_t)(bi * 2 + 1) * 1024 + c;
#pragma unroll
                for (int j = 0; j < 8; ++j) u1[j] = cp[j]; }
            else {
#pragma unroll
                for (int j = 0; j < 8; ++j) u1[j] = 0.f; }
            if (t >= 2) { unpack8(*(const u32x4*)(pr - 2 * NINP + C_CG + c), cgv); unpack8(*(const u32x4*)(pr - 2 * NINP + C_VC + c), vcv);
#pragma unroll
                for (int j = 0; j < 8; ++j) u0[j] = cgv[j] * vcv[j]; }
            else if (samp) { const float* cp = a.in[I_CCONV] + (size_t)(bi * 2 + t) * 1024 + c;
#pragma unroll
                for (int j = 0; j < 8; ++j) u0[j] = cp[j]; }
            else {
#pragma unroll
                for (int j = 0; j < 8; ++j) u0[j] = 0.f; }
            float o[8];
#pragma unroll
            for (int j = 0; j < 8; ++j) o[j] = bg[j] * (cw[c + j] * u0[j] + cw[1024 + c + j] * u1[j] + cw[2048 + c + j] * u2[j]);
            u32x4 w; w.x = pg8::cvt_pk_bf16(o[0], o[1]); w.y = pg8::cvt_pk_bf16(o[2], o[3]); w.z = pg8::cvt_pk_bf16(o[4], o[5]); w.w = pg8::cvt_pk_bf16(o[6], o[7]);
            *(u32x4*)(mix + (size_t)row * D + c) = w;
            float* cn = nullptr;
            if (!samp) { if (t >= 2046) cn = a.out + O_CONV_P + (size_t)(bi * 2 + (t - 2046)) * 1024 + c; }
            else { if (t >= 2) cn = a.out + O_CONV_S + (size_t)(bi * 2 + (t - 2)) * 1024 + c; }
            if (cn) {
#pragma unroll
                for (int j = 0; j < 8; ++j) cn[j] = u2[j]; }
        }
        if (!samp) {
            const float* og = (const float*)(a.ws + WS_OG) + (size_t)row * 1024;
#pragma unroll
            for (int h = 0; h < 4; ++h) { const f32x4 o4 = *(const f32x4*)(og + h * 256 + lane * 4);
                const float ss = wave_sum((o4[0] * o4[0] + o4[1] * o4[1]) + (o4[2] * o4[2] + o4[3] * o4[3])); const float rstd = rsqrtf(ss * (1.0f / 256.0f) + 1e-6f);
                const f32x4 gn = *(const f32x4*)(a.in[I_GLAN] + h * 256 + lane * 4); const u32x2 rw = *(const u32x2*)(pr + C_R + h * 256 + lane * 4);
                const float r0 = bflo(rw.x), r1 = bfhi(rw.x), r2 = bflo(rw.y), r3 = bfhi(rw.y);
                u32x2 w; w.x = pg8::cvt_pk_bf16(o4[0] * rstd * gn[0] * silu_f(r0), o4[1] * rstd * gn[1] * silu_f(r1)); w.y = pg8::cvt_pk_bf16(o4[2] * rstd * gn[2] * silu_f(r2), o4[3] * rstd * gn[3] * silu_f(r3));
                *(u32x2*)(mix + (size_t)row * D + 1024 + h * 256 + lane * 4) = w; }
        }
    }
}

__device__ __forceinline__ void xattn_prompt_item(const Args& a, int it) {
    const int tid = threadIdx.x, lane = tid & 63, wid = tid >> 6, fr = lane & 15, fq = lane >> 4;
    const int b = it >> 6, h = (it >> 4) & 3, tt = it & 15;
    const int r0 = b * 2048 + tt * 128 + wid * 16;
    const bf16_t* qp = (const bf16_t*)(a.ws + WS_XN) + (size_t)(r0 + fr) * D + h * 512 + fq * 16;
    const bf16_t* kp = (const bf16_t*)(a.ws + WS_MKB) + (size_t)(b * 256 + fr) * D + h * 512 + fq * 16;
    const bf16_t* vp = (const bf16_t*)(a.ws + WS_MVT) + (size_t)(b * 2048 + h * 512 + fr) * 256 + fq * 8;
    bf16x8 qf[8][2];
#pragma unroll
    for (int p = 0; p < 8; ++p) { qf[p][0] = *(const bf16x8*)(qp + p * 64); qf[p][1] = *(const bf16x8*)(qp + p * 64 + 8); }
    f32x4 st[16];
#pragma unroll
    for (int n = 0; n < 16; ++n) { f32x4 acc = (f32x4){0.f, 0.f, 0.f, 0.f}; const bf16_t* kr = kp + (size_t)n * 16 * D;
#pragma unroll
        for (int p = 0; p < 8; ++p) { const bf16x8 k0 = *(const bf16x8*)(kr + p * 64), k1 = *(const bf16x8*)(kr + p * 64 + 8);
            acc = __builtin_amdgcn_mfma_f32_16x16x32_bf16(k0, qf[p][0], acc, 0, 0, 0); acc = __builtin_amdgcn_mfma_f32_16x16x32_bf16(k1, qf[p][1], acc, 0, 0, 0); }
        st[n] = acc; }
    float mx = -3.0e38f;
#pragma unroll
    for (int n = 0; n < 16; ++n) mx = fmaxf(fmaxf(fmaxf(st[n][0], st[n][1]), fmaxf(st[n][2], st[n][3])), mx);
    mx = fmaxf(mx, __shfl_xor(mx, 16)); mx = fmaxf(mx, __shfl_xor(mx, 32));
    float sum = 0.f;
#pragma unroll
    for (int n = 0; n < 16; ++n) {
#pragma unroll
        for (int e = 0; e < 4; ++e) { const float p = __expf(st[n][e] - mx); st[n][e] = p; sum += p; } }
    sum += __shfl_xor(sum, 16); sum += __shfl_xor(sum, 32);
    const float inv = 1.0f / sum;
    bf16x8 pf[8];
#pragma unroll
    for (int i = 0; i < 8; ++i) { u32x4 w = pg8::pack8(st[2 * i], st[2 * i + 1]); pf[i] = __builtin_bit_cast(bf16x8, w); }
    bf16_t* op = (bf16_t*)(a.ws + WS_MIXIN) + (size_t)(r0 + fr) * D + h * 512 + 4 * fq;
#pragma unroll 4
    for (int dt = 0; dt < 32; ++dt) { f32x4 acc = (f32x4){0.f, 0.f, 0.f, 0.f}; const bf16_t* vr = vp + (size_t)dt * 16 * 256;
#pragma unroll
        for (int i = 0; i < 8; ++i) { const bf16x8 vf = *(const bf16x8*)(vr + i * 32); acc = __builtin_amdgcn_mfma_f32_16x16x32_bf16(vf, pf[i], acc, 0, 0, 0); }
        u32x2 w; w.x = pg8::cvt_pk_bf16(acc[0] * inv, acc[1] * inv); w.y = pg8::cvt_pk_bf16(acc[2] * inv, acc[3] * inv);
        *(u32x2*)(op + dt * 16) = w; }
}
__device__ __forceinline__ void xattn_sample_item(const Args& a, int it, float* lds) {
    const int tid = threadIdx.x, lane = tid & 63, wid = tid >> 6, b = it >> 2, h = it & 3;
    float* sc = lds; float* red = lds + 1024;
    const float* Kc = a.in[I_CMK] + ((size_t)b * 1024 + h) * 512; const float* Vc = a.in[I_CMV] + ((size_t)b * 1024 + h) * 512;
    const bf16_t* qb = (const bf16_t*)(a.ws + WS_XN) + (size_t)(MP + b * 4) * D + h * 512;
    float qr[4][8];
#pragma unroll
    for (int t = 0; t < 4; ++t) unpack8(*(const u32x4*)(qb + (size_t)t * D + lane * 8), qr[t]);
#pragma unroll 4
    for (int kk = 0; kk < 32; ++kk) { const int key = wid * 32 + kk; const float* kp = Kc + (size_t)key * 2048 + lane * 8; const f32x4 k0 = *(const f32x4*)kp, k1 = *(const f32x4*)(kp + 4);
        float p[4];
#pragma unroll
        for (int t = 0; t < 4; ++t) { p[t] = (qr[t][0] * k0[0] + qr[t][1] * k0[1]) + (qr[t][2] * k0[2] + qr[t][3] * k0[3]) + (qr[t][4] * k1[0] + qr[t][5] * k1[1]) + (qr[t][6] * k1[2] + qr[t][7] * k1[3]); p[t] = wave_sum(p[t]); }
        if (lane == 0) { sc[key] = p[0]; sc[256 + key] = p[1]; sc[512 + key] = p[2]; sc[768 + key] = p[3]; } }
    __syncthreads();
    if (wid < 4) { f32x4 s4 = *(const f32x4*)(sc + wid * 256 + lane * 4); const float mx = wave_max(fmaxf(fmaxf(s4[0], s4[1]), fmaxf(s4[2], s4[3])));
        s4[0] = __expf(s4[0] - mx); s4[1] = __expf(s4[1] - mx); s4[2] = __expf(s4[2] - mx); s4[3] = __expf(s4[3] - mx);
        const float inv = 1.0f / wave_sum((s4[0] + s4[1]) + (s4[2] + s4[3])); s4 = s4 * inv; *(f32x4*)(sc + wid * 256 + lane * 4) = s4; }
    __syncthreads();
    { const int dq = tid & 127, kq = tid >> 7; f32x4 acc[4];
#pragma unroll
        for (int t = 0; t < 4; ++t) acc[t] = (f32x4){0.f, 0.f, 0.f, 0.f};
#pragma unroll 8
        for (int kk = 0; kk < 64; ++kk) { const int key = kq * 64 + kk; const f32x4 v = *(const f32x4*)(Vc + (size_t)key * 2048 + dq * 4);
#pragma unroll
            for (int t = 0; t < 4; ++t) acc[t] += v * sc[t * 256 + key]; }
#pragma unroll
        for (int t = 0; t < 4; ++t) *(f32x4*)(red + (kq * 4 + t) * 512 + dq * 4) = acc[t]; }
    __syncthreads();
    { const int dq = tid & 127, t = tid >> 7; f32x4 o = *(const f32x4*)(red + t * 512 + dq * 4);
#pragma unroll
        for (int kq = 1; kq < 4; ++kq) o += *(const f32x4*)(red + (kq * 4 + t) * 512 + dq * 4);
        u32x2 w; w.x = pg8::cvt_pk_bf16(o[0], o[1]); w.y = pg8::cvt_pk_bf16(o[2], o[3]);
        *(u32x2*)((bf16_t*)(a.ws + WS_MIXIN) + (size_t)(MP + b * 4 + t) * D + h * 512 + dq * 4) = w; }
    __syncthreads();
}

__device__ __forceinline__ void phase_act(const Args& a) {
    const bf16_t* gu = (const bf16_t*)(a.ws + WS_GU); bf16_t* act = (bf16_t*)(a.ws + WS_PROJ);
    const float* cw = a.in[I_FCW]; const float* cb = a.in[I_FCB];
    const int total = MROWS * 704;
    for (int idx = blockIdx.x * 512 + threadIdx.x; idx < total; idx += gridDim.x * 512) {
        const int row = idx / 704, c = (idx - row * 704) * 8;
        const bool samp = row >= MP; const int t = samp ? ((row - MP) & 3) : (row & 2047), bi = samp ? ((row - MP) >> 2) : (row >> 11);
        const bf16_t* gr = gu + (size_t)row * (2 * DFF) + c;
        float g2[8], g1[8], g0[8], uu[8];
        unpack8(*(const u32x4*)gr, g2); unpack8(*(const u32x4*)(gr + DFF), uu);
        if (t >= 1) unpack8(*(const u32x4*)(gr - 2 * DFF), g1);
        else if (samp) { const float* cp = a.in[I_CFFN] + (size_t)(bi * 2 + 1) * DFF + c;
#pragma unroll
            for (int j = 0; j < 8; ++j) g1[j] = cp[j]; }
        else {
#pragma unroll
            for (int j = 0; j < 8; ++j) g1[j] = 0.f; }
        if (t >= 2) unpack8(*(const u32x4*)(gr - 4 * DFF), g0);
        else if (samp) { const float* cp = a.in[I_CFFN] + (size_t)(bi * 2 + t) * DFF + c;
#pragma unroll
            for (int j = 0; j < 8; ++j) g0[j] = cp[j]; }
        else {
#pragma unroll
            for (int j = 0; j < 8; ++j) g0[j] = 0.f; }
        float o[8];
#pragma unroll
        for (int j = 0; j < 8; ++j) { const float x = cw[c + j] * g0[j] + cw[DFF + c + j] * g1[j] + cw[2 * DFF + c + j] * g2[j] + cb[c + j]; o[j] = silu_f(x) * uu[j]; }
        u32x4 w; w.x = pg8::cvt_pk_bf16(o[0], o[1]); w.y = pg8::cvt_pk_bf16(o[2], o[3]); w.z = pg8::cvt_pk_bf16(o[4], o[5]); w.w = pg8::cvt_pk_bf16(o[6], o[7]);
        *(u32x4*)(act + (size_t)row * DFF + c) = w;
    }
}

__device__ __forceinline__ void phase_final(const Args& a) {
    const int lane = threadIdx.x & 63, gw = blockIdx.x * 8 + (threadIdx.x >> 6), nw = gridDim.x * 8;
    const float* ssq = (const float*)(a.ws + WS_SSQ3); const float* g = a.in[I_NFIN];
    for (int row = gw; row < MROWS; row += nw) {
        const float tot = wave_sum(lane < 32 ? ssq[(size_t)row * 32 + lane] : 0.f); const float rs = rsqrtf(tot * (1.0f / 2048.0f) + 1e-6f);
        float* y = a.out + O_Y + (size_t)row * D;
#pragma unroll
        for (int i = 0; i < 8; ++i) { f32x4 v = *(const f32x4*)(y + (i * 64 + lane) * 4); const f32x4 gg = *(const f32x4*)(g + (i * 64 + lane) * 4); v = v * rs * gg; *(f32x4*)(y + (i * 64 + lane) * 4) = v; }
    }
}

template <class Epi> __device__ __forceinline__ void run_gemm(PG8_LAS unsigned char* lds, const bf16_t* A, const bf16_t* Bt, int M, int N, int K, int cshift, const Epi& E) {
    pg8::Gemm g; g.A = A; g.Bt = Bt; g.M = M; g.N = N; g.K = K;
    pg8::StaticOrder S; S.init(M, N, (int)gridDim.x, (int)((blockIdx.x + gridDim.x - (cshift % gridDim.x)) % gridDim.x));
    pg8::gemm_phase<Epi, pg8::StaticOrder, false>(lds, g, S, E, nullptr);
}

__global__ void __launch_bounds__(512, 2) mk_fwd(Args a) {
    extern __shared__ __attribute__((aligned(16))) unsigned char shm[];
    cg::grid_group grid = cg::this_grid();
    PG8_LAS unsigned char* lds = (PG8_LAS unsigned char*)shm;
    float* ldsf = (float*)shm;
    unsigned char* ws = a.ws;
    phase_prep(a, ldsf);
    grid.sync();
    { pg8::EpiProj E; E.O = (bf16_t*)(ws + WS_PROJ); E.ldc = NINP;
      run_gemm(lds, (const bf16_t*)(ws + WS_XN), (const bf16_t*)(ws + WS_WT_IN), MROWS, NINP, D, 0, E); }
    { pg8::EpiKV E; E.outk = a.out + O_MK; E.outv = a.out + O_MV; E.mkb = (bf16_t*)(ws + WS_MKB); E.mvt = (bf16_t*)(ws + WS_MVT);
      run_gemm(lds, (const bf16_t*)(ws + WS_MEMN), (const bf16_t*)(ws + WS_WT_XKV), 1024, 4096, D, (MROWS / 256) * (NINP / 256), E); }
    grid.sync();
    for (int it = blockIdx.x; it < 256; it += gridDim.x) gla_prompt_item(a, it, ldsf);
    for (int it = blockIdx.x; it < 512; it += gridDim.x) gla_sample_item(a, it, ldsf);
    grid.sync();
    phase_mix_rows(a);
    grid.sync();
    { pg8::EpiRes<true> E; E.res0 = a.in[I_XP]; E.res1 = a.in[I_XS]; E.split = MP; E.hout = (float*)(ws + WS_H); E.hg = (bf16_t*)(ws + WS_HG); E.gain = a.in[I_NX]; E.ssq = (float*)(ws + WS_SSQ1);
      run_gemm(lds, (const bf16_t*)(ws + WS_MIXIN), (const bf16_t*)(ws + WS_WT_OUT), MROWS, D, D, 0, E); }
    grid.sync();
    { pg8::EpiScale<false> E; E.O = (bf16_t*)(ws + WS_XN); E.ldc = D; E.ssq = (const float*)(ws + WS_SSQ1); E.scale = 0.044194173824159216f; E.ffn_p = nullptr; E.ffn_s = nullptr;
      run_gemm(lds, (const bf16_t*)(ws + WS_HG), (const bf16_t*)(ws + WS_WT_XQ), MROWS, D, D, 0, E); }
    grid.sync();
    for (int it = blockIdx.x; it < 256; it += gridDim.x) xattn_prompt_item(a, it);
    for (int it = blockIdx.x; it < 512; it += gridDim.x) xattn_sample_item(a, it, ldsf);
    grid.sync();
    { pg8::EpiRes<true> E; E.res0 = (const float*)(ws + WS_H); E.res1 = E.res0; E.split = MROWS; E.hout = (float*)(ws + WS_H); E.hg = (bf16_t*)(ws + WS_HG); E.gain = a.in[I_NF]; E.ssq = (float*)(ws + WS_SSQ2);
      run_gemm(lds, (const bf16_t*)(ws + WS_MIXIN), (const bf16_t*)(ws + WS_WT_XO), MROWS, D, D, 0, E); }
    grid.sync();
    { pg8::EpiScale<true> E; E.O = (bf16_t*)(ws + WS_GU); E.ldc = 2 * DFF; E.ssq = (const float*)(ws + WS_SSQ2); E.scale = 1.0f; E.ffn_p = a.out + O_FFN_P; E.ffn_s = a.out + O_FFN_S;
      run_gemm(lds, (const bf16_t*)(ws + WS_HG), (const bf16_t*)(ws + WS_WT_FGU), MROWS, 2 * DFF, D, 0, E); }
    grid.sync();
    phase_act(a);
    grid.sync();
    { pg8::EpiRes<false> E; E.res0 = (const float*)(ws + WS_H); E.res1 = E.res0; E.split = MROWS; E.hout = a.out + O_Y; E.hg = nullptr; E.gain = nullptr; E.ssq = (float*)(ws + WS_SSQ3);
      run_gemm(lds, (const bf16_t*)(ws + WS_PROJ), (const bf16_t*)(ws + WS_WT_FD), MROWS, D, DFF, 0, E); }
    grid.sync();
    phase_final(a);
}

extern "C" void kernel_launch(void* const* d_in, const int* in_sizes, int n_in, void* d_out, int out_size, void* d_ws, size_t ws_size, hipStream_t stream) {
    static int grid = 0;
    if (grid == 0) {
        if (n_in != 28 || ws_size < WS_END) { fprintf(stderr, "kernel_launch: unexpected n_in %d or ws_size %zu (< %zu)\n", n_in, ws_size, (size_t)WS_END); grid = -1; return; }
        int dev = 0, cus = 0, per_cu = 0;
        (void)hipGetDevice(&dev); (void)hipDeviceGetAttribute(&cus, hipDeviceAttributeMultiprocessorCount, dev);
        (void)hipFuncSetAttribute((const void*)mk_fwd, hipFuncAttributeMaxDynamicSharedMemorySize, LDS_BYTES);
        (void)hipOccupancyMaxActiveBlocksPerMultiprocessor(&per_cu, (const void*)mk_fwd, 512, LDS_BYTES);
        if (per_cu < 1) { fprintf(stderr, "kernel_launch: occupancy query says %d blocks/CU\n", per_cu); grid = -1; return; }
        grid = cus;
    }
    if (grid < 0) return;
    Args a{};
    for (int i = 0; i < 28; ++i) a.in[i] = (const float*)d_in[i];
    a.out = (float*)d_out; a.ws = (unsigned char*)d_ws;
    void* args[] = {&a};
    hipError_t e = hipLaunchCooperativeKernel((const void*)mk_fwd, dim3(grid), dim3(512), args, LDS_BYTES, stream);
    if (e != hipSuccess) fprintf(stderr, "cooperative launch failed: %s (grid %d)\n", hipGetErrorString(e), grid);
}
```

```cpp
#include <hip/hip_runtime.h>
#include <hip/hip_cooperative_groups.h>
#include <cstdio>
namespace cg = cooperative_groups;

__device__ __forceinline__ int tid_opq() { int t = threadIdx.x; asm volatile("" : "+v"(t)); return t; }
namespace pg8 {
#define PG8_LAS __attribute__((address_space(3)))
typedef unsigned short bf16_t;
typedef short bf16x8 __attribute__((ext_vector_type(8)));
typedef float f32x4 __attribute__((ext_vector_type(4)));
typedef unsigned u32x4 __attribute__((ext_vector_type(4)));
constexpr int BM = 256, BK = 64, HALF = 128, HTB = HALF * BK * 2  , STAGE_BYTES = 8 * HTB, NXCD = 8, WGM = 8;

__host__ __device__ __forceinline__ int lds_byte(int r, int c) { const int st = (r >> 4) * 2 + (c >> 5), rr = r & 15, cc = c & 31, ob = rr * 64 + cc * 2; return st * 1024 + (ob ^ (((ob >> 9) & 1) << 5)); }
__host__ __device__ __forceinline__ void stage_rc(int b, int& R, int& C) { const int st = b / 1024, sb = b % 1024, swz = sb ^ (((sb >> 9) & 1) << 5); R = (st >> 1) * 16 + swz / 64; C = (st & 1) * 32 + (swz % 64) / 2; }
__host__ __device__ __forceinline__ int perm32(int rho) { const int n = rho >> 4, i = rho & 15; return 8 * (i >> 2) + 4 * n + (i & 3); }

struct Unit { int pm, pn; };
struct Gemm { const bf16_t* A; const bf16_t* Bt; int M, N, K; };

struct StaticOrder {
    int nM, nN, nwg, G, c;
    __host__ __device__ void init(int M, int N, int G_, int c_) { nM = M / BM; nN = N / BM; nwg = nM * nN; G = G_; c = c_; }
    __host__ __device__ bool next(int i, Unit& u) const {
        const long L = (long)i * G + c; if (L >= nwg) return false;
        int wgid = (int)L; { const int q = nwg / NXCD, r = nwg % NXCD, xcd = wgid % NXCD, off = wgid / NXCD; wgid = (xcd < r ? xcd * (q + 1) : r * (q + 1) + (xcd - r) * q) + off; }
        const int nig = WGM * nN, gid = wgid / nig, fm = gid * WGM, gsz = (nM - fm) < WGM ? (nM - fm) : WGM;
        u.pm = fm + ((wgid % nig) % gsz); u.pn = (wgid % nig) / gsz; return true;
    }
    __device__ __forceinline__ void a_ready(const Unit&) const {}
    __device__ __forceinline__ void done(const Unit&) const {}
};
typedef unsigned u32x2 __attribute__((ext_vector_type(2)));
__device__ __forceinline__ unsigned cvt_pk_bf16(float lo, float hi) { unsigned r; asm volatile("v_cvt_pk_bf16_f32 %0, %1, %2" : "=v"(r) : "v"(lo), "v"(hi)); return r; }
__device__ __forceinline__ u32x4 pack8(const f32x4 v0, const f32x4 v1) { u32x4 w; w.x = cvt_pk_bf16(v0[0], v0[1]); w.y = cvt_pk_bf16(v0[2], v0[3]); w.z = cvt_pk_bf16(v1[0], v1[1]); w.w = cvt_pk_bf16(v1[2], v1[3]); return w; }

struct EpiProj {
    static constexpr bool PERM = true, AFTER_DRAIN = false;
    bf16_t* O; int ldc;
    __device__ __forceinline__ void operator()(const f32x4 (&acc)[2][2][4][2], const Unit& u, int wr, int wc, int fr, int fq) const {
        const int row0 = u.pm * BM + wr * 64 + fr, col0 = u.pn * BM + wc * 32 + 8 * fq;
#pragma unroll
        for (int ai = 0; ai < 2; ++ai)
#pragma unroll
            for (int m = 0; m < 4; ++m) { bf16_t* rowp = O + (size_t)(row0 + ai * HALF + m * 16) * ldc + col0;
#pragma unroll
                for (int bj = 0; bj < 2; ++bj) *(u32x4*)(rowp + bj * HALF) = pack8(acc[ai][bj][m][0], acc[ai][bj][m][1]); }
    }
};

struct EpiKV {
    static constexpr bool PERM = false, AFTER_DRAIN = false;
    float* outk; float* outv; bf16_t* mkb; bf16_t* mvt;
    __device__ __forceinline__ void operator()(const f32x4 (&acc)[2][2][4][2], const Unit& u, int wr, int wc, int fr, int fq) const {
        const int row0 = u.pm * BM + wr * 64 + fr, col0 = (u.pn & 7) * BM + wc * 32 + 4 * fq;
        const bool isv = u.pn >= 8;
#pragma unroll
        for (int ai = 0; ai < 2; ++ai)
#pragma unroll
            for (int m = 0; m < 4; ++m) { const int r = row0 + ai * HALF + m * 16;
                const int bb = r >> 8, key = r & 255, pos = (key & ~31) + 8 * ((key >> 2) & 3) + 4 * ((key >> 4) & 1) + (key & 3);
#pragma unroll
                for (int bj = 0; bj < 2; ++bj)
#pragma unroll
                    for (int n = 0; n < 2; ++n) { const int c = col0 + bj * HALF + n * 16; const f32x4 v = acc[ai][bj][m][n];
                        if (!isv) { __builtin_nontemporal_store(v, (f32x4*)(outk + (size_t)r * 2048 + c)); u32x2 w; w.x = cvt_pk_bf16(v[0], v[1]); w.y = cvt_pk_bf16(v[2], v[3]); *(u32x2*)(mkb + (size_t)r * 2048 + c) = w; }
                        else { __builtin_nontemporal_store(v, (f32x4*)(outv + (size_t)r * 2048 + c)); const unsigned w0 = cvt_pk_bf16(v[0], v[1]), w1 = cvt_pk_bf16(v[2], v[3]);
                            bf16_t* tp = mvt + ((size_t)(bb * 2048 + c)) * 256 + pos;
                            tp[0] = (bf16_t)(w0 & 0xffffu); tp[256] = (bf16_t)(w0 >> 16); tp[512] = (bf16_t)(w1 & 0xffffu); tp[768] = (bf16_t)(w1 >> 16); } } }
    }
};

template <bool RESBF, bool HG, bool OUTF> struct EpiRes {
    static constexpr bool PERM = true, AFTER_DRAIN = false;
    const float* res0; const float* res1; int split; const bf16_t* resb; const float* rgain; float* hout; bf16_t* hg; const float* gain; float* ssq;
    __device__ __forceinline__ void operator()(const f32x4 (&acc)[2][2][4][2], const Unit& u, int wr, int wc, int fr, int fq) const {
        const int row0 = u.pm * BM + wr * 64 + fr, col0 = u.pn * BM + wc * 32 + 8 * fq;
        float ss[2][4];
#pragma unroll
        for (int ai = 0; ai < 2; ++ai)
#pragma unroll
            for (int m = 0; m < 4; ++m) ss[ai][m] = 0.f;
#pragma unroll
        for (int bj = 0; bj < 2; ++bj) { const int c = col0 + bj * HALF;
            f32x4 g0, g1, q0, q1;
            if (HG) { g0 = *(const f32x4*)(gain + c); g1 = *(const f32x4*)(gain + c + 4); }
            if (RESBF) { q0 = *(const f32x4*)(rgain + c); q1 = *(const f32x4*)(rgain + c + 4);
#pragma unroll
                for (int j = 0; j < 4; ++j) { q0[j] = 1.0f / q0[j]; q1[j] = 1.0f / q1[j]; } }
#pragma unroll
            for (int ai = 0; ai < 2; ++ai) {
                u32x4 rw[4]; f32x4 ra[4], rb[4];
#pragma unroll
                for (int m = 0; m < 4; ++m) { const int r = row0 + ai * HALF + m * 16;
                    if (RESBF) rw[m] = *(const u32x4*)(resb + (size_t)r * 2048 + c);
                    else { const float* rp = (r < split ? res0 + (size_t)r * 2048 : res1 + (size_t)(r - split) * 2048) + c; ra[m] = __builtin_nontemporal_load((const f32x4*)rp); rb[m] = __builtin_nontemporal_load((const f32x4*)(rp + 4)); } }
#pragma unroll
                for (int m = 0; m < 4; ++m) { const int r = row0 + ai * HALF + m * 16;
                    f32x4 h0, h1;
                    if (RESBF) { const u32x4 w = rw[m];
                        h0 = (f32x4){__uint_as_float(w.x << 16), __uint_as_float(w.x & 0xffff0000u), __uint_as_float(w.y << 16), __uint_as_float(w.y & 0xffff0000u)} * q0 + acc[ai][bj][m][0];
                        h1 = (f32x4){__uint_as_float(w.z << 16), __uint_as_float(w.z & 0xffff0000u), __uint_as_float(w.w << 16), __uint_as_float(w.w & 0xffff0000u)} * q1 + acc[ai][bj][m][1]; }
                    else { h0 = ra[m] + acc[ai][bj][m][0]; h1 = rb[m] + acc[ai][bj][m][1]; }
                    ss[ai][m] += (h0[0] * h0[0] + h0[1] * h0[1]) + (h0[2] * h0[2] + h0[3] * h0[3]) + (h1[0] * h1[0] + h1[1] * h1[1]) + (h1[2] * h1[2] + h1[3] * h1[3]);
                    if (OUTF) { float* hp = hout + (size_t)r * 2048 + c; *(f32x4*)hp = h0; *(f32x4*)(hp + 4) = h1; }
                    if (HG) *(u32x4*)(hg + (size_t)r * 2048 + c) = pack8(h0 * g0, h1 * g1); }
                __builtin_amdgcn_sched_barrier(0); } }
#pragma unroll
        for (int ai = 0; ai < 2; ++ai)
#pragma unroll
            for (int m = 0; m < 4; ++m) { float s = ss[ai][m]; s += __shfl_xor(s, 16); s += __shfl_xor(s, 32);
                if (fq == 0) ssq[(size_t)(row0 + ai * HALF + m * 16) * 32 + u.pn * 4 + wc] = s; }
    }
};

template <bool FFN> struct EpiScale {
    static constexpr bool PERM = true, AFTER_DRAIN = false;
    bf16_t* O; int ldc; const float* ssq; float scale; float* ffn_p; float* ffn_s;
    __device__ __forceinline__ void operator()(const f32x4 (&acc)[2][2][4][2], const Unit& u, int wr, int wc, int fr, int fq) const {
        const int row0 = u.pm * BM + wr * 64 + fr, col0 = u.pn * BM + wc * 32 + 8 * fq;
#pragma unroll
        for (int ai = 0; ai < 2; ++ai)
#pragma unroll
            for (int m = 0; m < 4; ++m) { const int r = row0 + ai * HALF + m * 16;
                const f32x4* sp = (const f32x4*)(ssq + (size_t)r * 32 + fq * 8); const f32x4 p0 = sp[0], p1 = sp[1];
                float s = ((p0[0] + p0[1]) + (p0[2] + p0[3])) + ((p1[0] + p1[1]) + (p1[2] + p1[3]));
                s += __shfl_xor(s, 16); s += __shfl_xor(s, 32);
                const float rs = rsqrtf(s * (1.0f / 2048.0f) + 1e-6f) * scale;
                bf16_t* rowp = O + (size_t)r * ldc + col0;
                float* dst = nullptr;
                if (FFN && u.pn < 22) {
                    if (r < 8192) { const int t = r & 2047; if (t >= 2046) dst = ffn_p + (size_t)((r >> 11) * 2 + (t - 2046)) * 5632; }
                    else { const int rr = r - 8192, t = rr & 3; if (t >= 2) dst = ffn_s + (size_t)((rr >> 2) * 2 + (t - 2)) * 5632; } }
#pragma unroll
                for (int bj = 0; bj < 2; ++bj) { const f32x4 v0 = acc[ai][bj][m][0] * rs, v1 = acc[ai][bj][m][1] * rs;
                    *(u32x4*)(rowp + bj * HALF) = pack8(v0, v1);
                    if (FFN) { if (dst) { *(f32x4*)(dst + col0 + bj * HALF) = v0; *(f32x4*)(dst + col0 + bj * HALF + 4) = v1; } } } }
    }
};

struct EpiFfn {
    static constexpr bool PERM = true, AFTER_DRAIN = false;
    bf16_t* act; bf16_t* GU; const float* ssq; const float* cw; const float* cb; float* ffn_p; float* ffn_s;
    template <int N> __device__ __forceinline__ static float ror(float x) { return __int_as_float(__builtin_amdgcn_update_dpp(0, __float_as_int(x), 0x120 + N, 0xf, 0xf, false)); }
    template <int N> __device__ __forceinline__ static f32x4 rot(const f32x4 v) { f32x4 r; r[0] = ror<N>(v[0]); r[1] = ror<N>(v[1]); r[2] = ror<N>(v[2]); r[3] = ror<N>(v[3]); return r; }
    __device__ __forceinline__ void operator()(const f32x4 (&acc)[2][2][4][2], const Unit& u, int wr, int wc, int fr, int fq) const {
        const int row0 = u.pm * BM + wr * 64 + fr, ch0 = u.pn * 128 + wc * 32 + 8 * fq;
        if (u.pm >= 32) {
#pragma unroll
            for (int ai = 0; ai < 2; ++ai)
#pragma unroll
                for (int m = 0; m < 4; ++m) { const int r = row0 + ai * HALF + m * 16;
                    const f32x4* sp = (const f32x4*)(ssq + (size_t)r * 32); float s = 0.f;
#pragma unroll
                    for (int i = 0; i < 8; ++i) { const f32x4 v = sp[i]; s += (v[0] + v[1]) + (v[2] + v[3]); }
                    const float rs = rsqrtf(s * (1.0f / 2048.0f) + 1e-6f);
                    const f32x4 g0 = acc[ai][0][m][0] * rs, g1 = acc[ai][0][m][1] * rs;
                    *(u32x4*)(GU + (size_t)r * 11264 + ch0) = pack8(g0, g1); *(u32x4*)(GU + (size_t)r * 11264 + 5632 + ch0) = pack8(acc[ai][1][m][0] * rs, acc[ai][1][m][1] * rs);
                    const int rr = r - 8192, t = rr & 3;
                    if (t >= 2) { float* dst = ffn_s + (size_t)((rr >> 2) * 2 + (t - 2)) * 5632 + ch0; *(f32x4*)dst = g0; *(f32x4*)(dst + 4) = g1; } }
            return; }
        float rsv[2][4];
#pragma unroll
        for (int ai = 0; ai < 2; ++ai)
#pragma unroll
            for (int m = 0; m < 4; ++m) { const f32x4* sp = (const f32x4*)(ssq + (size_t)(row0 + ai * HALF + m * 16) * 32 + fq * 8); const f32x4 v0 = sp[0], v1 = sp[1];
                float s = ((v0[0] + v0[1]) + (v0[2] + v0[3])) + ((v1[0] + v1[1]) + (v1[2] + v1[3]));
                s += __shfl_xor(s, 16); s += __shfl_xor(s, 32);
                rsv[ai][m] = rsqrtf(s * (1.0f / 2048.0f) + 1e-6f); }
#pragma unroll
        for (int n = 0; n < 2; ++n) { const int ch = ch0 + 4 * n;
            const f32x4 w0 = *(const f32x4*)(cw + ch), w1 = *(const f32x4*)(cw + 5632 + ch), w2 = *(const f32x4*)(cw + 11264 + ch), bz = *(const f32x4*)(cb + ch);
#pragma unroll
            for (int ai = 0; ai < 2; ++ai) {
                f32x4 q1, q2;
#pragma unroll
                for (int m = 0; m < 4; ++m) { const int r = row0 + ai * HALF + m * 16; const float rs = rsv[ai][m];
                    const f32x4 g = acc[ai][0][m][n] * rs, uu = acc[ai][1][m][n] * rs;
                    const f32x4 r1 = rot<1>(g), r2 = rot<2>(g);
                    f32x4 p1 = r1, p2 = r2;
                    if (m > 0) { if (fr < 1) p1 = q1; if (fr < 2) p2 = q2; }
                    q1 = r1; q2 = r2;
                    u32x2 w;
                    if (m == 0 && fr < 2) {
                        w.x = cvt_pk_bf16(g[0], g[1]); w.y = cvt_pk_bf16(g[2], g[3]); *(u32x2*)(GU + (size_t)r * 11264 + ch) = w;
                        w.x = cvt_pk_bf16(uu[0], uu[1]); w.y = cvt_pk_bf16(uu[2], uu[3]); *(u32x2*)(GU + (size_t)r * 11264 + 5632 + ch) = w; }
                    else {
                        const f32x4 x = w0 * p2 + w1 * p1 + w2 * g + bz; f32x4 o;
#pragma unroll
                        for (int j = 0; j < 4; ++j) o[j] = x[j] * __builtin_amdgcn_rcpf(1.0f + __expf(-x[j])) * uu[j];
                        w.x = cvt_pk_bf16(o[0], o[1]); w.y = cvt_pk_bf16(o[2], o[3]); *(u32x2*)(act + (size_t)r * 5632 + ch) = w; }
                    if (m == 3 && fr >= 14) {
                        w.x = cvt_pk_bf16(g[0], g[1]); w.y = cvt_pk_bf16(g[2], g[3]); *(u32x2*)(GU + (size_t)r * 11264 + ch) = w;
                        const int t = r & 2047; if (t >= 2046) *(f32x4*)(ffn_p + (size_t)((r >> 11) * 2 + (t - 2046)) * 5632 + ch) = g; }
                    __builtin_amdgcn_sched_barrier(0); } } }
    }
};

template <class Epi, class Sched, bool STAMP = false>
__device__ __forceinline__ void gemm_phase(PG8_LAS unsigned char* lds, const Gemm g, const Sched& S, const Epi& E, unsigned long long* stamps) {
    const int tid = ::tid_opq(), wid = __builtin_amdgcn_readfirstlane(tid >> 6), lane = tid & 63, wr = wid >> 2, wc = wid & 3, fr = lane & 15, fq = lane >> 4;
    const int K = g.K, nt = K / BK;
    int ts_lo = 0, ts_hi = 0, nts = 0; const unsigned long long rt_entry = STAMP ? (unsigned long long)wall_clock64() : 0ull;
#define PG8_STAMP() do { if (STAMP && wid == 0 && nts < 64) { const unsigned long long _c = (unsigned long long)clock64(); \
        ts_lo = (lane == nts) ? (int)(unsigned)_c : ts_lo; ts_hi = (lane == nts) ? (int)(unsigned)(_c >> 32) : ts_hi; ++nts; } } while (0)
    PG8_STAMP();
    unsigned voffA[2], voffB[2];
#pragma unroll
    for (int i = 0; i < 2; ++i) { int R, C; stage_rc(tid * 16 + i * 8192, R, C); const int Rb = Epi::PERM ? ((R & ~31) + perm32(R & 31)) : R;
        voffA[i] = (unsigned)(R * K + C) * 2u; voffB[i] = (unsigned)(Rb * K + C) * 2u; }
    const size_t kstep = (size_t)(BK * 2);
    const size_t hstep = (size_t)HALF * K * 2;
    const size_t tstep = 2 * hstep;
    const unsigned ldsw = (unsigned)wid * 1024u;
    const int aoff = lds_byte(wr * 64 + fr, fq * 8), boff = lds_byte(wc * 32 + fr, fq * 8);
#define PG8_SA(b, h) (((b) * 2 + (h)) * HTB)
#define PG8_SB(b, h) ((4 + (b) * 2 + (h)) * HTB)
#define PG8_STAGE(bufoff, gbase, voff) do { _Pragma("unroll") for (int _i = 0; _i < 2; ++_i) \
        __builtin_amdgcn_global_load_lds((const unsigned*)((const char*)(gbase) + (voff)[_i]), (PG8_LAS unsigned*)(lds + (bufoff) + ldsw + _i * 8192), 16, 0, 0); } while (0)
#define PG8_LDA(dst, b, h) do { _Pragma("unroll") for (int m = 0; m < 4; ++m) _Pragma("unroll") for (int k = 0; k < 2; ++k) dst[m][k] = *(const PG8_LAS bf16x8*)(lds + PG8_SA(b, h) + aoff + m * 2048 + k * 1024); } while (0)
#define PG8_LDB(dst, b, h) do { _Pragma("unroll") for (int n = 0; n < 2; ++n) _Pragma("unroll") for (int k = 0; k < 2; ++k) dst[n][k] = *(const PG8_LAS bf16x8*)(lds + PG8_SB(b, h) + boff + n * 2048 + k * 1024); } while (0)
#define PG8_MMA(ai, bj, At, Bt) do { __builtin_amdgcn_s_setprio(1); _Pragma("unroll") for (int m = 0; m < 4; ++m) _Pragma("unroll") for (int n = 0; n < 2; ++n) _Pragma("unroll") for (int k = 0; k < 2; ++k) \
        acc[ai][bj][m][n] = __builtin_amdgcn_mfma_f32_16x16x32_bf16(Bt[n][k], At[m][k], acc[ai][bj][m][n], 0, 0, 0); __builtin_amdgcn_s_setprio(0); } while (0)
#define PG8_WAIT_V(n) asm volatile("s_waitcnt vmcnt(" #n ")" ::: "memory")
#define PG8_WAIT_L(n) asm volatile("s_waitcnt lgkmcnt(" #n ")" ::: "memory")
#define PG8_BAR __builtin_amdgcn_s_barrier()
#define PG8_SCHED __builtin_amdgcn_sched_barrier(0)
    Unit cur, nxt; int ui = 0;
    if (!S.next(0, cur)) return;
    f32x4 acc[2][2][4][2];
#pragma unroll
    for (int a = 0; a < 2; ++a)
#pragma unroll
        for (int b = 0; b < 2; ++b)
#pragma unroll
            for (int m = 0; m < 4; ++m)
#pragma unroll
                for (int n = 0; n < 2; ++n) acc[a][b][m][n] = (f32x4){0.f, 0.f, 0.f, 0.f};
    bf16x8 At[4][2], B0[2][2], B1[2][2];
    const char* cA = (const char*)g.A + (size_t)cur.pm * tstep; const char* cB = (const char*)g.Bt + (size_t)cur.pn * tstep;
    S.a_ready(cur);
    PG8_STAGE(PG8_SB(0, 0), cB, voffB); PG8_STAGE(PG8_SA(0, 0), cA, voffA); PG8_STAGE(PG8_SB(0, 1), cB + hstep, voffB); PG8_STAGE(PG8_SA(0, 1), cA + hstep, voffA);
    if (wr == 1) PG8_BAR;
    PG8_WAIT_V(4); PG8_BAR;
    PG8_STAGE(PG8_SB(1, 0), cB + kstep, voffB); PG8_STAGE(PG8_SA(1, 0), cA + kstep, voffA); PG8_STAGE(PG8_SB(1, 1), cB + hstep + kstep, voffB);
    PG8_WAIT_V(6); PG8_BAR;
    PG8_STAMP();
    for (;;) {
        const bool has_next = S.next(ui + 1, nxt);
        const char* nA = has_next ? (const char*)g.A + (size_t)nxt.pm * tstep : cA; const char* nB = has_next ? (const char*)g.Bt + (size_t)nxt.pn * tstep : cB;
        for (int t = 0; t < nt; t += 2) {
            const bool last = (t == nt - 2);
            const char* a1 = cA + (size_t)(t + 1) * kstep;
            const char* a2 = last ? nA : cA + (size_t)(t + 2) * kstep; const char* b2 = last ? nB : cB + (size_t)(t + 2) * kstep;
            const char* a3 = a2 + kstep; const char* b3 = b2 + kstep;
            if (last && has_next) S.a_ready(nxt);
            PG8_LDB(B0, 0, 0); PG8_SCHED; PG8_LDA(At, 0, 0); PG8_STAGE(PG8_SA(1, 1), a1 + hstep, voffA);
            PG8_WAIT_L(8); PG8_BAR; PG8_WAIT_L(0); PG8_MMA(0, 0, At, B0); PG8_BAR; PG8_SCHED;
            PG8_LDB(B1, 0, 1); PG8_STAGE(PG8_SB(0, 0), b2, voffB);
            PG8_BAR; PG8_WAIT_L(0); PG8_MMA(0, 1, At, B1); PG8_BAR;
            PG8_LDA(At, 0, 1); PG8_STAGE(PG8_SA(0, 0), a2, voffA);
            PG8_BAR; PG8_WAIT_L(0); PG8_MMA(1, 0, At, B0); PG8_BAR; PG8_SCHED;
            PG8_STAGE(PG8_SB(0, 1), b2 + hstep, voffB);
            PG8_WAIT_V(6); PG8_BAR; PG8_MMA(1, 1, At, B1); PG8_BAR;
            PG8_LDB(B0, 1, 0); PG8_SCHED; PG8_LDA(At, 1, 0); PG8_STAGE(PG8_SA(0, 1), a2 + hstep, voffA);
            PG8_WAIT_L(8); PG8_BAR; PG8_WAIT_L(0); PG8_MMA(0, 0, At, B0); PG8_BAR; PG8_SCHED;
            PG8_LDB(B1, 1, 1); PG8_STAGE(PG8_SB(1, 0), b3, voffB);
            PG8_BAR; PG8_WAIT_L(0); PG8_MMA(0, 1, At, B1); PG8_BAR;
            PG8_LDA(At, 1, 1); PG8_STAGE(PG8_SA(1, 0), a3, voffA);
            PG8_BAR; PG8_WAIT_L(0); PG8_MMA(1, 0, At, B0); PG8_BAR; PG8_SCHED;
            PG8_STAGE(PG8_SB(1, 1), b3 + hstep, voffB);
            PG8_WAIT_V(6); PG8_BAR; PG8_MMA(1, 1, At, B1); PG8_BAR;
        }
        PG8_STAMP();
        if constexpr (!Epi::AFTER_DRAIN) { E(acc, cur, wr, wc, fr, fq); S.done(cur); }
        PG8_STAMP();
        if (!has_next) break;
#pragma unroll
        for (int a = 0; a < 2; ++a)
#pragma unroll
            for (int b = 0; b < 2; ++b)
#pragma unroll
                for (int m = 0; m < 4; ++m)
#pragma unroll
                    for (int n = 0; n < 2; ++n) acc[a][b][m][n] = (f32x4){0.f, 0.f, 0.f, 0.f};
        cur = nxt; cA = nA; cB = nB; ++ui;
    }
    PG8_WAIT_V(0);
    if (wr == 0) PG8_BAR;
    PG8_BAR;
    if constexpr (Epi::AFTER_DRAIN) { E.fused(acc, cur, wr, wc, fr, fq, lds, wid, lane); S.done(cur); }
    PG8_STAMP();
    if (STAMP && wid == 0) { stamps[lane] = lane < nts ? (((unsigned long long)(unsigned)ts_hi << 32) | (unsigned)ts_lo) : 0ull;
        if (lane == 62) stamps[62] = rt_entry; if (lane == 63) stamps[63] = (unsigned long long)wall_clock64(); }
#undef PG8_STAMP
#undef PG8_SA
#undef PG8_SB
#undef PG8_STAGE
#undef PG8_LDA
#undef PG8_LDB
#undef PG8_MMA
#undef PG8_WAIT_V
#undef PG8_WAIT_L
#undef PG8_BAR
#undef PG8_SCHED
}
}
#define XB_TMO      128
#define XB_XCNT(j)  (256  + 64 * (j))
#define XB_XSUB(j)  (1280 + 64 * (j))
#define XB_XGEN(j)  (2304 + 64 * (j))
#define XB_TOP      3328
#define XB_TOPGEN   3392
#define XCD_BAR_WORDS 3456
#define XB_SPIN_CAP (1u << 18)
#define LAS __attribute__((address_space(3)))

__device__ __forceinline__ unsigned xb_ld(unsigned* p)              { return __hip_atomic_load(p, __ATOMIC_RELAXED, __HIP_MEMORY_SCOPE_AGENT); }
__device__ __forceinline__ unsigned xb_add(unsigned* p, unsigned v) { return __hip_atomic_fetch_add(p, v, __ATOMIC_RELAXED, __HIP_MEMORY_SCOPE_AGENT); }
__device__ __forceinline__ unsigned xb_xcc_id() { return (unsigned)__builtin_amdgcn_s_getreg((3 << 11) | 20) & 0xFu; }
#define XB_SPIN(cond, bar) do { unsigned _sp = 0; while (cond) { __builtin_amdgcn_s_sleep(1); \
    if ((++_sp & 255u) == 0u) { if (xb_ld(&(bar)[XB_TMO])) break; if (_sp > XB_SPIN_CAP) { atomicAdd(&(bar)[XB_TMO], 1u); break; } } } } while (0)

struct XcdBarrier {
    unsigned* bar; unsigned x;
    volatile LAS unsigned* st;
};

__device__ __forceinline__ XcdBarrier xcd_barrier_post(unsigned* bar, volatile LAS unsigned* st) {
    XcdBarrier b; b.bar = bar; b.x = xb_xcc_id(); b.st = st;
    if (threadIdx.x == 0) (void)xb_add(&bar[XB_XCNT(b.x)], 1u);
    return b;
}
__device__ __forceinline__ void xcd_barrier_complete(unsigned* bar, unsigned x, unsigned& nloc, unsigned& nx) {
    const unsigned G = gridDim.x * gridDim.y * gridDim.z;
    unsigned sum, cnt, mine, sp = 0u;
    for (;;) {
        sum = 0u; cnt = 0u; mine = 0u;
#pragma unroll
        for (unsigned j = 0; j < 16; ++j) { const unsigned c = xb_ld(&bar[XB_XCNT(j)]); sum += c; cnt += (c > 0u) ? 1u : 0u; mine = (j == x) ? c : mine; }
        if (sum == G) break;
        __builtin_amdgcn_s_sleep(1);
        if ((++sp & 255u) == 0u) { if (xb_ld(&bar[XB_TMO])) break; if (sp > XB_SPIN_CAP) { atomicAdd(&bar[XB_TMO], 1u); break; } }
    }
    nloc = mine > 0u ? mine : 1u; nx = cnt > 0u ? cnt : 1u;
}

__device__ __forceinline__ void xcd_barrier(const XcdBarrier& b) {
    asm volatile("s_waitcnt vmcnt(0)" ::: "memory");
    __syncthreads();
    if (threadIdx.x == 0) {
        unsigned* bar = b.bar;
        __builtin_amdgcn_s_waitcnt(0);
        unsigned nloc = b.st[0], nx = b.st[1];
        if (nloc == 0u) { xcd_barrier_complete(bar, b.x, nloc, nx); b.st[0] = nloc; b.st[1] = nx; }
        const unsigned old = xb_add(&bar[XB_XSUB(b.x)], 1u);
        const unsigned gen = old / nloc;
        if (old + 1u == (gen + 1u) * nloc) {
            __builtin_amdgcn_fence(__ATOMIC_RELEASE, "agent");
            asm volatile("s_waitcnt vmcnt(0)" ::: "memory");
            const unsigned og = xb_add(&bar[XB_TOP], 1u);
            const unsigned tg = og / nx;
            if (og + 1u == (tg + 1u) * nx) xb_add(&bar[XB_TOPGEN], 1u);
            else XB_SPIN(xb_ld(&bar[XB_TOPGEN]) == tg, bar);
            __builtin_amdgcn_fence(__ATOMIC_ACQUIRE, "agent");
            xb_add(&bar[XB_XGEN(b.x)], 1u);
            asm volatile("s_waitcnt vmcnt(0)" ::: "memory");
        } else {
            XB_SPIN(xb_ld(&bar[XB_XGEN(b.x)]) == gen, bar);
            __builtin_amdgcn_fence(__ATOMIC_ACQUIRE, "agent");
            asm volatile("s_waitcnt vmcnt(0)" ::: "memory");
        }
    }
    __syncthreads();
}

using pg8::bf16_t; using pg8::f32x4; using pg8::u32x4; using pg8::u32x2; using pg8::bf16x8;
constexpr int D = 2048, MP = 8192, MSAMP = 512, MROWS = 8704, NINP = 6400, NIN = 6160, DFF = 5632;
constexpr int C_BG = 0, C_CG = 1024, C_VC = 2048, C_Q = 3072, C_K = 3584, C_V = 4096, C_R = 5120, C_G1 = 6144;
constexpr size_t al256(size_t x) { return (x + 255) & ~(size_t)255; }
constexpr size_t WS_WT_IN = 0;
constexpr size_t WS_WT_OUT = WS_WT_IN + al256((size_t)NINP * D * 2);
constexpr size_t WS_WT_XQ = WS_WT_OUT + al256((size_t)D * D * 2);
constexpr size_t WS_WT_XO = WS_WT_XQ + al256((size_t)D * D * 2);
constexpr size_t WS_WT_XKV = WS_WT_XO + al256((size_t)D * D * 2);
constexpr size_t WS_WT_FGU = WS_WT_XKV + al256((size_t)2 * D * D * 2);
constexpr size_t WS_WT_FD = WS_WT_FGU + al256((size_t)2 * DFF * D * 2);
constexpr size_t WS_XN = WS_WT_FD + al256((size_t)D * DFF * 2);
constexpr size_t WS_MEMN = WS_XN + al256((size_t)MROWS * D * 2);
constexpr size_t WS_PROJ = WS_MEMN + al256((size_t)1024 * D * 2);
constexpr size_t WS_MIXIN = WS_PROJ + al256((size_t)MROWS * NINP * 2);
constexpr size_t WS_H = WS_MIXIN + al256((size_t)MROWS * D * 2);
constexpr size_t WS_HG = WS_H + al256((size_t)MROWS * D * 4);
constexpr size_t WS_MKB = WS_HG + al256((size_t)MROWS * D * 2);
constexpr size_t WS_MVT = WS_MKB + al256((size_t)1024 * D * 2);
constexpr size_t WS_OG = WS_MVT + al256((size_t)1024 * D * 2);
constexpr size_t WS_GU = WS_OG + al256((size_t)MP * 1024 * 4);
constexpr size_t WS_SSQ1 = WS_GU + al256((size_t)MROWS * 2 * DFF * 2);
constexpr size_t WS_SSQ2 = WS_SSQ1 + al256((size_t)MROWS * 32 * 4);
constexpr size_t WS_SSQ3 = WS_SSQ2 + al256((size_t)MROWS * 32 * 4);
constexpr size_t WS_F = WS_SSQ3 + al256((size_t)MROWS * 32 * 4);
constexpr size_t WS_BAR = WS_F + al256((size_t)MROWS * 512 * 4);
constexpr size_t WS_END = WS_BAR + al256((size_t)(XCD_BAR_WORDS + 64) * 4);
constexpr size_t O_Y = 0, O_CONV_P = 17825792, O_GLA_P = 17833984, O_FFN_P = 18358272, O_MK = 18403328, O_MV = 20500480, O_CONV_S = 22597632, O_GLA_S = 22859776, O_FFN_S = 39636992;
constexpr int LDS_BYTES = 147456;
constexpr size_t GL_SST_OFF = 67108864, GL_EL_OFF = 67108864 + 33554432;

struct Args { const float* in[28]; float* out; unsigned char* ws; };
enum { I_XP = 0, I_XS, I_MEM, I_CCONV, I_SGLA, I_CFFN, I_CMK, I_CMV, I_NMIX, I_WIN, I_CONVW, I_WG2, I_BG, I_GLAN, I_WOUT, I_NX, I_NMEM, I_WXQ, I_WXK, I_WXV, I_WXO, I_NF, I_WFG, I_WFU, I_FCW, I_FCB, I_WFD, I_NFIN };

__device__ __forceinline__ float bflo(unsigned w) { return __uint_as_float(w << 16); }
__device__ __forceinline__ float bfhi(unsigned w) { return __uint_as_float(w & 0xffff0000u); }
__device__ __forceinline__ float bf2f(bf16_t b) { return __uint_as_float(((unsigned)b) << 16); }
__device__ __forceinline__ bf16_t f2bf(float f) { unsigned u = __float_as_uint(f); u += 0x7FFFu + ((u >> 16) & 1u); return (bf16_t)(u >> 16); }
__device__ __forceinline__ float silu_f(float x) { return x / (1.0f + __expf(-x)); }
__device__ __forceinline__ float log_forget(float z) { const float ls = fminf(z, 0.f) - log1pf(__expf(-fabsf(z))); return ls * 0.0625f; }
template <int CTRL> __device__ __forceinline__ float dpp_f(float x) { return __int_as_float(__builtin_amdgcn_update_dpp(0, __float_as_int(x), CTRL, 0xf, 0xf, false)); }
__device__ __forceinline__ float rdl(float x, int l) { return __int_as_float(__builtin_amdgcn_readlane(__float_as_int(x), l)); }
__device__ __forceinline__ float wave_sum(float v) {
    v += dpp_f<0xB1>(v);
    v += dpp_f<0x4E>(v);
    v += dpp_f<0x141>(v);
    v += dpp_f<0x140>(v);
    return (rdl(v, 0) + rdl(v, 16)) + (rdl(v, 32) + rdl(v, 48)); }
__device__ __forceinline__ float wave_max(float v) {
    v = fmaxf(v, dpp_f<0xB1>(v)); v = fmaxf(v, dpp_f<0x4E>(v)); v = fmaxf(v, dpp_f<0x141>(v)); v = fmaxf(v, dpp_f<0x140>(v));
    return fmaxf(fmaxf(rdl(v, 0), rdl(v, 16)), fmaxf(rdl(v, 32), rdl(v, 48))); }
__device__ __forceinline__ void unpack8(const u32x4 w, float (&f)[8]) { f[0] = bflo(w.x); f[1] = bfhi(w.x); f[2] = bflo(w.y); f[3] = bfhi(w.y); f[4] = bflo(w.z); f[5] = bfhi(w.z); f[6] = bflo(w.w); f[7] = bfhi(w.w); }

constexpr int TT_WIN = 800, TT_SQ = 256, TT_FF = 704, TT_TOTAL = 800 + 5 * 256 + 3 * 704;
__device__ __forceinline__ void tr_decode(const Args& a, int gi, const float*& src, bf16_t*& dst, int& K, int& N, int& k0, int& n0, int& ilv) {
    unsigned char* ws = a.ws; int nkt; ilv = 0;
    if (gi < TT_WIN) { src = a.in[I_WIN]; dst = (bf16_t*)(ws + WS_WT_IN); K = D; N = NIN; nkt = 32; }
    else { gi -= TT_WIN;
        if (gi < 5 * TT_SQ) { const int j = gi >> 8; gi &= 255; K = D; N = D; nkt = 32;
            { const float* p0 = a.in[I_WXK]; const float* p1 = a.in[I_WXV]; const float* p2 = a.in[I_WOUT]; const float* p3 = a.in[I_WXQ]; const float* p4 = a.in[I_WXO];
              src = j == 0 ? p0 : j == 1 ? p1 : j == 2 ? p2 : j == 3 ? p3 : p4; }
            dst = (bf16_t*)(ws + (j <= 1 ? WS_WT_XKV : j == 2 ? WS_WT_OUT : j == 3 ? WS_WT_XQ : WS_WT_XO)) + (j == 1 ? (size_t)D * D : 0); }
        else { gi -= 5 * TT_SQ;
            if (gi < TT_FF) { src = a.in[I_WFG]; dst = (bf16_t*)(ws + WS_WT_FGU); K = D; N = DFF; nkt = 32; ilv = 1; }
            else if (gi < 2 * TT_FF) { gi -= TT_FF; src = a.in[I_WFU]; dst = (bf16_t*)(ws + WS_WT_FGU); K = D; N = DFF; nkt = 32; ilv = 2; }
            else { gi -= 2 * TT_FF; src = a.in[I_WFD]; dst = (bf16_t*)(ws + WS_WT_FD); K = DFF; N = D; nkt = 88; } } }
    k0 = (gi % nkt) * 64; n0 = (gi / nkt) * 256;
}
constexpr int TT_EARLY = TT_WIN + 2 * TT_SQ;
__device__ __forceinline__ void phase_transposes(const Args& a, float* tile, int lo, int hi, unsigned* ctr, volatile int* qslot) {
    const int tid = tid_opq(), r = tid >> 6, c4 = (tid & 63) * 4;
    int gi;
    if (ctr) { if (tid == 0) *qslot = lo + (int)atomicAdd(ctr, 1u); __syncthreads(); gi = *qslot; __syncthreads(); } else gi = lo + blockIdx.x;
    if (gi >= hi) return;
    const float* src; bf16_t* dst; int K, N, k0, n0, ilv; f32x4 v[8];
    tr_decode(a, gi, src, dst, K, N, k0, n0, ilv);
#pragma unroll
    for (int i = 0; i < 8; ++i) { v[i] = (f32x4){0.f, 0.f, 0.f, 0.f}; if (n0 + c4 < N) v[i] = __builtin_nontemporal_load((const f32x4*)(src + (size_t)(k0 + r + 8 * i) * N + n0 + c4)); }
    for (;;) {
#pragma unroll
        for (int i = 0; i < 8; ++i) { float* tp = tile + (r + 8 * i) * 257 + c4; tp[0] = v[i][0]; tp[1] = v[i][1]; tp[2] = v[i][2]; tp[3] = v[i][3]; }
        if (ctr && tid == 0) *qslot = lo + (int)atomicAdd(ctr, 1u);
        __syncthreads();
        const int nrow = n0 + (tid >> 1);
        bf16_t* cdst = dst + (size_t)(ilv ? ((nrow >> 7) * 256 + (nrow & 127) + (ilv == 2 ? 128 : 0)) : nrow) * K + k0 + (tid & 1) * 32;
        gi = ctr ? *qslot : gi + (int)gridDim.x; const bool more = gi < hi;
        if (more) { tr_decode(a, gi, src, dst, K, N, k0, n0, ilv);
#pragma unroll
            for (int i = 0; i < 8; ++i) { v[i] = (f32x4){0.f, 0.f, 0.f, 0.f}; if (n0 + c4 < N) v[i] = __builtin_nontemporal_load((const f32x4*)(src + (size_t)(k0 + r + 8 * i) * N + n0 + c4)); } }
        { const float* tp = tile + ((tid & 1) * 32) * 257 + (tid >> 1);
#pragma unroll
            for (int q = 0; q < 4; ++q) { u32x4 w; w.x = pg8::cvt_pk_bf16(tp[(q * 8 + 0) * 257], tp[(q * 8 + 1) * 257]); w.y = pg8::cvt_pk_bf16(tp[(q * 8 + 2) * 257], tp[(q * 8 + 3) * 257]);
                w.z = pg8::cvt_pk_bf16(tp[(q * 8 + 4) * 257], tp[(q * 8 + 5) * 257]); w.w = pg8::cvt_pk_bf16(tp[(q * 8 + 6) * 257], tp[(q * 8 + 7) * 257]);
                *(u32x4*)(cdst + q * 8) = w; } }
        __syncthreads();
        if (!more) break;
    }
}
__device__ __forceinline__ const float* prep_row_src(const Args& a, int row) { return row < MP ? a.in[I_XP] + (size_t)row * D : row < MROWS ? a.in[I_XS] + (size_t)(row - MP) * D : a.in[I_MEM] + (size_t)(row - MROWS) * D; }
__device__ __forceinline__ void phase_prep(const Args& a, float* lds) {
    unsigned char* ws = a.ws;
    phase_transposes(a, lds, 0, TT_EARLY, nullptr, nullptr);
    const int lane = tid_opq() & 63, gw = blockIdx.x * 8 + (tid_opq() >> 6), nw = gridDim.x * 8;
    int row = gw; if (row >= MROWS + 1024) return;
    f32x4 v[8];
    { const float* x = prep_row_src(a, row);
#pragma unroll
      for (int i = 0; i < 8; ++i) v[i] = __builtin_nontemporal_load((const f32x4*)(x + (i * 64 + lane) * 4)); }
    for (;;) {
        const int nrow = row + nw; const bool more = nrow < MROWS + 1024;
        f32x4 nv[8];
        if (more) { const float* x = prep_row_src(a, nrow);
#pragma unroll
            for (int i = 0; i < 8; ++i) nv[i] = __builtin_nontemporal_load((const f32x4*)(x + (i * 64 + lane) * 4)); }
        float ss = 0.f;
#pragma unroll
        for (int i = 0; i < 8; ++i) ss += (v[i][0] * v[i][0] + v[i][1] * v[i][1]) + (v[i][2] * v[i][2] + v[i][3] * v[i][3]);
        ss = wave_sum(ss); const float rs = rsqrtf(ss * (1.0f / 2048.0f) + 1e-6f);
        const float* gain = row < MROWS ? a.in[I_NMIX] : a.in[I_NMEM];
        bf16_t* o = row < MROWS ? (bf16_t*)(ws + WS_XN) + (size_t)row * D : (bf16_t*)(ws + WS_MEMN) + (size_t)(row - MROWS) * D;
#pragma unroll
        for (int i = 0; i < 8; ++i) { const f32x4 g = *(const f32x4*)(gain + (i * 64 + lane) * 4); u32x2 w; w.x = pg8::cvt_pk_bf16(v[i][0] * rs * g[0], v[i][1] * rs * g[1]); w.y = pg8::cvt_pk_bf16(v[i][2] * rs * g[2], v[i][3] * rs * g[3]);
            *(u32x2*)(o + (i * 64 + lane) * 4) = w; }
        if (!more) break;
#pragma unroll
        for (int i = 0; i < 8; ++i) v[i] = nv[i];
        row = nrow;
    }
}


__device__ __forceinline__ void gla_prompt_item(const Args& a, int item, float* lds) {
    const int tid = tid_opq(), b = item >> 6, h = (item >> 4) & 3, sl = item & 15;
    float* qs = lds; float* ks = qs + 4096; float* fs = ks + 4096; float* vs = fs + 4096; float* opart = vs + 512;
    const bf16_t* proj = (const bf16_t*)(a.ws + WS_PROJ) + (size_t)(b * 2048) * NINP;
    const float* Fg = (const float*)(a.ws + WS_F) + (size_t)(b * 2048) * 512 + h * 128;
    float* og = (float*)(a.ws + WS_OG);
    const int tt = tid >> 4, sub = tid & 15;
    const int dv = tid & 15, dkg = tid >> 4;
    float s0 = 0.f, s1 = 0.f, s2 = 0.f, s3 = 0.f;
    u32x4 rq, rk; f32x4 rf0, rf1; bf16_t rv;
    { const bf16_t* row = proj + (size_t)tt * NINP; rq = *(const u32x4*)(row + C_Q + h * 128 + sub * 8); rk = *(const u32x4*)(row + C_K + h * 128 + sub * 8);
      rf0 = *(const f32x4*)(Fg + (size_t)tt * 512 + sub * 8); rf1 = *(const f32x4*)(Fg + (size_t)tt * 512 + sub * 8 + 4); rv = row[C_V + h * 256 + sl * 16 + sub]; }
    for (int n = 0; n < 64; ++n) {
        { float qf[8], kf[8]; unpack8(rq, qf); unpack8(rk, kf);
            float* fp = fs + tt * 128 + sub * 8; float* qp = qs + tt * 128 + sub * 8; float* kp = ks + tt * 128 + sub * 8;
            *(f32x4*)fp = rf0; *(f32x4*)(fp + 4) = rf1;
            *(f32x4*)qp = (f32x4){qf[0], qf[1], qf[2], qf[3]} * 0.08838834764831845f; *(f32x4*)(qp + 4) = (f32x4){qf[4], qf[5], qf[6], qf[7]} * 0.08838834764831845f;
            *(f32x4*)kp = (f32x4){kf[0], kf[1], kf[2], kf[3]}; *(f32x4*)(kp + 4) = (f32x4){kf[4], kf[5], kf[6], kf[7]};
            vs[tt * 16 + sub] = bf2f(rv); }
        __syncthreads();
        if (n + 1 < 64) { const bf16_t* row = proj + (size_t)((n + 1) * 32 + tt) * NINP; rq = *(const u32x4*)(row + C_Q + h * 128 + sub * 8); rk = *(const u32x4*)(row + C_K + h * 128 + sub * 8);
            const float* fr_ = Fg + (size_t)((n + 1) * 32 + tt) * 512 + sub * 8; rf0 = *(const f32x4*)fr_; rf1 = *(const f32x4*)(fr_ + 4); rv = row[C_V + h * 256 + sl * 16 + sub]; }
#pragma unroll 8
        for (int t = 0; t < 32; ++t) {
            const f32x4 f4 = *(const f32x4*)(fs + t * 128 + dkg * 4), k4 = *(const f32x4*)(ks + t * 128 + dkg * 4), q4 = *(const f32x4*)(qs + t * 128 + dkg * 4); const float v = vs[t * 16 + dv];
            s0 = f4[0] * s0 + k4[0] * v; s1 = f4[1] * s1 + k4[1] * v; s2 = f4[2] * s2 + k4[2] * v; s3 = f4[3] * s3 + k4[3] * v;
            opart[dkg * 528 + t * 16 + dv] = (q4[0] * s0 + q4[1] * s1) + (q4[2] * s2 + q4[3] * s3); }
        __syncthreads();
        { float o = 0.f;
#pragma unroll 8
            for (int g = 0; g < 32; ++g) o += opart[g * 528 + tid];
            og[(size_t)(b * 2048 + n * 32 + (tid >> 4)) * 1024 + h * 256 + sl * 16 + (tid & 15)] = o; }
    }
    float* so = a.out + O_GLA_P + ((size_t)((b * 4 + h) * 128 + dkg * 4)) * 256 + sl * 16 + dv;
    so[0] = s0; so[256] = s1; so[512] = s2; so[768] = s3;
    __syncthreads();
}

__device__ __forceinline__ void gla_sample_item(const Args& a, int it, float* lds) {
    const int tid = tid_opq(), b = it >> 2, h = it & 3, lane = tid & 63, wid = tid >> 6;
    float* qs = lds; float* ks = qs + 512; float* fs = ks + 512; float* vs = fs + 512; float* red = vs + 1024; float* rsum = red + 512;
    const bf16_t* proj = (const bf16_t*)(a.ws + WS_PROJ) + (size_t)(MP + b * 4) * NINP;
    { const int t = tid >> 7, dk = tid & 127; const bf16_t* row = proj + (size_t)t * NINP;
        fs[tid] = __expf(((const float*)(a.ws + WS_F))[(size_t)(MP + b * 4 + t) * 512 + h * 128 + dk]); qs[tid] = bf2f(row[C_Q + h * 128 + dk]) * 0.08838834764831845f; ks[tid] = bf2f(row[C_K + h * 128 + dk]); }
#pragma unroll
    for (int i = 0; i < 2; ++i) { const int idx = tid + i * 512, t = idx >> 8, d = idx & 255; vs[idx] = bf2f(proj[(size_t)t * NINP + C_V + h * 256 + d]); }
    const int dv = tid & 255, half = tid >> 8;
    float s[64];
    const float* sp = a.in[I_SGLA] + ((size_t)((b * 4 + h) * 128 + half * 64)) * 256 + dv;
#pragma unroll
    for (int j = 0; j < 64; ++j) s[j] = __builtin_nontemporal_load(sp + (size_t)j * 256);
    __syncthreads();
    float ov[4];
#pragma unroll
    for (int t = 0; t < 4; ++t) { const float v = vs[t * 256 + dv]; float po = 0.f;
#pragma unroll
        for (int j = 0; j < 64; j += 4) { const f32x4 f4 = *(const f32x4*)(fs + t * 128 + half * 64 + j), k4 = *(const f32x4*)(ks + t * 128 + half * 64 + j), q4 = *(const f32x4*)(qs + t * 128 + half * 64 + j);
#pragma unroll
            for (int e = 0; e < 4; ++e) { s[j + e] = f4[e] * s[j + e] + k4[e] * v; po += q4[e] * s[j + e]; } }
        red[t * 512 + half * 256 + dv] = po; ov[t] = po; }
    float* so = a.out + O_GLA_S + ((size_t)((b * 4 + h) * 128 + half * 64)) * 256 + dv;
#pragma unroll
    for (int j = 0; j < 64; ++j) __builtin_nontemporal_store(s[j], so + (size_t)j * 256);
    __syncthreads();
    float* rs2 = red + 2048;
#pragma unroll
    for (int t = 0; t < 4; ++t) { const float o = red[t * 512 + dv] + red[t * 512 + 256 + dv]; ov[t] = o; const float ss = wave_sum(o * o); if (lane == 0) rs2[t * 8 + wid] = ss; }
    __syncthreads();
    if (half == 0) {
#pragma unroll
        for (int t = 0; t < 4; ++t) { const float tot = (rs2[t * 8] + rs2[t * 8 + 1]) + (rs2[t * 8 + 2] + rs2[t * 8 + 3]); const float rstd = rsqrtf(tot * (1.0f / 256.0f) + 1e-6f);
            const float rg = bf2f(proj[(size_t)t * NINP + C_R + h * 256 + dv]);
            ((bf16_t*)(a.ws + WS_MIXIN))[(size_t)(MP + b * 4 + t) * D + 1024 + h * 256 + dv] = f2bf(ov[t] * rstd * a.in[I_GLAN][h * 256 + dv] * silu_f(rg)); } }
    __syncthreads();
}

struct RowRaw { u32x4 bg[2], c0[2], v0[2], c1[2], v1[2], c2[2], v2[2], g1a, g1b; };
__device__ __forceinline__ void rows_pre_load(const bf16_t* __restrict__ projb, int row, int lane, RowRaw& R) {
    const bool samp = row >= MP; const int t = samp ? ((row - MP) & 3) : (row & 2047);
    const bf16_t* pr = projb + (size_t)row * NINP; const int b1 = t >= 1 ? NINP : 0, b2 = t >= 2 ? 2 * NINP : 0;
#pragma unroll
    for (int i = 0; i < 2; ++i) { const int c = i * 512 + lane * 8;
        R.bg[i] = *(const u32x4*)(pr + C_BG + c); R.c2[i] = *(const u32x4*)(pr + C_CG + c); R.v2[i] = *(const u32x4*)(pr + C_VC + c);
        R.c1[i] = *(const u32x4*)(pr - b1 + C_CG + c); R.v1[i] = *(const u32x4*)(pr - b1 + C_VC + c);
        R.c0[i] = *(const u32x4*)(pr - b2 + C_CG + c); R.v0[i] = *(const u32x4*)(pr - b2 + C_VC + c); }
    R.g1a = *(const u32x4*)(pr + C_G1); R.g1b = *(const u32x4*)(pr + C_G1 + 8);
}
__device__ __forceinline__ void rows_pre_compute(const Args& a, int row, int lane, const RowRaw& R) {
    bf16_t* mix = (bf16_t*)(a.ws + WS_MIXIN); const float* cw = a.in[I_CONVW];
    const bool samp = row >= MP; const int t = samp ? ((row - MP) & 3) : (row & 2047), bi = samp ? ((row - MP) >> 2) : (row >> 11);
#pragma unroll
    for (int i = 0; i < 2; ++i) { const int c = i * 512 + lane * 8;
        float bg[8], cgv[8], vcv[8], u2[8], u1[8], u0[8];
        unpack8(R.bg[i], bg); unpack8(R.c2[i], cgv); unpack8(R.v2[i], vcv);
#pragma unroll
        for (int j = 0; j < 8; ++j) u2[j] = cgv[j] * vcv[j];
        if (t >= 1) { unpack8(R.c1[i], cgv); unpack8(R.v1[i], vcv);
#pragma unroll
            for (int j = 0; j < 8; ++j) u1[j] = cgv[j] * vcv[j]; }
        else if (samp) { const float* cp = a.in[I_CCONV] + (size_t)(bi * 2 + 1) * 1024 + c;
#pragma unroll
            for (int j = 0; j < 8; ++j) u1[j] = cp[j]; }
        else {
#pragma unroll
            for (int j = 0; j < 8; ++j) u1[j] = 0.f; }
        if (t >= 2) { unpack8(R.c0[i], cgv); unpack8(R.v0[i], vcv);
#pragma unroll
            for (int j = 0; j < 8; ++j) u0[j] = cgv[j] * vcv[j]; }
        else if (samp) { const float* cp = a.in[I_CCONV] + (size_t)(bi * 2 + t) * 1024 + c;
#pragma unroll
            for (int j = 0; j < 8; ++j) u0[j] = cp[j]; }
        else {
#pragma unroll
            for (int j = 0; j < 8; ++j) u0[j] = 0.f; }
        float o[8];
#pragma unroll
        for (int j = 0; j < 8; ++j) o[j] = bg[j] * (cw[c + j] * u0[j] + cw[1024 + c + j] * u1[j] + cw[2048 + c + j] * u2[j]);
        u32x4 w; w.x = pg8::cvt_pk_bf16(o[0], o[1]); w.y = pg8::cvt_pk_bf16(o[2], o[3]); w.z = pg8::cvt_pk_bf16(o[4], o[5]); w.w = pg8::cvt_pk_bf16(o[6], o[7]);
        *(u32x4*)(mix + (size_t)row * D + c) = w;
        float* cn = nullptr;
        if (!samp) { if (t >= 2046) cn = a.out + O_CONV_P + (size_t)(bi * 2 + (t - 2046)) * 1024 + c; }
        else { if (t >= 2) cn = a.out + O_CONV_S + (size_t)(bi * 2 + (t - 2)) * 1024 + c; }
        if (cn) {
#pragma unroll
            for (int j = 0; j < 8; ++j) cn[j] = u2[j]; }
    }
    {
        float g1[16]; { float t8[8]; unpack8(R.g1a, t8);
#pragma unroll
            for (int j = 0; j < 8; ++j) g1[j] = t8[j];
            unpack8(R.g1b, t8);
#pragma unroll
            for (int j = 0; j < 8; ++j) g1[8 + j] = t8[j]; }
        f32x4 z0 = *(const f32x4*)(a.in[I_BG] + lane * 8), z1 = *(const f32x4*)(a.in[I_BG] + lane * 8 + 4);
#pragma unroll
        for (int r = 0; r < 16; ++r) { z0 += *(const f32x4*)(a.in[I_WG2] + r * 512 + lane * 8) * g1[r]; z1 += *(const f32x4*)(a.in[I_WG2] + r * 512 + lane * 8 + 4) * g1[r]; }
        f32x4 f0, f1;
#pragma unroll
        for (int j = 0; j < 4; ++j) { f0[j] = log_forget(z0[j]); f1[j] = log_forget(z1[j]); }
        float* fo = (float*)(a.ws + WS_F) + (size_t)row * 512 + lane * 8; *(f32x4*)fo = f0; *(f32x4*)(fo + 4) = f1; }
}
__device__ __forceinline__ void phase_rows_pre(const Args& a) {
    const int lane = tid_opq() & 63, wid = tid_opq() >> 6;
    const bf16_t* projb = (const bf16_t*)(a.ws + WS_PROJ);
    const int per = (MROWS + (int)gridDim.x - 1) / (int)gridDim.x, base = blockIdx.x * per, lim = (base + per < MROWS) ? base + per : MROWS;
    int row = base + wid; if (row >= lim) return;
    RowRaw cur; rows_pre_load(projb, row, lane, cur);
    for (;;) {
        const int nrow = row + 8; const bool more = nrow < lim;
        RowRaw nxt; if (more) rows_pre_load(projb, nrow, lane, nxt); else nxt = cur;
        rows_pre_compute(a, row, lane, cur);
        if (!more) break;
        cur = nxt; row = nrow;
    }
}
__device__ __forceinline__ void phase_gla_norm(const Args& a) {
    const int lane = tid_opq() & 63, gw = blockIdx.x * 8 + (tid_opq() >> 6), nw = gridDim.x * 8;
    const bf16_t* projb = (const bf16_t*)(a.ws + WS_PROJ); bf16_t* mix = (bf16_t*)(a.ws + WS_MIXIN);
    for (int row = gw; row < MP; row += nw) {
        const bf16_t* pr = projb + (size_t)row * NINP;
        {
            const float* og = (const float*)(a.ws + WS_OG) + (size_t)row * 1024;
#pragma unroll
            for (int h = 0; h < 4; ++h) { const f32x4 o4 = *(const f32x4*)(og + h * 256 + lane * 4);
                const float ss = wave_sum((o4[0] * o4[0] + o4[1] * o4[1]) + (o4[2] * o4[2] + o4[3] * o4[3])); const float rstd = rsqrtf(ss * (1.0f / 256.0f) + 1e-6f);
                const f32x4 gn = *(const f32x4*)(a.in[I_GLAN] + h * 256 + lane * 4); const u32x2 rw = *(const u32x2*)(pr + C_R + h * 256 + lane * 4);
                const float r0 = bflo(rw.x), r1 = bfhi(rw.x), r2 = bflo(rw.y), r3 = bfhi(rw.y);
                u32x2 w; w.x = pg8::cvt_pk_bf16(o4[0] * rstd * gn[0] * silu_f(r0), o4[1] * rstd * gn[1] * silu_f(r1)); w.y = pg8::cvt_pk_bf16(o4[2] * rstd * gn[2] * silu_f(r2), o4[3] * rstd * gn[3] * silu_f(r3));
                *(u32x2*)(mix + (size_t)row * D + 1024 + h * 256 + lane * 4) = w; }
        }
    }
}

constexpr int GL_LDK = 72, GL_LDQ = 136;
__device__ __forceinline__ void gla_cum(const float* __restrict__ lf_base, int d, int qt, float* part, float (&cum)[16], float& Lval) {
    float run = 0.f;
#pragma unroll
    for (int jj = 0; jj < 16; ++jj) { run += lf_base[(size_t)(qt * 16 + jj) * 512 + d]; cum[jj] = run; }
    part[qt * 128 + d] = run;
    __syncthreads();
    const float p0 = part[d], p1 = part[128 + d], p2 = part[256 + d], p3 = part[384 + d];
    const float off = (qt > 0 ? p0 : 0.f) + (qt > 1 ? p1 : 0.f) + (qt > 2 ? p2 : 0.f);
#pragma unroll
    for (int jj = 0; jj < 16; ++jj) cum[jj] += off;
    Lval = (p0 + p1) + (p2 + p3);
}
__device__ __forceinline__ void gla_stage_vt(const bf16_t* __restrict__ proj_rows, int h, bf16_t* VT, int tid) {
    const int v = tid & 255, jh = tid >> 8; const bf16_t* src = proj_rows + (size_t)(jh * 32) * NINP + C_V + h * 256 + v;
#pragma unroll
    for (int q = 0; q < 4; ++q) { unsigned w[4];
#pragma unroll
        for (int e = 0; e < 4; ++e) { const unsigned lo = src[(size_t)(q * 8 + 2 * e) * NINP], hi = src[(size_t)(q * 8 + 2 * e + 1) * NINP]; w[e] = lo | (hi << 16); }
        u32x4 ww; ww.x = w[0]; ww.y = w[1]; ww.z = w[2]; ww.w = w[3]; *(u32x4*)(VT + v * GL_LDK + jh * 32 + q * 8) = ww; }
}
__device__ __forceinline__ void gla_pass_a(const Args& a, int item, unsigned char* ldsb) {
    const int tid = tid_opq(), lane = tid & 63, wid = tid >> 6, fr = lane & 15, fq = lane >> 4;
    const int b = item >> 7, h = (item >> 5) & 3, n = item & 31, row0 = b * 2048 + n * 64;
    bf16_t* KlT = (bf16_t*)ldsb; bf16_t* VT = KlT + 128 * GL_LDK; float* part = (float*)(VT + 256 * GL_LDK);
    const bf16_t* prow = (const bf16_t*)(a.ws + WS_PROJ) + (size_t)row0 * NINP;
    { const int d = tid & 127, qt = tid >> 7; float cum[16], Lv;
        gla_cum((const float*)(a.ws + WS_F) + (size_t)row0 * 512 + h * 128, d, qt, part, cum, Lv);
        const bf16_t* kp = prow + (size_t)(qt * 16) * NINP + C_K + h * 128 + d; unsigned w[8];
#pragma unroll
        for (int e = 0; e < 8; ++e) { const float k0 = bf2f(kp[(size_t)(2 * e) * NINP]) * __expf(Lv - cum[2 * e]), k1 = bf2f(kp[(size_t)(2 * e + 1) * NINP]) * __expf(Lv - cum[2 * e + 1]); w[e] = pg8::cvt_pk_bf16(k0, k1); }
        u32x4 w0, w1; w0.x = w[0]; w0.y = w[1]; w0.z = w[2]; w0.w = w[3]; w1.x = w[4]; w1.y = w[5]; w1.z = w[6]; w1.w = w[7];
        *(u32x4*)(KlT + d * GL_LDK + qt * 16) = w0; *(u32x4*)(KlT + d * GL_LDK + qt * 16 + 8) = w1;
        if (qt == 0) ((float*)(a.ws + WS_GU + GL_EL_OFF))[(size_t)item * 128 + d] = __expf(Lv); }
    gla_stage_vt(prow, h, VT, tid);
    __syncthreads();
    { const bf16x8 x0 = *(const bf16x8*)(KlT + (wid * 16 + fr) * GL_LDK + fq * 8), x1 = *(const bf16x8*)(KlT + (wid * 16 + fr) * GL_LDK + 32 + fq * 8);
        float* kc = (float*)(a.ws + WS_GU) + (size_t)item * 32768 + wid * 16 + 4 * fq;
#pragma unroll 4
        for (int vt = 0; vt < 16; ++vt) { const bf16x8 y0 = *(const bf16x8*)(VT + (vt * 16 + fr) * GL_LDK + fq * 8), y1 = *(const bf16x8*)(VT + (vt * 16 + fr) * GL_LDK + 32 + fq * 8);
            f32x4 acc = (f32x4){0.f, 0.f, 0.f, 0.f};
            acc = __builtin_amdgcn_mfma_f32_16x16x32_bf16(x0, y0, acc, 0, 0, 0); acc = __builtin_amdgcn_mfma_f32_16x16x32_bf16(x1, y1, acc, 0, 0, 0);
            *(f32x4*)(kc + (size_t)(vt * 16 + fr) * 128) = acc; } }
    __syncthreads();
}
__device__ __forceinline__ void gla_pass_b(const Args& a) {
    const float* KC = (const float*)(a.ws + WS_GU); const float* EL = (const float*)(a.ws + WS_GU + GL_EL_OFF); bf16_t* SST = (bf16_t*)(a.ws + WS_GU + GL_SST_OFF);
    for (int gid = blockIdx.x * 512 + tid_opq(); gid < 131072; gid += gridDim.x * 512) {
        const int bh = gid >> 13, v = (gid >> 5) & 255, d4 = (gid & 31) * 4;
        f32x4 s = (f32x4){0.f, 0.f, 0.f, 0.f};
#pragma unroll 8
        for (int n = 0; n < 32; ++n) { const int item = bh * 32 + n;
            const f32x4 kc = *(const f32x4*)(KC + (size_t)item * 32768 + v * 128 + d4), el = *(const f32x4*)(EL + (size_t)item * 128 + d4);
            u32x2 w; w.x = pg8::cvt_pk_bf16(s[0], s[1]); w.y = pg8::cvt_pk_bf16(s[2], s[3]); *(u32x2*)(SST + (size_t)item * 32768 + v * 128 + d4) = w;
            s = el * s + kc; }
        float* so = a.out + O_GLA_P + ((size_t)(bh * 128 + d4)) * 256 + v; so[0] = s[0]; so[256] = s[1]; so[512] = s[2]; so[768] = s[3];
    }
}
__device__ __forceinline__ void gla_pass_c(const Args& a, int item, unsigned char* ldsb) {
    const int tid = tid_opq(), lane = tid & 63, wid = tid >> 6, fr = lane & 15, fq = lane >> 4;
    const int b = item >> 7, h = (item >> 5) & 3, n = item & 31, row0 = b * 2048 + n * 64;
    bf16_t* Qd = (bf16_t*)ldsb; bf16_t* Kd = Qd + 64 * GL_LDQ; bf16_t* VT = Kd + 64 * GL_LDQ; bf16_t* SS = VT + 256 * GL_LDK; float* part = (float*)(SS + 256 * GL_LDQ); float* red = part + 512;
    const bf16_t* sst = (const bf16_t*)(a.ws + WS_GU + GL_SST_OFF) + (size_t)item * 32768;
    u32x4 sr[8];
#pragma unroll
    for (int i = 0; i < 8; ++i) sr[i] = *(const u32x4*)(sst + (size_t)(tid + 512 * i) * 8);
    const bf16_t* prow = (const bf16_t*)(a.ws + WS_PROJ) + (size_t)row0 * NINP;
    { const int d = tid & 127, qt = tid >> 7; float cum[16], Lv;
        const bf16_t* qp = prow + (size_t)(qt * 16) * NINP + C_Q + h * 128 + d; const bf16_t* kp = qp + (C_K - C_Q);
        bf16_t qraw[16], kraw[16];
#pragma unroll
        for (int jj = 0; jj < 16; ++jj) { qraw[jj] = qp[(size_t)jj * NINP]; kraw[jj] = kp[(size_t)jj * NINP]; }
        const int vv = tid & 255, jh = tid >> 8; const bf16_t* vsrc = prow + (size_t)(jh * 32) * NINP + C_V + h * 256 + vv; unsigned vw[16];
#pragma unroll
        for (int e = 0; e < 16; ++e) { const unsigned lo = vsrc[(size_t)(2 * e) * NINP], hi = vsrc[(size_t)(2 * e + 1) * NINP]; vw[e] = lo | (hi << 16); }
        gla_cum((const float*)(a.ws + WS_F) + (size_t)row0 * 512 + h * 128, d, qt, part, cum, Lv);
#pragma unroll
        for (int jj = 0; jj < 16; ++jj) { const float e = __expf(cum[jj]);
            Qd[(qt * 16 + jj) * GL_LDQ + d] = f2bf(bf2f(qraw[jj]) * 0.08838834764831845f * e);
            Kd[(qt * 16 + jj) * GL_LDQ + d] = f2bf(bf2f(kraw[jj]) / e); }
#pragma unroll
        for (int q = 0; q < 4; ++q) { u32x4 ww; ww.x = vw[4 * q]; ww.y = vw[4 * q + 1]; ww.z = vw[4 * q + 2]; ww.w = vw[4 * q + 3]; *(u32x4*)(VT + vv * GL_LDK + jh * 32 + q * 8) = ww; } }
#pragma unroll
    for (int i = 0; i < 8; ++i) { const int id = tid + 512 * i; *(u32x4*)(SS + (id >> 4) * GL_LDQ + (id & 15) * 8) = sr[i]; }
    __syncthreads();
    const int it = wid >> 1, vh = wid & 1;
    bf16x8 qf[4];
#pragma unroll
    for (int ks = 0; ks < 4; ++ks) qf[ks] = *(const bf16x8*)(Qd + (it * 16 + fr) * GL_LDQ + ks * 32 + fq * 8);
    f32x4 aa[4];
#pragma unroll
    for (int jt = 0; jt < 4; ++jt) { f32x4 acc = (f32x4){0.f, 0.f, 0.f, 0.f};
        if (jt <= it) {
#pragma unroll
            for (int ks = 0; ks < 4; ++ks) { const bf16x8 kf = *(const bf16x8*)(Kd + (jt * 16 + fr) * GL_LDQ + ks * 32 + fq * 8); acc = __builtin_amdgcn_mfma_f32_16x16x32_bf16(kf, qf[ks], acc, 0, 0, 0); }
            if (jt == it) {
#pragma unroll
                for (int e = 0; e < 4; ++e) if (4 * fq + e > fr) acc[e] = 0.f; } }
        aa[jt] = acc; }
    bf16x8 pa[2];
#pragma unroll
    for (int s = 0; s < 2; ++s) { const u32x4 w = pg8::pack8(aa[2 * s], aa[2 * s + 1]); pa[s] = __builtin_bit_cast(bf16x8, w); }
    f32x4 o[8]; float ss = 0.f;
#pragma unroll
    for (int vt = 0; vt < 8; ++vt) { const int vrow = (vh * 8 + vt) * 16 + fr; f32x4 acc = (f32x4){0.f, 0.f, 0.f, 0.f};
#pragma unroll
        for (int s = 0; s < 2; ++s) { const u32x2 lo = *(const u32x2*)(VT + vrow * GL_LDK + 32 * s + 4 * fq), hi = *(const u32x2*)(VT + vrow * GL_LDK + 32 * s + 16 + 4 * fq);
            u32x4 w; w.x = lo.x; w.y = lo.y; w.z = hi.x; w.w = hi.y; acc = __builtin_amdgcn_mfma_f32_16x16x32_bf16(__builtin_bit_cast(bf16x8, w), pa[s], acc, 0, 0, 0); }
#pragma unroll
        for (int ks = 0; ks < 4; ++ks) { const bf16x8 sf = *(const bf16x8*)(SS + vrow * GL_LDQ + ks * 32 + fq * 8); acc = __builtin_amdgcn_mfma_f32_16x16x32_bf16(sf, qf[ks], acc, 0, 0, 0); }
        o[vt] = acc; ss += (acc[0] * acc[0] + acc[1] * acc[1]) + (acc[2] * acc[2] + acc[3] * acc[3]); }
    ss += __shfl_xor(ss, 16); ss += __shfl_xor(ss, 32);
    if (fq == 0) red[(it * 16 + fr) * 2 + vh] = ss;
    __syncthreads();
    { const float tot = red[(it * 16 + fr) * 2] + red[(it * 16 + fr) * 2 + 1]; const float rstd = rsqrtf(tot * (1.0f / 256.0f) + 1e-6f);
        const int row = row0 + it * 16 + fr; const bf16_t* rg = prow + (size_t)(it * 16 + fr) * NINP + C_R + h * 256; bf16_t* mo = (bf16_t*)(a.ws + WS_MIXIN) + (size_t)row * D + 1024 + h * 256;
#pragma unroll
        for (int vt = 0; vt < 8; ++vt) { const int v0 = (vh * 8 + vt) * 16 + 4 * fq; const f32x4 gn = *(const f32x4*)(a.in[I_GLAN] + h * 256 + v0); const u32x2 rw = *(const u32x2*)(rg + v0);
            u32x2 w; w.x = pg8::cvt_pk_bf16(o[vt][0] * rstd * gn[0] * silu_f(bflo(rw.x)), o[vt][1] * rstd * gn[1] * silu_f(bfhi(rw.x)));
            w.y = pg8::cvt_pk_bf16(o[vt][2] * rstd * gn[2] * silu_f(bflo(rw.y)), o[vt][3] * rstd * gn[3] * silu_f(bfhi(rw.y)));
            *(u32x2*)(mo + v0) = w; } }
    __syncthreads();
}

constexpr int XA_LDK = 136, XA_LDV = 264, XA_BUF = 128 * 264;
__device__ __forceinline__ void xattn_prompt_item(const Args& a, int it, unsigned char* ldsb) {
    const int tid = tid_opq(), lane = tid & 63, wid = tid >> 6, fr = lane & 15, fq = lane >> 4;
    const int b = it >> 6, h = (it >> 4) & 3, tt = it & 15;
    const int r0 = b * 2048 + tt * 128 + wid * 16;
    bf16_t* buf0 = (bf16_t*)ldsb; bf16_t* buf1 = buf0 + 34816;
    const bf16_t* qp = (const bf16_t*)(a.ws + WS_XN) + (size_t)(r0 + fr) * D + h * 512 + fq * 8;
    const bf16_t* kg = (const bf16_t*)(a.ws + WS_MKB) + (size_t)(b * 256) * D + h * 512;
    const bf16_t* vg = (const bf16_t*)(a.ws + WS_MVT) + (size_t)(b * 2048 + h * 512) * 256;
    u32x4 rs[8];
#pragma unroll
    for (int i = 0; i < 8; ++i) { const int id = tid + 512 * i, row = id >> 4, sg = id & 15; rs[i] = *(const u32x4*)(kg + (size_t)row * D + sg * 8); }
#pragma unroll
    for (int i = 0; i < 8; ++i) { const int id = tid + 512 * i, row = id >> 4, sg = id & 15; *(u32x4*)(buf0 + row * XA_LDK + sg * 8) = rs[i]; }
    __syncthreads();
    f32x4 st[16];
#pragma unroll
    for (int n = 0; n < 16; ++n) st[n] = (f32x4){0.f, 0.f, 0.f, 0.f};
#pragma unroll
    for (int c = 0; c < 4; ++c) {
        bf16_t* cur = (c & 1) ? buf1 : buf0; bf16_t* nxt = (c & 1) ? buf0 : buf1;
        if (c < 3) {
#pragma unroll
            for (int i = 0; i < 8; ++i) { const int id = tid + 512 * i, row = id >> 4, sg = id & 15; rs[i] = *(const u32x4*)(kg + (size_t)row * D + (c + 1) * 128 + sg * 8); } }
        else {
#pragma unroll
            for (int i = 0; i < 8; ++i) { const int id = tid + 512 * i, row = id >> 5, sg = id & 31; rs[i] = *(const u32x4*)(vg + (size_t)row * 256 + sg * 8); } }
        bf16x8 qf[4];
#pragma unroll
        for (int ks = 0; ks < 4; ++ks) qf[ks] = *(const bf16x8*)(qp + c * 128 + ks * 32);
#pragma unroll
        for (int n = 0; n < 16; ++n) {
#pragma unroll
            for (int ks = 0; ks < 4; ++ks) { const bf16x8 kf = *(const bf16x8*)(cur + (n * 16 + fr) * XA_LDK + ks * 32 + fq * 8); st[n] = __builtin_amdgcn_mfma_f32_16x16x32_bf16(kf, qf[ks], st[n], 0, 0, 0); } }
        if (c < 3) {
#pragma unroll
            for (int i = 0; i < 8; ++i) { const int id = tid + 512 * i, row = id >> 4, sg = id & 15; *(u32x4*)(nxt + row * XA_LDK + sg * 8) = rs[i]; } }
        else {
#pragma unroll
            for (int i = 0; i < 8; ++i) { const int id = tid + 512 * i, row = id >> 5, sg = id & 31; *(u32x4*)(nxt + row * XA_LDV + sg * 8) = rs[i]; } }
        __syncthreads();
    }
    float mx = -3.0e38f;
#pragma unroll
    for (int n = 0; n < 16; ++n) mx = fmaxf(fmaxf(fmaxf(st[n][0], st[n][1]), fmaxf(st[n][2], st[n][3])), mx);
    mx = fmaxf(mx, __shfl_xor(mx, 16)); mx = fmaxf(mx, __shfl_xor(mx, 32));
    float sum = 0.f;
#pragma unroll
    for (int n = 0; n < 16; ++n) {
#pragma unroll
        for (int e = 0; e < 4; ++e) { const float p = __expf(st[n][e] - mx); st[n][e] = p; sum += p; } }
    sum += __shfl_xor(sum, 16); sum += __shfl_xor(sum, 32);
    const float inv = 1.0f / sum;
    bf16x8 pf[8];
#pragma unroll
    for (int i = 0; i < 8; ++i) { u32x4 w = pg8::pack8(st[2 * i], st[2 * i + 1]); pf[i] = __builtin_bit_cast(bf16x8, w); }
    bf16_t* op = (bf16_t*)(a.ws + WS_MIXIN) + (size_t)(r0 + fr) * D + h * 512 + 4 * fq;
#pragma unroll
    for (int c = 0; c < 4; ++c) {
        bf16_t* cur = (c & 1) ? buf1 : buf0; bf16_t* nxt = (c & 1) ? buf0 : buf1;
        if (c < 3) {
#pragma unroll
            for (int i = 0; i < 8; ++i) { const int id = tid + 512 * i, row = id >> 5, sg = id & 31; rs[i] = *(const u32x4*)(vg + (size_t)((c + 1) * 128 + row) * 256 + sg * 8); } }
#pragma unroll
        for (int dt = 0; dt < 8; ++dt) { f32x4 acc = (f32x4){0.f, 0.f, 0.f, 0.f};
#pragma unroll
            for (int i = 0; i < 8; ++i) { const bf16x8 vf = *(const bf16x8*)(cur + (dt * 16 + fr) * XA_LDV + i * 32 + fq * 8); acc = __builtin_amdgcn_mfma_f32_16x16x32_bf16(vf, pf[i], acc, 0, 0, 0); }
            u32x2 w; w.x = pg8::cvt_pk_bf16(acc[0] * inv, acc[1] * inv); w.y = pg8::cvt_pk_bf16(acc[2] * inv, acc[3] * inv);
            *(u32x2*)(op + c * 128 + dt * 16) = w; }
        if (c < 3) {
#pragma unroll
            for (int i = 0; i < 8; ++i) { const int id = tid + 512 * i, row = id >> 5, sg = id & 31; *(u32x4*)(nxt + row * XA_LDV + sg * 8) = rs[i]; } }
        __syncthreads();
    }
}
__device__ __forceinline__ void xattn_sample_item(const Args& a, int it, float* lds) {
    const int tid = tid_opq(), lane = tid & 63, wid = tid >> 6, fr = lane & 15, fq = lane >> 4, b = it >> 2, h = it & 3;
    float* sc = lds; float* pT = lds + 1024; float* red = lds + 2048;
    const float* Kc = a.in[I_CMK] + ((size_t)b * 1024 + h) * 512; const float* Vc = a.in[I_CMV] + ((size_t)b * 1024 + h) * 512;
    const bf16_t* qb = (const bf16_t*)(a.ws + WS_XN) + (size_t)(MP + b * 4 + (fr & 3)) * D + h * 512 + fq * 8;
    bf16x8 qf[16];
#pragma unroll
    for (int ks = 0; ks < 16; ++ks) { u32x4 w = *(const u32x4*)(qb + ks * 32); if (fr >= 4) w = (u32x4){0u, 0u, 0u, 0u}; qf[ks] = __builtin_bit_cast(bf16x8, w); }
#pragma unroll
    for (int n = 0; n < 2; ++n) { f32x4 acc = (f32x4){0.f, 0.f, 0.f, 0.f}; const float* kr = Kc + (size_t)(wid * 32 + n * 16 + fr) * 2048 + fq * 8;
#pragma unroll
        for (int ks = 0; ks < 16; ++ks) { const f32x4 k0 = __builtin_nontemporal_load((const f32x4*)(kr + ks * 32)), k1 = __builtin_nontemporal_load((const f32x4*)(kr + ks * 32 + 4));
            const u32x4 w = pg8::pack8(k0, k1); acc = __builtin_amdgcn_mfma_f32_16x16x32_bf16(__builtin_bit_cast(bf16x8, w), qf[ks], acc, 0, 0, 0); }
        if (fr < 4) {
#pragma unroll
            for (int e = 0; e < 4; ++e) sc[fr * 256 + wid * 32 + n * 16 + 4 * fq + e] = acc[e]; } }
    __syncthreads();
    if (wid < 4) { f32x4 s4 = *(const f32x4*)(sc + wid * 256 + lane * 4); const float mx = wave_max(fmaxf(fmaxf(s4[0], s4[1]), fmaxf(s4[2], s4[3])));
        s4[0] = __expf(s4[0] - mx); s4[1] = __expf(s4[1] - mx); s4[2] = __expf(s4[2] - mx); s4[3] = __expf(s4[3] - mx);
        const float inv = 1.0f / wave_sum((s4[0] + s4[1]) + (s4[2] + s4[3])); s4 = s4 * inv;
#pragma unroll
        for (int e = 0; e < 4; ++e) pT[(lane * 4 + e) * 4 + wid] = s4[e]; }
    __syncthreads();
    { const int dq = tid & 127, kq = tid >> 7; f32x4 acc[4];
#pragma unroll
        for (int t = 0; t < 4; ++t) acc[t] = (f32x4){0.f, 0.f, 0.f, 0.f};
#pragma unroll 16
        for (int kk = 0; kk < 64; ++kk) { const int key = kq * 64 + kk; const f32x4 v = __builtin_nontemporal_load((const f32x4*)(Vc + (size_t)key * 2048 + dq * 4)); const f32x4 p4 = *(const f32x4*)(pT + key * 4);
#pragma unroll
            for (int t = 0; t < 4; ++t) acc[t] += v * p4[t]; }
#pragma unroll
        for (int t = 0; t < 4; ++t) *(f32x4*)(red + (kq * 4 + t) * 512 + dq * 4) = acc[t]; }
    __syncthreads();
    { const int dq = tid & 127, t = tid >> 7; f32x4 o = *(const f32x4*)(red + t * 512 + dq * 4);
#pragma unroll
        for (int kq = 1; kq < 4; ++kq) o += *(const f32x4*)(red + (kq * 4 + t) * 512 + dq * 4);
        u32x2 w; w.x = pg8::cvt_pk_bf16(o[0], o[1]); w.y = pg8::cvt_pk_bf16(o[2], o[3]);
        *(u32x2*)((bf16_t*)(a.ws + WS_MIXIN) + (size_t)(MP + b * 4 + t) * D + h * 512 + dq * 4) = w; }
    __syncthreads();
}

__device__ __forceinline__ void phase_act(const Args& a) {
    const bf16_t* gu = (const bf16_t*)(a.ws + WS_GU); bf16_t* act = (bf16_t*)(a.ws + WS_PROJ);
    const float* cw = a.in[I_FCW]; const float* cb = a.in[I_FCB];
    const int total = (256 + MSAMP) * 704;
    for (int idx = blockIdx.x * 512 + tid_opq(); idx < total; idx += gridDim.x * 512) {
        const int ri = idx / 704, c = (idx - ri * 704) * 8, row = ri < 256 ? (ri >> 1) * 64 + (ri & 1) : MP + (ri - 256);
        const bool samp = row >= MP; const int t = samp ? ((row - MP) & 3) : (row & 2047), bi = samp ? ((row - MP) >> 2) : (row >> 11);
        const bf16_t* gr = gu + (size_t)row * (2 * DFF) + c;
        float g2[8], g1[8], g0[8], uu[8];
        unpack8(*(const u32x4*)gr, g2); unpack8(*(const u32x4*)(gr + DFF), uu);
        if (t >= 1) unpack8(*(const u32x4*)(gr - 2 * DFF), g1);
        else if (samp) { const float* cp = a.in[I_CFFN] + (size_t)(bi * 2 + 1) * DFF + c;
#pragma unroll
            for (int j = 0; j < 8; ++j) g1[j] = cp[j]; }
        else {
#pragma unroll
            for (int j = 0; j < 8; ++j) g1[j] = 0.f; }
        if (t >= 2) unpack8(*(const u32x4*)(gr - 4 * DFF), g0);
        else if (samp) { const float* cp = a.in[I_CFFN] + (size_t)(bi * 2 + t) * DFF + c;
#pragma unroll
            for (int j = 0; j < 8; ++j) g0[j] = cp[j]; }
        else {
#pragma unroll
            for (int j = 0; j < 8; ++j) g0[j] = 0.f; }
        float o[8];
#pragma unroll
        for (int j = 0; j < 8; ++j) { const float x = cw[c + j] * g0[j] + cw[DFF + c + j] * g1[j] + cw[2 * DFF + c + j] * g2[j] + cb[c + j]; o[j] = silu_f(x) * uu[j]; }
        u32x4 w; w.x = pg8::cvt_pk_bf16(o[0], o[1]); w.y = pg8::cvt_pk_bf16(o[2], o[3]); w.z = pg8::cvt_pk_bf16(o[4], o[5]); w.w = pg8::cvt_pk_bf16(o[6], o[7]);
        *(u32x4*)(act + (size_t)row * DFF + c) = w;
    }
}

__device__ __forceinline__ void phase_final(const Args& a) {
    const int lane = tid_opq() & 63, gw = blockIdx.x * 8 + (tid_opq() >> 6), nw = gridDim.x * 8;
    const float* ssq = (const float*)(a.ws + WS_SSQ3); const float* g = a.in[I_NFIN];
    int row = gw; if (row >= MROWS) return;
    f32x4 gg[8];
#pragma unroll
    for (int i = 0; i < 8; ++i) gg[i] = *(const f32x4*)(g + (i * 64 + lane) * 4);
    f32x4 v[8]; float sq = lane < 32 ? ssq[(size_t)row * 32 + lane] : 0.f;
#pragma unroll
    for (int i = 0; i < 8; ++i) v[i] = *(const f32x4*)(a.out + O_Y + (size_t)row * D + (i * 64 + lane) * 4);
    for (;;) {
        const int nrow = row + nw; const bool more = nrow < MROWS;
        f32x4 nv[8]; float nsq = 0.f;
        if (more) { nsq = lane < 32 ? ssq[(size_t)nrow * 32 + lane] : 0.f;
#pragma unroll
            for (int i = 0; i < 8; ++i) nv[i] = *(const f32x4*)(a.out + O_Y + (size_t)nrow * D + (i * 64 + lane) * 4); }
        const float rs = rsqrtf(wave_sum(sq) * (1.0f / 2048.0f) + 1e-6f);
        float* y = a.out + O_Y + (size_t)row * D;
#pragma unroll
        for (int i = 0; i < 8; ++i) __builtin_nontemporal_store(v[i] * rs * gg[i], (f32x4*)(y + (i * 64 + lane) * 4));
        if (!more) break;
#pragma unroll
        for (int i = 0; i < 8; ++i) v[i] = nv[i];
        sq = nsq; row = nrow;
    }
}

struct SmallEpi { const float* res; const bf16_t* resb; const float* rgain; float* hout; bf16_t* hg; const float* gain; float* ssq; bf16_t* O; const float* ssq_in; float scale; };
template <int MODE, bool HG, bool RESBF = false, bool OUTF = true> __device__ __forceinline__ void small_gemm(const bf16_t* __restrict__ A, const bf16_t* __restrict__ Bt, int K, int row_base, const SmallEpi& E, unsigned char* ldsb) {
    const int tid = tid_opq(), lane = tid & 63, wid = tid >> 6, fr = lane & 15, fq = lane >> 4;
    constexpr int LDP = 68;
    float* part = (float*)ldsb;
    const int kslice = K >> 3, npair = kslice >> 6;
    for (int tile = blockIdx.x; tile < 256; tile += gridDim.x) {
        const int tm = tile >> 5, tn = tile & 31;
        const bf16_t* ap = A + (size_t)(tm * 64 + fr) * K + wid * kslice + fq * 16; const bf16_t* bp = Bt + (size_t)(tn * 64 + fr) * K + wid * kslice + fq * 16;
        f32x4 acc[4][4];
#pragma unroll
        for (int mi = 0; mi < 4; ++mi)
#pragma unroll
            for (int ni = 0; ni < 4; ++ni) acc[mi][ni] = (f32x4){0.f, 0.f, 0.f, 0.f};
        bf16x8 af[4][2], bf[4][2];
#pragma unroll
        for (int i = 0; i < 4; ++i) { af[i][0] = *(const bf16x8*)(ap + (size_t)(i * 16) * K); af[i][1] = *(const bf16x8*)(ap + (size_t)(i * 16) * K + 8);
            bf[i][0] = *(const bf16x8*)(bp + (size_t)(i * 16) * K); bf[i][1] = *(const bf16x8*)(bp + (size_t)(i * 16) * K + 8); }
        for (int p = 0; p < npair; ++p) {
            bf16x8 an[4][2], bn[4][2];
            const int pn = (p + 1 < npair) ? p + 1 : p;
#pragma unroll
            for (int i = 0; i < 4; ++i) { an[i][0] = *(const bf16x8*)(ap + (size_t)(i * 16) * K + pn * 64); an[i][1] = *(const bf16x8*)(ap + (size_t)(i * 16) * K + pn * 64 + 8);
                bn[i][0] = *(const bf16x8*)(bp + (size_t)(i * 16) * K + pn * 64); bn[i][1] = *(const bf16x8*)(bp + (size_t)(i * 16) * K + pn * 64 + 8); }
#pragma unroll
            for (int hh = 0; hh < 2; ++hh)
#pragma unroll
                for (int mi = 0; mi < 4; ++mi)
#pragma unroll
                    for (int ni = 0; ni < 4; ++ni) acc[mi][ni] = __builtin_amdgcn_mfma_f32_16x16x32_bf16(bf[ni][hh], af[mi][hh], acc[mi][ni], 0, 0, 0);
#pragma unroll
            for (int i = 0; i < 4; ++i) { af[i][0] = an[i][0]; af[i][1] = an[i][1]; bf[i][0] = bn[i][0]; bf[i][1] = bn[i][1]; }
        }
#pragma unroll
        for (int mi = 0; mi < 4; ++mi)
#pragma unroll
            for (int ni = 0; ni < 4; ++ni) *(f32x4*)(part + (size_t)wid * 64 * LDP + (mi * 16 + fr) * LDP + ni * 16 + 4 * fq) = acc[mi][ni];
        __syncthreads();
        const int rloc = tid >> 3, cc = (tid & 7) * 8, rl = tm * 64 + rloc, r = row_base + rl, c0 = tn * 64 + cc;
        f32x4 v0 = *(const f32x4*)(part + rloc * LDP + cc), v1 = *(const f32x4*)(part + rloc * LDP + cc + 4);
#pragma unroll
        for (int w = 1; w < 8; ++w) { v0 += *(const f32x4*)(part + (size_t)w * 64 * LDP + rloc * LDP + cc); v1 += *(const f32x4*)(part + (size_t)w * 64 * LDP + rloc * LDP + cc + 4); }
        if (MODE == 0) {
            f32x4 h0, h1;
            if (RESBF) { const u32x4 w = *(const u32x4*)(E.resb + (size_t)r * 2048 + c0); const f32x4 q0 = *(const f32x4*)(E.rgain + c0), q1 = *(const f32x4*)(E.rgain + c0 + 4);
                h0 = (f32x4){__uint_as_float(w.x << 16) / q0[0], __uint_as_float(w.x & 0xffff0000u) / q0[1], __uint_as_float(w.y << 16) / q0[2], __uint_as_float(w.y & 0xffff0000u) / q0[3]} + v0;
                h1 = (f32x4){__uint_as_float(w.z << 16) / q1[0], __uint_as_float(w.z & 0xffff0000u) / q1[1], __uint_as_float(w.w << 16) / q1[2], __uint_as_float(w.w & 0xffff0000u) / q1[3]} + v1; }
            else { const float* rp = E.res + (size_t)rl * 2048 + c0; h0 = *(const f32x4*)rp + v0; h1 = *(const f32x4*)(rp + 4) + v1; }
            if (OUTF) { float* hp = E.hout + (size_t)r * 2048 + c0; *(f32x4*)hp = h0; *(f32x4*)(hp + 4) = h1; }
            float ss = (h0[0] * h0[0] + h0[1] * h0[1]) + (h0[2] * h0[2] + h0[3] * h0[3]) + (h1[0] * h1[0] + h1[1] * h1[1]) + (h1[2] * h1[2] + h1[3] * h1[3]);
            if (HG) { const f32x4 g0 = *(const f32x4*)(E.gain + c0), g1 = *(const f32x4*)(E.gain + c0 + 4); *(u32x4*)(E.hg + (size_t)r * 2048 + c0) = pg8::pack8(h0 * g0, h1 * g1); }
            ss += dpp_f<0xB1>(ss); ss += dpp_f<0x4E>(ss); ss += dpp_f<0x141>(ss);
            if ((tid & 7) == 0) E.ssq[(size_t)r * 32 + tn] = ss;
        } else {
            const f32x4 pq = *(const f32x4*)(E.ssq_in + (size_t)r * 32 + (tid & 7) * 4); float sm = (pq[0] + pq[1]) + (pq[2] + pq[3]);
            sm += dpp_f<0xB1>(sm); sm += dpp_f<0x4E>(sm); sm += dpp_f<0x141>(sm);
            const float rs = rsqrtf(sm * (1.0f / 2048.0f) + 1e-6f) * E.scale;
            *(u32x4*)(E.O + (size_t)r * 2048 + c0) = pg8::pack8(v0 * rs, v1 * rs);
        }
        __syncthreads();
    }
}


template <class Epi> __device__ __forceinline__ void run_gemm(PG8_LAS unsigned char* lds, const bf16_t* A, const bf16_t* Bt, int M, int N, int K, int cshift, const Epi& E) {
    pg8::Gemm g; g.A = A; g.Bt = Bt; g.M = M; g.N = N; g.K = K;
    pg8::StaticOrder S; S.init(M, N, (int)gridDim.x, (int)((blockIdx.x + gridDim.x - (cshift % gridDim.x)) % gridDim.x));
    pg8::gemm_phase<Epi, pg8::StaticOrder, false>(lds, g, S, E, nullptr);
}

#ifndef REP_SYNC
#define REP_SYNC 0
#endif
#ifndef REP_P0
#define REP_P0 0
#endif
#ifndef REP_P4
#define REP_P4 0
#endif
#ifndef REP_P9
#define REP_P9 0
#endif
#ifndef REP_P1
#define REP_P1 0
#endif
#ifndef REP_P3
#define REP_P3 0
#endif
#ifndef REP_SM
#define REP_SM 0
#endif
#ifndef REP_GA
#define REP_GA 0
#endif
#ifndef REP_GS
#define REP_GS 0
#endif
#ifndef REP_GB
#define REP_GB 0
#endif
#ifndef REP_GC
#define REP_GC 0
#endif
#ifndef REP_P1B
#define REP_P1B 0
#endif
#ifndef REP_P5
#define REP_P5 0
#endif
#ifndef REP_P7
#define REP_P7 0
#endif
#define GSYNC() do { xcd_barrier(xbar); if (REP_SYNC) xcd_barrier(xbar); } while (0)
__global__ void __launch_bounds__(512, 2) mk_fwd(Args a) {
    extern __shared__ __attribute__((aligned(16))) unsigned char shm[];
    cg::grid_group grid = cg::this_grid();
    PG8_LAS unsigned char* lds = (PG8_LAS unsigned char*)shm;
    float* ldsf = (float*)shm;
    unsigned char* ws = a.ws;
    volatile LAS unsigned* xst = (volatile LAS unsigned*)(lds + LDS_BYTES - 16);
    if (threadIdx.x < 4) xst[threadIdx.x] = 0u;
    __syncthreads();
    XcdBarrier xbar = xcd_barrier_post((unsigned*)(ws + WS_BAR), xst);
    for (int rep = 0; rep <= REP_P0; ++rep) { phase_prep(a, ldsf); if (REP_P0) __syncthreads(); }
    if (a.ws == nullptr) grid.sync();
    GSYNC();
    for (int rep1 = 0; rep1 <= REP_P1; ++rep1)
    { pg8::EpiProj E; E.O = (bf16_t*)(ws + WS_PROJ); E.ldc = NINP;
      run_gemm(lds, (const bf16_t*)(ws + WS_XN), (const bf16_t*)(ws + WS_WT_IN), MROWS, NINP, D, 0, E); }
    { pg8::EpiKV E; E.outk = a.out + O_MK; E.outv = a.out + O_MV; E.mkb = (bf16_t*)(ws + WS_MKB); E.mvt = (bf16_t*)(ws + WS_MVT);
      run_gemm(lds, (const bf16_t*)(ws + WS_MEMN), (const bf16_t*)(ws + WS_WT_XKV), 1024, 4096, D, (MROWS / 256) * (NINP / 256), E); }
    __syncthreads();
    phase_transposes(a, ldsf, TT_EARLY, TT_TOTAL, (unsigned*)(ws + WS_BAR) + XCD_BAR_WORDS + 1, (volatile int*)(ldsf + 64 * 257 + 8));
    GSYNC();
    for (int rep = 0; rep <= REP_P1B; ++rep) phase_rows_pre(a);
    GSYNC();
    for (int rep = 0; rep <= REP_GA; ++rep)
    for (int it = blockIdx.x; it < 512; it += gridDim.x) gla_pass_a(a, it, shm);
    for (int rep = 0; rep <= REP_GS; ++rep)
    for (int it = blockIdx.x; it < 512; it += gridDim.x) gla_sample_item(a, it, ldsf);
    GSYNC();
    for (int rep = 0; rep <= REP_GB; ++rep) { gla_pass_b(a); if (REP_GB) __syncthreads(); }
    GSYNC();
    for (int rep = 0; rep <= REP_GC; ++rep)
    for (int it = blockIdx.x; it < 512; it += gridDim.x) gla_pass_c(a, it, shm);
    GSYNC();
    for (int rep3 = 0; rep3 <= REP_P3; ++rep3)
    { pg8::EpiRes<false, true, false> E{}; E.res0 = a.in[I_XP]; E.res1 = a.in[I_XS]; E.split = MP; E.hg = (bf16_t*)(ws + WS_HG); E.gain = a.in[I_NX]; E.ssq = (float*)(ws + WS_SSQ1);
      run_gemm(lds, (const bf16_t*)(ws + WS_MIXIN), (const bf16_t*)(ws + WS_WT_OUT), MP, D, D, 0, E);
      SmallEpi SE{}; SE.res = a.in[I_XS]; SE.hg = E.hg; SE.gain = E.gain; SE.ssq = E.ssq;
      small_gemm<0, true, false, false>((const bf16_t*)(ws + WS_MIXIN) + (size_t)MP * D, (const bf16_t*)(ws + WS_WT_OUT), D, MP, SE, shm); }
    GSYNC();
    for (int rep4 = 0; rep4 <= REP_P4; ++rep4)
    { pg8::EpiScale<false> E; E.O = (bf16_t*)(ws + WS_XN); E.ldc = D; E.ssq = (const float*)(ws + WS_SSQ1); E.scale = 0.044194173824159216f; E.ffn_p = nullptr; E.ffn_s = nullptr;
      run_gemm(lds, (const bf16_t*)(ws + WS_HG), (const bf16_t*)(ws + WS_WT_XQ), MP, D, D, 0, E);
      SmallEpi SE{}; SE.O = E.O; SE.ssq_in = E.ssq; SE.scale = E.scale;
      for (int rep = 0; rep <= REP_SM; ++rep) small_gemm<1, false>((const bf16_t*)(ws + WS_HG) + (size_t)MP * D, (const bf16_t*)(ws + WS_WT_XQ), D, MP, SE, shm); }
    GSYNC();
    {
      const bool sample_first = ((blockIdx.x >> 3) & 1) != 0;
      if (!sample_first) for (int it = blockIdx.x; it < 256; it += gridDim.x) { const int x = it & 7, j = it >> 3; xattn_prompt_item(a, (gridDim.x == 256) ? ((x * 2 + (j >> 4)) * 16 + (j & 15)) : it, shm); }
      for (int it = blockIdx.x; it < 512; it += gridDim.x) xattn_sample_item(a, it, ldsf);
      if (sample_first) for (int it = blockIdx.x; it < 256; it += gridDim.x) { const int x = it & 7, j = it >> 3; xattn_prompt_item(a, (gridDim.x == 256) ? ((x * 2 + (j >> 4)) * 16 + (j & 15)) : it, shm); } }
    GSYNC();
    { pg8::EpiRes<true, true, false> E{}; E.resb = (const bf16_t*)(ws + WS_HG); E.rgain = a.in[I_NX]; E.hg = (bf16_t*)(ws + WS_HG); E.gain = a.in[I_NF]; E.ssq = (float*)(ws + WS_SSQ2);
      run_gemm(lds, (const bf16_t*)(ws + WS_MIXIN), (const bf16_t*)(ws + WS_WT_XO), MP, D, D, 0, E);
      SmallEpi SE{}; SE.resb = E.resb; SE.rgain = E.rgain; SE.hg = E.hg; SE.gain = E.gain; SE.ssq = E.ssq;
      small_gemm<0, true, true, false>((const bf16_t*)(ws + WS_MIXIN) + (size_t)MP * D, (const bf16_t*)(ws + WS_WT_XO), D, MP, SE, shm); }
    GSYNC();
    for (int rep = 0; rep <= REP_P7; ++rep)
    { pg8::EpiFfn E; E.act = (bf16_t*)(ws + WS_PROJ); E.GU = (bf16_t*)(ws + WS_GU); E.ssq = (const float*)(ws + WS_SSQ2); E.cw = a.in[I_FCW]; E.cb = a.in[I_FCB]; E.ffn_p = a.out + O_FFN_P; E.ffn_s = a.out + O_FFN_S;
      run_gemm(lds, (const bf16_t*)(ws + WS_HG), (const bf16_t*)(ws + WS_WT_FGU), MROWS, 2 * DFF, D, 0, E); }
    GSYNC();
    phase_act(a);
    GSYNC();
    for (int rep9 = 0; rep9 <= REP_P9; ++rep9)
    { pg8::EpiRes<true, false, true> E{}; E.resb = (const bf16_t*)(ws + WS_HG); E.rgain = a.in[I_NF]; E.hout = a.out + O_Y; E.ssq = (float*)(ws + WS_SSQ3);
      run_gemm(lds, (const bf16_t*)(ws + WS_PROJ), (const bf16_t*)(ws + WS_WT_FD), MP, D, DFF, 0, E);
      SmallEpi SE{}; SE.resb = E.resb; SE.rgain = E.rgain; SE.hout = E.hout; SE.ssq = E.ssq;
      small_gemm<0, false, true, true>((const bf16_t*)(ws + WS_PROJ) + (size_t)MP * DFF, (const bf16_t*)(ws + WS_WT_FD), DFF, MP, SE, shm); }
    GSYNC();
    phase_final(a);
}

extern "C" void kernel_launch(void* const* d_in, const int* in_sizes, int n_in, void* d_out, int out_size, void* d_ws, size_t ws_size, hipStream_t stream) {
    static int grid = 0;
    if (grid == 0) {
        if (n_in != 28 || ws_size < WS_END) { fprintf(stderr, "kernel_launch: unexpected n_in %d or ws_size %zu (< %zu)\n", n_in, ws_size, (size_t)WS_END); grid = -1; return; }
        int dev = 0, cus = 0, per_cu = 0;
        (void)hipGetDevice(&dev); (void)hipDeviceGetAttribute(&cus, hipDeviceAttributeMultiprocessorCount, dev);
        (void)hipFuncSetAttribute((const void*)mk_fwd, hipFuncAttributeMaxDynamicSharedMemorySize, LDS_BYTES);
        (void)hipOccupancyMaxActiveBlocksPerMultiprocessor(&per_cu, (const void*)mk_fwd, 512, LDS_BYTES);
        if (per_cu < 1) { fprintf(stderr, "kernel_launch: occupancy query says %d blocks/CU\n", per_cu); grid = -1; return; }
        grid = cus;
    }
    if (grid < 0) return;
    Args a{};
    for (int i = 0; i < 28; ++i) a.in[i] = (const float*)d_in[i];
    a.out = (float*)d_out; a.ws = (unsigned char*)d_ws;
    if (hipMemsetAsync((unsigned char*)d_ws + WS_BAR, 0, (size_t)(XCD_BAR_WORDS + 64) * 4, stream) != hipSuccess) { fprintf(stderr, "kernel_launch: memset of barrier words failed\n"); return; }
    void* args[] = {&a};
    hipError_t e = hipLaunchCooperativeKernel((const void*)mk_fwd, dim3(grid), dim3(512), args, LDS_BYTES, stream);
    if (e != hipSuccess) fprintf(stderr, "cooperative launch failed: %s (grid %d)\n", hipGetErrorString(e), grid);
}
```

```cpp
#include <hip/hip_runtime.h>
#include <hip/hip_cooperative_groups.h>
#include <cstdio>
namespace cg = cooperative_groups;

__device__ __forceinline__ int tid_opq() { int t = threadIdx.x; asm volatile("" : "+v"(t)); return t; }
namespace pg8 {
#define PG8_LAS __attribute__((address_space(3)))
typedef unsigned short bf16_t;
typedef short bf16x8 __attribute__((ext_vector_type(8)));
typedef float f32x4 __attribute__((ext_vector_type(4)));
typedef unsigned u32x4 __attribute__((ext_vector_type(4)));
constexpr int BM = 256, BK = 64, HALF = 128, HTB = HALF * BK * 2  , STAGE_BYTES = 8 * HTB, NXCD = 8, WGM = 8;

__host__ __device__ __forceinline__ int lds_byte(int r, int c) { const int st = (r >> 4) * 2 + (c >> 5), rr = r & 15, cc = c & 31, ob = rr * 64 + cc * 2; return st * 1024 + (ob ^ (((ob >> 9) & 1) << 5)); }
__host__ __device__ __forceinline__ void stage_rc(int b, int& R, int& C) { const int st = b / 1024, sb = b % 1024, swz = sb ^ (((sb >> 9) & 1) << 5); R = (st >> 1) * 16 + swz / 64; C = (st & 1) * 32 + (swz % 64) / 2; }
__host__ __device__ __forceinline__ int perm32(int rho) { const int n = rho >> 4, i = rho & 15; return 8 * (i >> 2) + 4 * n + (i & 3); }

struct Unit { int pm, pn; };
struct Gemm { const bf16_t* A; const bf16_t* Bt; int M, N, K; };

struct StaticOrder {
    int nM, nN, nwg, G, c;
    __host__ __device__ void init(int M, int N, int G_, int c_) { nM = M / BM; nN = N / BM; nwg = nM * nN; G = G_; c = c_; }
    __host__ __device__ bool next(int i, Unit& u) const {
        const long L = (long)i * G + c; if (L >= nwg) return false;
        int wgid = (int)L; { const int q = nwg / NXCD, r = nwg % NXCD, xcd = wgid % NXCD, off = wgid / NXCD; wgid = (xcd < r ? xcd * (q + 1) : r * (q + 1) + (xcd - r) * q) + off; }
        const int nig = WGM * nN, gid = wgid / nig, fm = gid * WGM, gsz = (nM - fm) < WGM ? (nM - fm) : WGM;
        u.pm = fm + ((wgid % nig) % gsz); u.pn = (wgid % nig) / gsz; return true;
    }
    __device__ __forceinline__ void a_ready(const Unit&) const {}
    __device__ __forceinline__ void done(const Unit&) const {}
};
typedef unsigned u32x2 __attribute__((ext_vector_type(2)));
__device__ __forceinline__ unsigned cvt_pk_bf16(float lo, float hi) { unsigned r; asm volatile("v_cvt_pk_bf16_f32 %0, %1, %2" : "=v"(r) : "v"(lo), "v"(hi)); return r; }
__device__ __forceinline__ u32x4 pack8(const f32x4 v0, const f32x4 v1) { u32x4 w; w.x = cvt_pk_bf16(v0[0], v0[1]); w.y = cvt_pk_bf16(v0[2], v0[3]); w.z = cvt_pk_bf16(v1[0], v1[1]); w.w = cvt_pk_bf16(v1[2], v1[3]); return w; }

struct EpiProj {
    static constexpr bool PERM = true, AFTER_DRAIN = false;
    bf16_t* O; int ldc;
    __device__ __forceinline__ void operator()(const f32x4 (&acc)[2][2][4][2], const Unit& u, int wr, int wc, int fr, int fq) const {
        const int row0 = u.pm * BM + wr * 64 + fr, col0 = u.pn * BM + wc * 32 + 8 * fq;
#pragma unroll
        for (int ai = 0; ai < 2; ++ai)
#pragma unroll
            for (int m = 0; m < 4; ++m) { bf16_t* rowp = O + (size_t)(row0 + ai * HALF + m * 16) * ldc + col0;
#pragma unroll
                for (int bj = 0; bj < 2; ++bj) *(u32x4*)(rowp + bj * HALF) = pack8(acc[ai][bj][m][0], acc[ai][bj][m][1]); }
    }
};

struct EpiKV {
    static constexpr bool PERM = false, AFTER_DRAIN = false;
    float* outk; float* outv; bf16_t* mkb; bf16_t* mvt;
    __device__ __forceinline__ void operator()(const f32x4 (&acc)[2][2][4][2], const Unit& u, int wr, int wc, int fr, int fq) const {
        const int row0 = u.pm * BM + wr * 64 + fr, col0 = (u.pn & 7) * BM + wc * 32 + 4 * fq;
        const bool isv = u.pn >= 8;
#pragma unroll
        for (int ai = 0; ai < 2; ++ai)
#pragma unroll
            for (int m = 0; m < 4; ++m) { const int r = row0 + ai * HALF + m * 16;
                const int bb = r >> 8, key = r & 255, pos = (key & ~31) + 8 * ((key >> 2) & 3) + 4 * ((key >> 4) & 1) + (key & 3);
#pragma unroll
                for (int bj = 0; bj < 2; ++bj)
#pragma unroll
                    for (int n = 0; n < 2; ++n) { const int c = col0 + bj * HALF + n * 16; const f32x4 v = acc[ai][bj][m][n];
                        if (!isv) { __builtin_nontemporal_store(v, (f32x4*)(outk + (size_t)r * 2048 + c)); u32x2 w; w.x = cvt_pk_bf16(v[0], v[1]); w.y = cvt_pk_bf16(v[2], v[3]); *(u32x2*)(mkb + (size_t)r * 2048 + c) = w; }
                        else { __builtin_nontemporal_store(v, (f32x4*)(outv + (size_t)r * 2048 + c)); const unsigned w0 = cvt_pk_bf16(v[0], v[1]), w1 = cvt_pk_bf16(v[2], v[3]);
                            bf16_t* tp = mvt + ((size_t)(bb * 2048 + c)) * 256 + pos;
                            tp[0] = (bf16_t)(w0 & 0xffffu); tp[256] = (bf16_t)(w0 >> 16); tp[512] = (bf16_t)(w1 & 0xffffu); tp[768] = (bf16_t)(w1 >> 16); } } }
    }
};

template <bool RESBF, bool HG, bool OUTF> struct EpiRes {
    static constexpr bool PERM = true, AFTER_DRAIN = false;
    const float* res0; const float* res1; int split; const bf16_t* resb; const float* rgain; float* hout; bf16_t* hg; const float* gain; float* ssq;
    __device__ __forceinline__ void operator()(const f32x4 (&acc)[2][2][4][2], const Unit& u, int wr, int wc, int fr, int fq) const {
        const int row0 = u.pm * BM + wr * 64 + fr, col0 = u.pn * BM + wc * 32 + 8 * fq;
        float ss[2][4];
#pragma unroll
        for (int ai = 0; ai < 2; ++ai)
#pragma unroll
            for (int m = 0; m < 4; ++m) ss[ai][m] = 0.f;
#pragma unroll
        for (int bj = 0; bj < 2; ++bj) { const int c = col0 + bj * HALF;
            f32x4 g0, g1, q0, q1;
            if (HG) { g0 = *(const f32x4*)(gain + c); g1 = *(const f32x4*)(gain + c + 4); }
            if (RESBF) { q0 = *(const f32x4*)(rgain + c); q1 = *(const f32x4*)(rgain + c + 4);
#pragma unroll
                for (int j = 0; j < 4; ++j) { q0[j] = __builtin_amdgcn_rcpf(q0[j]); q1[j] = __builtin_amdgcn_rcpf(q1[j]); } }
#pragma unroll
            for (int ai = 0; ai < 2; ++ai) {
                u32x4 rw[4]; f32x4 ra[4], rb[4];
#pragma unroll
                for (int m = 0; m < 4; ++m) { const int r = row0 + ai * HALF + m * 16;
                    if (RESBF) rw[m] = *(const u32x4*)(resb + (size_t)r * 2048 + c);
                    else { const float* rp = (r < split ? res0 + (size_t)r * 2048 : res1 + (size_t)(r - split) * 2048) + c; ra[m] = __builtin_nontemporal_load((const f32x4*)rp); rb[m] = __builtin_nontemporal_load((const f32x4*)(rp + 4)); } }
#pragma unroll
                for (int m = 0; m < 4; ++m) { const int r = row0 + ai * HALF + m * 16;
                    f32x4 h0, h1;
                    if (RESBF) { const u32x4 w = rw[m];
                        h0 = (f32x4){__uint_as_float(w.x << 16), __uint_as_float(w.x & 0xffff0000u), __uint_as_float(w.y << 16), __uint_as_float(w.y & 0xffff0000u)} * q0 + acc[ai][bj][m][0];
                        h1 = (f32x4){__uint_as_float(w.z << 16), __uint_as_float(w.z & 0xffff0000u), __uint_as_float(w.w << 16), __uint_as_float(w.w & 0xffff0000u)} * q1 + acc[ai][bj][m][1]; }
                    else { h0 = ra[m] + acc[ai][bj][m][0]; h1 = rb[m] + acc[ai][bj][m][1]; }
                    ss[ai][m] += (h0[0] * h0[0] + h0[1] * h0[1]) + (h0[2] * h0[2] + h0[3] * h0[3]) + (h1[0] * h1[0] + h1[1] * h1[1]) + (h1[2] * h1[2] + h1[3] * h1[3]);
                    if (OUTF) { float* hp = hout + (size_t)r * 2048 + c; *(f32x4*)hp = h0; *(f32x4*)(hp + 4) = h1; }
                    if (HG) *(u32x4*)(hg + (size_t)r * 2048 + c) = pack8(h0 * g0, h1 * g1); }
                __builtin_amdgcn_sched_barrier(0); } }
#pragma unroll
        for (int ai = 0; ai < 2; ++ai)
#pragma unroll
            for (int m = 0; m < 4; ++m) { float s = ss[ai][m]; s += __shfl_xor(s, 16); s += __shfl_xor(s, 32);
                if (fq == 0) ssq[(size_t)(row0 + ai * HALF + m * 16) * 32 + u.pn * 4 + wc] = s; }
    }
};

template <bool FFN> struct EpiScale {
    static constexpr bool PERM = true, AFTER_DRAIN = false;
    bf16_t* O; int ldc; const float* ssq; float scale; float* ffn_p; float* ffn_s;
    __device__ __forceinline__ void operator()(const f32x4 (&acc)[2][2][4][2], const Unit& u, int wr, int wc, int fr, int fq) const {
        const int row0 = u.pm * BM + wr * 64 + fr, col0 = u.pn * BM + wc * 32 + 8 * fq;
#pragma unroll
        for (int ai = 0; ai < 2; ++ai)
#pragma unroll
            for (int m = 0; m < 4; ++m) { const int r = row0 + ai * HALF + m * 16;
                const f32x4* sp = (const f32x4*)(ssq + (size_t)r * 32 + fq * 8); const f32x4 p0 = sp[0], p1 = sp[1];
                float s = ((p0[0] + p0[1]) + (p0[2] + p0[3])) + ((p1[0] + p1[1]) + (p1[2] + p1[3]));
                s += __shfl_xor(s, 16); s += __shfl_xor(s, 32);
                const float rs = rsqrtf(s * (1.0f / 2048.0f) + 1e-6f) * scale;
                bf16_t* rowp = O + (size_t)r * ldc + col0;
                float* dst = nullptr;
                if (FFN && u.pn < 22) {
                    if (r < 8192) { const int t = r & 2047; if (t >= 2046) dst = ffn_p + (size_t)((r >> 11) * 2 + (t - 2046)) * 5632; }
                    else { const int rr = r - 8192, t = rr & 3; if (t >= 2) dst = ffn_s + (size_t)((rr >> 2) * 2 + (t - 2)) * 5632; } }
#pragma unroll
                for (int bj = 0; bj < 2; ++bj) { const f32x4 v0 = acc[ai][bj][m][0] * rs, v1 = acc[ai][bj][m][1] * rs;
                    *(u32x4*)(rowp + bj * HALF) = pack8(v0, v1);
                    if (FFN) { if (dst) { *(f32x4*)(dst + col0 + bj * HALF) = v0; *(f32x4*)(dst + col0 + bj * HALF + 4) = v1; } } } }
    }
};

struct EpiFfn {
    static constexpr bool PERM = true, AFTER_DRAIN = false;
    bf16_t* act; bf16_t* GU; const float* ssq; const float* cw; const float* cb; float* ffn_p; float* ffn_s;
    template <int N> __device__ __forceinline__ static float ror(float x) { return __int_as_float(__builtin_amdgcn_update_dpp(0, __float_as_int(x), 0x120 + N, 0xf, 0xf, false)); }
    template <int N> __device__ __forceinline__ static f32x4 rot(const f32x4 v) { f32x4 r; r[0] = ror<N>(v[0]); r[1] = ror<N>(v[1]); r[2] = ror<N>(v[2]); r[3] = ror<N>(v[3]); return r; }
    __device__ __forceinline__ void operator()(const f32x4 (&acc)[2][2][4][2], const Unit& u, int wr, int wc, int fr, int fq) const {
        const int row0 = u.pm * BM + wr * 64 + fr, ch0 = u.pn * 128 + wc * 32 + 8 * fq;
        if (u.pm >= 32) {
#pragma unroll
            for (int ai = 0; ai < 2; ++ai)
#pragma unroll
                for (int m = 0; m < 4; ++m) { const int r = row0 + ai * HALF + m * 16;
                    const f32x4* sp = (const f32x4*)(ssq + (size_t)r * 32); float s = 0.f;
#pragma unroll
                    for (int i = 0; i < 8; ++i) { const f32x4 v = sp[i]; s += (v[0] + v[1]) + (v[2] + v[3]); }
                    const float rs = rsqrtf(s * (1.0f / 2048.0f) + 1e-6f);
                    const f32x4 g0 = acc[ai][0][m][0] * rs, g1 = acc[ai][0][m][1] * rs;
                    *(u32x4*)(GU + (size_t)r * 11264 + ch0) = pack8(g0, g1); *(u32x4*)(GU + (size_t)r * 11264 + 5632 + ch0) = pack8(acc[ai][1][m][0] * rs, acc[ai][1][m][1] * rs);
                    const int rr = r - 8192, t = rr & 3;
                    if (t >= 2) { float* dst = ffn_s + (size_t)((rr >> 2) * 2 + (t - 2)) * 5632 + ch0; *(f32x4*)dst = g0; *(f32x4*)(dst + 4) = g1; } }
            return; }
        float rsv[2][4];
#pragma unroll
        for (int ai = 0; ai < 2; ++ai)
#pragma unroll
            for (int m = 0; m < 4; ++m) { const f32x4* sp = (const f32x4*)(ssq + (size_t)(row0 + ai * HALF + m * 16) * 32 + fq * 8); const f32x4 v0 = sp[0], v1 = sp[1];
                float s = ((v0[0] + v0[1]) + (v0[2] + v0[3])) + ((v1[0] + v1[1]) + (v1[2] + v1[3]));
                s += __shfl_xor(s, 16); s += __shfl_xor(s, 32);
                rsv[ai][m] = rsqrtf(s * (1.0f / 2048.0f) + 1e-6f); }
#pragma unroll
        for (int n = 0; n < 2; ++n) { const int ch = ch0 + 4 * n;
            const f32x4 w0 = *(const f32x4*)(cw + ch), w1 = *(const f32x4*)(cw + 5632 + ch), w2 = *(const f32x4*)(cw + 11264 + ch), bz = *(const f32x4*)(cb + ch);
#pragma unroll
            for (int ai = 0; ai < 2; ++ai) {
                f32x4 q1, q2;
#pragma unroll
                for (int m = 0; m < 4; ++m) { const int r = row0 + ai * HALF + m * 16; const float rs = rsv[ai][m];
                    const f32x4 g = acc[ai][0][m][n] * rs, uu = acc[ai][1][m][n] * rs;
                    const f32x4 r1 = rot<1>(g), r2 = rot<2>(g);
                    f32x4 p1 = r1, p2 = r2;
                    if (m > 0) { if (fr < 1) p1 = q1; if (fr < 2) p2 = q2; }
                    q1 = r1; q2 = r2;
                    u32x2 w;
                    if (m == 0 && fr < 2) {
                        w.x = cvt_pk_bf16(g[0], g[1]); w.y = cvt_pk_bf16(g[2], g[3]); *(u32x2*)(GU + (size_t)r * 11264 + ch) = w;
                        w.x = cvt_pk_bf16(uu[0], uu[1]); w.y = cvt_pk_bf16(uu[2], uu[3]); *(u32x2*)(GU + (size_t)r * 11264 + 5632 + ch) = w; }
                    else {
                        const f32x4 x = w0 * p2 + w1 * p1 + w2 * g + bz; f32x4 o;
#pragma unroll
                        for (int j = 0; j < 4; ++j) o[j] = x[j] * __builtin_amdgcn_rcpf(1.0f + __expf(-x[j])) * uu[j];
                        w.x = cvt_pk_bf16(o[0], o[1]); w.y = cvt_pk_bf16(o[2], o[3]); *(u32x2*)(act + (size_t)r * 5632 + ch) = w; }
                    if (m == 3 && fr >= 14) {
                        w.x = cvt_pk_bf16(g[0], g[1]); w.y = cvt_pk_bf16(g[2], g[3]); *(u32x2*)(GU + (size_t)r * 11264 + ch) = w;
                        const int t = r & 2047; if (t >= 2046) *(f32x4*)(ffn_p + (size_t)((r >> 11) * 2 + (t - 2046)) * 5632 + ch) = g; }
                    __builtin_amdgcn_sched_barrier(0); } } }
    }
};

template <class Epi, class Sched, bool STAMP = false>
__device__ __forceinline__ void gemm_phase(PG8_LAS unsigned char* lds, const Gemm g, const Sched& S, const Epi& E, unsigned long long* stamps) {
    const int tid = ::tid_opq(), wid = __builtin_amdgcn_readfirstlane(tid >> 6), lane = tid & 63, wr = wid >> 2, wc = wid & 3, fr = lane & 15, fq = lane >> 4;
    const int K = g.K, nt = K / BK;
    int ts_lo = 0, ts_hi = 0, nts = 0; const unsigned long long rt_entry = STAMP ? (unsigned long long)wall_clock64() : 0ull;
#define PG8_STAMP() do { if (STAMP && wid == 0 && nts < 64) { const unsigned long long _c = (unsigned long long)clock64(); \
        ts_lo = (lane == nts) ? (int)(unsigned)_c : ts_lo; ts_hi = (lane == nts) ? (int)(unsigned)(_c >> 32) : ts_hi; ++nts; } } while (0)
    PG8_STAMP();
    unsigned voffA[2], voffB[2];
#pragma unroll
    for (int i = 0; i < 2; ++i) { int R, C; stage_rc(tid * 16 + i * 8192, R, C); const int Rb = Epi::PERM ? ((R & ~31) + perm32(R & 31)) : R;
        voffA[i] = (unsigned)(R * K + C) * 2u; voffB[i] = (unsigned)(Rb * K + C) * 2u; }
    const size_t kstep = (size_t)(BK * 2);
    const size_t hstep = (size_t)HALF * K * 2;
    const size_t tstep = 2 * hstep;
    const unsigned ldsw = (unsigned)wid * 1024u;
    const int aoff = lds_byte(wr * 64 + fr, fq * 8), boff = lds_byte(wc * 32 + fr, fq * 8);
#define PG8_SA(b, h) (((b) * 2 + (h)) * HTB)
#define PG8_SB(b, h) ((4 + (b) * 2 + (h)) * HTB)
#define PG8_STAGE(bufoff, gbase, voff) do { _Pragma("unroll") for (int _i = 0; _i < 2; ++_i) \
        __builtin_amdgcn_global_load_lds((const unsigned*)((const char*)(gbase) + (voff)[_i]), (PG8_LAS unsigned*)(lds + (bufoff) + ldsw + _i * 8192), 16, 0, 0); } while (0)
#define PG8_LDA(dst, b, h) do { _Pragma("unroll") for (int m = 0; m < 4; ++m) _Pragma("unroll") for (int k = 0; k < 2; ++k) dst[m][k] = *(const PG8_LAS bf16x8*)(lds + PG8_SA(b, h) + aoff + m * 2048 + k * 1024); } while (0)
#define PG8_LDB(dst, b, h) do { _Pragma("unroll") for (int n = 0; n < 2; ++n) _Pragma("unroll") for (int k = 0; k < 2; ++k) dst[n][k] = *(const PG8_LAS bf16x8*)(lds + PG8_SB(b, h) + boff + n * 2048 + k * 1024); } while (0)
#define PG8_MMA(ai, bj, At, Bt) do { __builtin_amdgcn_s_setprio(1); _Pragma("unroll") for (int m = 0; m < 4; ++m) _Pragma("unroll") for (int n = 0; n < 2; ++n) _Pragma("unroll") for (int k = 0; k < 2; ++k) \
        acc[ai][bj][m][n] = __builtin_amdgcn_mfma_f32_16x16x32_bf16(Bt[n][k], At[m][k], acc[ai][bj][m][n], 0, 0, 0); __builtin_amdgcn_s_setprio(0); } while (0)
#define PG8_WAIT_V(n) asm volatile("s_waitcnt vmcnt(" #n ")" ::: "memory")
#define PG8_WAIT_L(n) asm volatile("s_waitcnt lgkmcnt(" #n ")" ::: "memory")
#define PG8_BAR __builtin_amdgcn_s_barrier()
#define PG8_SCHED __builtin_amdgcn_sched_barrier(0)
    Unit cur, nxt; int ui = 0;
    if (!S.next(0, cur)) return;
    f32x4 acc[2][2][4][2];
#pragma unroll
    for (int a = 0; a < 2; ++a)
#pragma unroll
        for (int b = 0; b < 2; ++b)
#pragma unroll
            for (int m = 0; m < 4; ++m)
#pragma unroll
                for (int n = 0; n < 2; ++n) acc[a][b][m][n] = (f32x4){0.f, 0.f, 0.f, 0.f};
    bf16x8 At[4][2], B0[2][2], B1[2][2];
    const char* cA = (const char*)g.A + (size_t)cur.pm * tstep; const char* cB = (const char*)g.Bt + (size_t)cur.pn * tstep;
    S.a_ready(cur);
    PG8_STAGE(PG8_SB(0, 0), cB, voffB); PG8_STAGE(PG8_SA(0, 0), cA, voffA); PG8_STAGE(PG8_SB(0, 1), cB + hstep, voffB); PG8_STAGE(PG8_SA(0, 1), cA + hstep, voffA);
    if (wr == 1) PG8_BAR;
    PG8_WAIT_V(4); PG8_BAR;
    PG8_STAGE(PG8_SB(1, 0), cB + kstep, voffB); PG8_STAGE(PG8_SA(1, 0), cA + kstep, voffA); PG8_STAGE(PG8_SB(1, 1), cB + hstep + kstep, voffB);
    PG8_WAIT_V(6); PG8_BAR;
    PG8_STAMP();
    for (;;) {
        const bool has_next = S.next(ui + 1, nxt);
        const char* nA = has_next ? (const char*)g.A + (size_t)nxt.pm * tstep : cA; const char* nB = has_next ? (const char*)g.Bt + (size_t)nxt.pn * tstep : cB;
        for (int t = 0; t < nt; t += 2) {
            const bool last = (t == nt - 2);
            const char* a1 = cA + (size_t)(t + 1) * kstep;
            const char* a2 = last ? nA : cA + (size_t)(t + 2) * kstep; const char* b2 = last ? nB : cB + (size_t)(t + 2) * kstep;
            const char* a3 = a2 + kstep; const char* b3 = b2 + kstep;
            if (last && has_next) S.a_ready(nxt);
            PG8_LDB(B0, 0, 0); PG8_SCHED; PG8_LDA(At, 0, 0); PG8_STAGE(PG8_SA(1, 1), a1 + hstep, voffA);
            PG8_WAIT_L(8); PG8_BAR; PG8_WAIT_L(0); PG8_MMA(0, 0, At, B0); PG8_BAR; PG8_SCHED;
            PG8_LDB(B1, 0, 1); PG8_STAGE(PG8_SB(0, 0), b2, voffB);
            PG8_BAR; PG8_WAIT_L(0); PG8_MMA(0, 1, At, B1); PG8_BAR;
            PG8_LDA(At, 0, 1); PG8_STAGE(PG8_SA(0, 0), a2, voffA);
            PG8_BAR; PG8_WAIT_L(0); PG8_MMA(1, 0, At, B0); PG8_BAR; PG8_SCHED;
            PG8_STAGE(PG8_SB(0, 1), b2 + hstep, voffB);
            PG8_WAIT_V(6); PG8_BAR; PG8_MMA(1, 1, At, B1); PG8_BAR;
            PG8_LDB(B0, 1, 0); PG8_SCHED; PG8_LDA(At, 1, 0); PG8_STAGE(PG8_SA(0, 1), a2 + hstep, voffA);
            PG8_WAIT_L(8); PG8_BAR; PG8_WAIT_L(0); PG8_MMA(0, 0, At, B0); PG8_BAR; PG8_SCHED;
            PG8_LDB(B1, 1, 1); PG8_STAGE(PG8_SB(1, 0), b3, voffB);
            PG8_BAR; PG8_WAIT_L(0); PG8_MMA(0, 1, At, B1); PG8_BAR;
            PG8_LDA(At, 1, 1); PG8_STAGE(PG8_SA(1, 0), a3, voffA);
            PG8_BAR; PG8_WAIT_L(0); PG8_MMA(1, 0, At, B0); PG8_BAR; PG8_SCHED;
            PG8_STAGE(PG8_SB(1, 1), b3 + hstep, voffB);
            PG8_WAIT_V(6); PG8_BAR; PG8_MMA(1, 1, At, B1); PG8_BAR;
        }
        PG8_STAMP();
        if constexpr (!Epi::AFTER_DRAIN) { E(acc, cur, wr, wc, fr, fq); S.done(cur); }
        PG8_STAMP();
        if (!has_next) break;
#pragma unroll
        for (int a = 0; a < 2; ++a)
#pragma unroll
            for (int b = 0; b < 2; ++b)
#pragma unroll
                for (int m = 0; m < 4; ++m)
#pragma unroll
                    for (int n = 0; n < 2; ++n) acc[a][b][m][n] = (f32x4){0.f, 0.f, 0.f, 0.f};
        cur = nxt; cA = nA; cB = nB; ++ui;
    }
    PG8_WAIT_V(0);
    if (wr == 0) PG8_BAR;
    PG8_BAR;
    if constexpr (Epi::AFTER_DRAIN) { E.fused(acc, cur, wr, wc, fr, fq, lds, wid, lane); S.done(cur); }
    PG8_STAMP();
    if (STAMP && wid == 0) { stamps[lane] = lane < nts ? (((unsigned long long)(unsigned)ts_hi << 32) | (unsigned)ts_lo) : 0ull;
        if (lane == 62) stamps[62] = rt_entry; if (lane == 63) stamps[63] = (unsigned long long)wall_clock64(); }
#undef PG8_STAMP
#undef PG8_SA
#undef PG8_SB
#undef PG8_STAGE
#undef PG8_LDA
#undef PG8_LDB
#undef PG8_MMA
#undef PG8_WAIT_V
#undef PG8_WAIT_L
#undef PG8_BAR
#undef PG8_SCHED
}
}
#define XB_TMO      128
#define XB_XCNT(j)  (256  + 64 * (j))
#define XB_XSUB(j)  (1280 + 64 * (j))
#define XB_XGEN(j)  (2304 + 64 * (j))
#define XB_TOP      3328
#define XB_TOPGEN   3392
#define XCD_BAR_WORDS 3456
#define XB_SPIN_CAP (1u << 18)
#define LAS __attribute__((address_space(3)))

__device__ __forceinline__ unsigned xb_ld(unsigned* p)              { return __hip_atomic_load(p, __ATOMIC_RELAXED, __HIP_MEMORY_SCOPE_AGENT); }
__device__ __forceinline__ unsigned xb_add(unsigned* p, unsigned v) { return __hip_atomic_fetch_add(p, v, __ATOMIC_RELAXED, __HIP_MEMORY_SCOPE_AGENT); }
__device__ __forceinline__ unsigned xb_xcc_id() { return (unsigned)__builtin_amdgcn_s_getreg((3 << 11) | 20) & 0xFu; }
#define XB_SPIN(cond, bar) do { unsigned _sp = 0; while (cond) { __builtin_amdgcn_s_sleep(1); \
    if ((++_sp & 255u) == 0u) { if (xb_ld(&(bar)[XB_TMO])) break; if (_sp > XB_SPIN_CAP) { atomicAdd(&(bar)[XB_TMO], 1u); break; } } } } while (0)

struct XcdBarrier {
    unsigned* bar; unsigned x;
    volatile LAS unsigned* st;
};

__device__ __forceinline__ XcdBarrier xcd_barrier_post(unsigned* bar, volatile LAS unsigned* st) {
    XcdBarrier b; b.bar = bar; b.x = xb_xcc_id(); b.st = st;
    if (threadIdx.x == 0) (void)xb_add(&bar[XB_XCNT(b.x)], 1u);
    return b;
}
__device__ __forceinline__ void xcd_barrier_complete(unsigned* bar, unsigned x, unsigned& nloc, unsigned& nx) {
    const unsigned G = gridDim.x * gridDim.y * gridDim.z;
    unsigned sum, cnt, mine, sp = 0u;
    for (;;) {
        sum = 0u; cnt = 0u; mine = 0u;
#pragma unroll
        for (unsigned j = 0; j < 16; ++j) { const unsigned c = xb_ld(&bar[XB_XCNT(j)]); sum += c; cnt += (c > 0u) ? 1u : 0u; mine = (j == x) ? c : mine; }
        if (sum == G) break;
        __builtin_amdgcn_s_sleep(1);
        if ((++sp & 255u) == 0u) { if (xb_ld(&bar[XB_TMO])) break; if (sp > XB_SPIN_CAP) { atomicAdd(&bar[XB_TMO], 1u); break; } }
    }
    nloc = mine > 0u ? mine : 1u; nx = cnt > 0u ? cnt : 1u;
}

__device__ __forceinline__ void xcd_barrier(const XcdBarrier& b) {
    asm volatile("s_waitcnt vmcnt(0)" ::: "memory");
    __syncthreads();
    if (threadIdx.x == 0) {
        unsigned* bar = b.bar;
        __builtin_amdgcn_s_waitcnt(0);
        unsigned nloc = b.st[0], nx = b.st[1];
        if (nloc == 0u) { xcd_barrier_complete(bar, b.x, nloc, nx); b.st[0] = nloc; b.st[1] = nx; }
        const unsigned old = xb_add(&bar[XB_XSUB(b.x)], 1u);
        const unsigned gen = old / nloc;
        if (old + 1u == (gen + 1u) * nloc) {
            __builtin_amdgcn_fence(__ATOMIC_RELEASE, "agent");
            asm volatile("s_waitcnt vmcnt(0)" ::: "memory");
            const unsigned og = xb_add(&bar[XB_TOP], 1u);
            const unsigned tg = og / nx;
            if (og + 1u == (tg + 1u) * nx) xb_add(&bar[XB_TOPGEN], 1u);
            else XB_SPIN(xb_ld(&bar[XB_TOPGEN]) == tg, bar);
            __builtin_amdgcn_fence(__ATOMIC_ACQUIRE, "agent");
            xb_add(&bar[XB_XGEN(b.x)], 1u);
            asm volatile("s_waitcnt vmcnt(0)" ::: "memory");
        } else {
            XB_SPIN(xb_ld(&bar[XB_XGEN(b.x)]) == gen, bar);
            __builtin_amdgcn_fence(__ATOMIC_ACQUIRE, "agent");
            asm volatile("s_waitcnt vmcnt(0)" ::: "memory");
        }
    }
    __syncthreads();
}

using pg8::bf16_t; using pg8::f32x4; using pg8::u32x4; using pg8::u32x2; using pg8::bf16x8;
constexpr int D = 2048, MP = 8192, MSAMP = 512, MROWS = 8704, NINP = 6400, NIN = 6160, DFF = 5632;
constexpr int C_BG = 0, C_CG = 1024, C_VC = 2048, C_Q = 3072, C_K = 3584, C_V = 4096, C_R = 5120, C_G1 = 6144;
constexpr size_t al256(size_t x) { return (x + 255) & ~(size_t)255; }
constexpr size_t WS_WT_IN = 0;
constexpr size_t WS_WT_OUT = WS_WT_IN + al256((size_t)NINP * D * 2);
constexpr size_t WS_WT_XQ = WS_WT_OUT + al256((size_t)D * D * 2);
constexpr size_t WS_WT_XO = WS_WT_XQ + al256((size_t)D * D * 2);
constexpr size_t WS_WT_XKV = WS_WT_XO + al256((size_t)D * D * 2);
constexpr size_t WS_WT_FGU = WS_WT_XKV + al256((size_t)2 * D * D * 2);
constexpr size_t WS_WT_FD = WS_WT_FGU + al256((size_t)2 * DFF * D * 2);
constexpr size_t WS_XN = WS_WT_FD + al256((size_t)D * DFF * 2);
constexpr size_t WS_MEMN = WS_XN + al256((size_t)MROWS * D * 2);
constexpr size_t WS_PROJ = WS_MEMN + al256((size_t)1024 * D * 2);
constexpr size_t WS_MIXIN = WS_PROJ + al256((size_t)MROWS * NINP * 2);
constexpr size_t WS_H = WS_MIXIN + al256((size_t)MROWS * D * 2);
constexpr size_t WS_HG = WS_H + al256((size_t)MROWS * D * 4);
constexpr size_t WS_MKB = WS_HG + al256((size_t)MROWS * D * 2);
constexpr size_t WS_MVT = WS_MKB + al256((size_t)1024 * D * 2);
constexpr size_t WS_OG = WS_MVT + al256((size_t)1024 * D * 2);
constexpr size_t WS_GU = WS_OG + al256((size_t)MP * 1024 * 4);
constexpr size_t WS_SSQ1 = WS_GU + al256((size_t)MROWS * 2 * DFF * 2);
constexpr size_t WS_SSQ2 = WS_SSQ1 + al256((size_t)MROWS * 32 * 4);
constexpr size_t WS_SSQ3 = WS_SSQ2 + al256((size_t)MROWS * 32 * 4);
constexpr size_t WS_F = WS_SSQ3 + al256((size_t)MROWS * 32 * 4);
constexpr size_t WS_BAR = WS_F + al256((size_t)MROWS * 512 * 4);
constexpr size_t WS_END = WS_BAR + al256((size_t)(XCD_BAR_WORDS + 64) * 4);
constexpr size_t O_Y = 0, O_CONV_P = 17825792, O_GLA_P = 17833984, O_FFN_P = 18358272, O_MK = 18403328, O_MV = 20500480, O_CONV_S = 22597632, O_GLA_S = 22859776, O_FFN_S = 39636992;
constexpr int LDS_BYTES = 147456;
constexpr size_t GL_SST_OFF = 67108864, GL_EL_OFF = 67108864 + 33554432;

struct Args { const float* in[28]; float* out; unsigned char* ws; };
enum { I_XP = 0, I_XS, I_MEM, I_CCONV, I_SGLA, I_CFFN, I_CMK, I_CMV, I_NMIX, I_WIN, I_CONVW, I_WG2, I_BG, I_GLAN, I_WOUT, I_NX, I_NMEM, I_WXQ, I_WXK, I_WXV, I_WXO, I_NF, I_WFG, I_WFU, I_FCW, I_FCB, I_WFD, I_NFIN };

__device__ __forceinline__ float bflo(unsigned w) { return __uint_as_float(w << 16); }
__device__ __forceinline__ float bfhi(unsigned w) { return __uint_as_float(w & 0xffff0000u); }
__device__ __forceinline__ float bf2f(bf16_t b) { return __uint_as_float(((unsigned)b) << 16); }
__device__ __forceinline__ bf16_t f2bf(float f) { unsigned u = __float_as_uint(f); u += 0x7FFFu + ((u >> 16) & 1u); return (bf16_t)(u >> 16); }
__device__ __forceinline__ float silu_f(float x) { return x * __builtin_amdgcn_rcpf(1.0f + __expf(-x)); }
__device__ __forceinline__ float log_forget(float z) { const float ls = fminf(z, 0.f) - log1pf(__expf(-fabsf(z))); return ls * 0.0625f; }
template <int CTRL> __device__ __forceinline__ float dpp_f(float x) { return __int_as_float(__builtin_amdgcn_update_dpp(0, __float_as_int(x), CTRL, 0xf, 0xf, false)); }
__device__ __forceinline__ float rdl(float x, int l) { return __int_as_float(__builtin_amdgcn_readlane(__float_as_int(x), l)); }
__device__ __forceinline__ float wave_sum(float v) {
    v += dpp_f<0xB1>(v);
    v += dpp_f<0x4E>(v);
    v += dpp_f<0x141>(v);
    v += dpp_f<0x140>(v);
    return (rdl(v, 0) + rdl(v, 16)) + (rdl(v, 32) + rdl(v, 48)); }
__device__ __forceinline__ float wave_max(float v) {
    v = fmaxf(v, dpp_f<0xB1>(v)); v = fmaxf(v, dpp_f<0x4E>(v)); v = fmaxf(v, dpp_f<0x141>(v)); v = fmaxf(v, dpp_f<0x140>(v));
    return fmaxf(fmaxf(rdl(v, 0), rdl(v, 16)), fmaxf(rdl(v, 32), rdl(v, 48))); }
__device__ __forceinline__ void unpack8(const u32x4 w, float (&f)[8]) { f[0] = bflo(w.x); f[1] = bfhi(w.x); f[2] = bflo(w.y); f[3] = bfhi(w.y); f[4] = bflo(w.z); f[5] = bfhi(w.z); f[6] = bflo(w.w); f[7] = bfhi(w.w); }

constexpr int TT_WIN = 800, TT_SQ = 256, TT_FF = 704, TT_TOTAL = 800 + 5 * 256 + 3 * 704;
__device__ __forceinline__ void tr_decode(const Args& a, int gi, const float*& src, bf16_t*& dst, int& K, int& N, int& k0, int& n0, int& ilv) {
    unsigned char* ws = a.ws; int nkt; ilv = 0;
    if (gi < TT_WIN) { src = a.in[I_WIN]; dst = (bf16_t*)(ws + WS_WT_IN); K = D; N = NIN; nkt = 32; }
    else { gi -= TT_WIN;
        if (gi < 5 * TT_SQ) { const int j = gi >> 8; gi &= 255; K = D; N = D; nkt = 32;
            { const float* p0 = a.in[I_WXK]; const float* p1 = a.in[I_WXV]; const float* p2 = a.in[I_WOUT]; const float* p3 = a.in[I_WXQ]; const float* p4 = a.in[I_WXO];
              src = j == 0 ? p0 : j == 1 ? p1 : j == 2 ? p2 : j == 3 ? p3 : p4; }
            dst = (bf16_t*)(ws + (j <= 1 ? WS_WT_XKV : j == 2 ? WS_WT_OUT : j == 3 ? WS_WT_XQ : WS_WT_XO)) + (j == 1 ? (size_t)D * D : 0); }
        else { gi -= 5 * TT_SQ;
            if (gi < TT_FF) { src = a.in[I_WFG]; dst = (bf16_t*)(ws + WS_WT_FGU); K = D; N = DFF; nkt = 32; ilv = 1; }
            else if (gi < 2 * TT_FF) { gi -= TT_FF; src = a.in[I_WFU]; dst = (bf16_t*)(ws + WS_WT_FGU); K = D; N = DFF; nkt = 32; ilv = 2; }
            else { gi -= 2 * TT_FF; src = a.in[I_WFD]; dst = (bf16_t*)(ws + WS_WT_FD); K = DFF; N = D; nkt = 88; } } }
    k0 = (gi % nkt) * 64; n0 = (gi / nkt) * 256;
}
constexpr int TT_EARLY = TT_WIN + 2 * TT_SQ;
__device__ __forceinline__ void phase_transposes(const Args& a, float* tile, int lo, int hi, unsigned* ctr, volatile int* qslot) {
    const int tid = tid_opq(), r = tid >> 6, c4 = (tid & 63) * 4;
    int gi;
    if (ctr) { if (tid == 0) *qslot = lo + (int)atomicAdd(ctr, 1u); __syncthreads(); gi = *qslot; __syncthreads(); } else gi = lo + blockIdx.x;
    if (gi >= hi) return;
    const float* src; bf16_t* dst; int K, N, k0, n0, ilv; f32x4 v[8];
    tr_decode(a, gi, src, dst, K, N, k0, n0, ilv);
#pragma unroll
    for (int i = 0; i < 8; ++i) { v[i] = (f32x4){0.f, 0.f, 0.f, 0.f}; if (n0 + c4 < N) v[i] = __builtin_nontemporal_load((const f32x4*)(src + (size_t)(k0 + r + 8 * i) * N + n0 + c4)); }
    for (;;) {
#pragma unroll
        for (int i = 0; i < 8; ++i) { float* tp = tile + (r + 8 * i) * 257 + c4; tp[0] = v[i][0]; tp[1] = v[i][1]; tp[2] = v[i][2]; tp[3] = v[i][3]; }
        if (ctr && tid == 0) *qslot = lo + (int)atomicAdd(ctr, 1u);
        __syncthreads();
        const int nrow = n0 + (tid >> 1);
        bf16_t* cdst = dst + (size_t)(ilv ? ((nrow >> 7) * 256 + (nrow & 127) + (ilv == 2 ? 128 : 0)) : nrow) * K + k0 + (tid & 1) * 32;
        gi = ctr ? *qslot : gi + (int)gridDim.x; const bool more = gi < hi;
        if (more) { tr_decode(a, gi, src, dst, K, N, k0, n0, ilv);
#pragma unroll
            for (int i = 0; i < 8; ++i) { v[i] = (f32x4){0.f, 0.f, 0.f, 0.f}; if (n0 + c4 < N) v[i] = __builtin_nontemporal_load((const f32x4*)(src + (size_t)(k0 + r + 8 * i) * N + n0 + c4)); } }
        { const float* tp = tile + ((tid & 1) * 32) * 257 + (tid >> 1);
#pragma unroll
            for (int q = 0; q < 4; ++q) { u32x4 w; w.x = pg8::cvt_pk_bf16(tp[(q * 8 + 0) * 257], tp[(q * 8 + 1) * 257]); w.y = pg8::cvt_pk_bf16(tp[(q * 8 + 2) * 257], tp[(q * 8 + 3) * 257]);
                w.z = pg8::cvt_pk_bf16(tp[(q * 8 + 4) * 257], tp[(q * 8 + 5) * 257]); w.w = pg8::cvt_pk_bf16(tp[(q * 8 + 6) * 257], tp[(q * 8 + 7) * 257]);
                *(u32x4*)(cdst + q * 8) = w; } }
        __syncthreads();
        if (!more) break;
    }
}
__device__ __forceinline__ const float* prep_row_src(const Args& a, int row) { return row < MP ? a.in[I_XP] + (size_t)row * D : row < MROWS ? a.in[I_XS] + (size_t)(row - MP) * D : a.in[I_MEM] + (size_t)(row - MROWS) * D; }
__device__ __forceinline__ void phase_prep(const Args& a, float* lds) {
    unsigned char* ws = a.ws;
    phase_transposes(a, lds, 0, TT_EARLY, nullptr, nullptr);
    const int lane = tid_opq() & 63, gw = blockIdx.x * 8 + (tid_opq() >> 6), nw = gridDim.x * 8;
    int row = gw; if (row >= MROWS + 1024) return;
    f32x4 v[8];
    { const float* x = prep_row_src(a, row);
#pragma unroll
      for (int i = 0; i < 8; ++i) v[i] = __builtin_nontemporal_load((const f32x4*)(x + (i * 64 + lane) * 4)); }
    for (;;) {
        const int nrow = row + nw; const bool more = nrow < MROWS + 1024;
        f32x4 nv[8];
        if (more) { const float* x = prep_row_src(a, nrow);
#pragma unroll
            for (int i = 0; i < 8; ++i) nv[i] = __builtin_nontemporal_load((const f32x4*)(x + (i * 64 + lane) * 4)); }
        float ss = 0.f;
#pragma unroll
        for (int i = 0; i < 8; ++i) ss += (v[i][0] * v[i][0] + v[i][1] * v[i][1]) + (v[i][2] * v[i][2] + v[i][3] * v[i][3]);
        ss = wave_sum(ss); const float rs = rsqrtf(ss * (1.0f / 2048.0f) + 1e-6f);
        const float* gain = row < MROWS ? a.in[I_NMIX] : a.in[I_NMEM];
        bf16_t* o = row < MROWS ? (bf16_t*)(ws + WS_XN) + (size_t)row * D : (bf16_t*)(ws + WS_MEMN) + (size_t)(row - MROWS) * D;
#pragma unroll
        for (int i = 0; i < 8; ++i) { const f32x4 g = *(const f32x4*)(gain + (i * 64 + lane) * 4); u32x2 w; w.x = pg8::cvt_pk_bf16(v[i][0] * rs * g[0], v[i][1] * rs * g[1]); w.y = pg8::cvt_pk_bf16(v[i][2] * rs * g[2], v[i][3] * rs * g[3]);
            *(u32x2*)(o + (i * 64 + lane) * 4) = w; }
        if (!more) break;
#pragma unroll
        for (int i = 0; i < 8; ++i) v[i] = nv[i];
        row = nrow;
    }
}


__device__ __forceinline__ void gla_prompt_item(const Args& a, int item, float* lds) {
    const int tid = tid_opq(), b = item >> 6, h = (item >> 4) & 3, sl = item & 15;
    float* qs = lds; float* ks = qs + 4096; float* fs = ks + 4096; float* vs = fs + 4096; float* opart = vs + 512;
    const bf16_t* proj = (const bf16_t*)(a.ws + WS_PROJ) + (size_t)(b * 2048) * NINP;
    const float* Fg = (const float*)(a.ws + WS_F) + (size_t)(b * 2048) * 512 + h * 128;
    float* og = (float*)(a.ws + WS_OG);
    const int tt = tid >> 4, sub = tid & 15;
    const int dv = tid & 15, dkg = tid >> 4;
    float s0 = 0.f, s1 = 0.f, s2 = 0.f, s3 = 0.f;
    u32x4 rq, rk; f32x4 rf0, rf1; bf16_t rv;
    { const bf16_t* row = proj + (size_t)tt * NINP; rq = *(const u32x4*)(row + C_Q + h * 128 + sub * 8); rk = *(const u32x4*)(row + C_K + h * 128 + sub * 8);
      rf0 = *(const f32x4*)(Fg + (size_t)tt * 512 + sub * 8); rf1 = *(const f32x4*)(Fg + (size_t)tt * 512 + sub * 8 + 4); rv = row[C_V + h * 256 + sl * 16 + sub]; }
    for (int n = 0; n < 64; ++n) {
        { float qf[8], kf[8]; unpack8(rq, qf); unpack8(rk, kf);
            float* fp = fs + tt * 128 + sub * 8; float* qp = qs + tt * 128 + sub * 8; float* kp = ks + tt * 128 + sub * 8;
            *(f32x4*)fp = rf0; *(f32x4*)(fp + 4) = rf1;
            *(f32x4*)qp = (f32x4){qf[0], qf[1], qf[2], qf[3]} * 0.08838834764831845f; *(f32x4*)(qp + 4) = (f32x4){qf[4], qf[5], qf[6], qf[7]} * 0.08838834764831845f;
            *(f32x4*)kp = (f32x4){kf[0], kf[1], kf[2], kf[3]}; *(f32x4*)(kp + 4) = (f32x4){kf[4], kf[5], kf[6], kf[7]};
            vs[tt * 16 + sub] = bf2f(rv); }
        __syncthreads();
        if (n + 1 < 64) { const bf16_t* row = proj + (size_t)((n + 1) * 32 + tt) * NINP; rq = *(const u32x4*)(row + C_Q + h * 128 + sub * 8); rk = *(const u32x4*)(row + C_K + h * 128 + sub * 8);
            const float* fr_ = Fg + (size_t)((n + 1) * 32 + tt) * 512 + sub * 8; rf0 = *(const f32x4*)fr_; rf1 = *(const f32x4*)(fr_ + 4); rv = row[C_V + h * 256 + sl * 16 + sub]; }
#pragma unroll 8
        for (int t = 0; t < 32; ++t) {
            const f32x4 f4 = *(const f32x4*)(fs + t * 128 + dkg * 4), k4 = *(const f32x4*)(ks + t * 128 + dkg * 4), q4 = *(const f32x4*)(qs + t * 128 + dkg * 4); const float v = vs[t * 16 + dv];
            s0 = f4[0] * s0 + k4[0] * v; s1 = f4[1] * s1 + k4[1] * v; s2 = f4[2] * s2 + k4[2] * v; s3 = f4[3] * s3 + k4[3] * v;
            opart[dkg * 528 + t * 16 + dv] = (q4[0] * s0 + q4[1] * s1) + (q4[2] * s2 + q4[3] * s3); }
        __syncthreads();
        { float o = 0.f;
#pragma unroll 8
            for (int g = 0; g < 32; ++g) o += opart[g * 528 + tid];
            og[(size_t)(b * 2048 + n * 32 + (tid >> 4)) * 1024 + h * 256 + sl * 16 + (tid & 15)] = o; }
    }
    float* so = a.out + O_GLA_P + ((size_t)((b * 4 + h) * 128 + dkg * 4)) * 256 + sl * 16 + dv;
    so[0] = s0; so[256] = s1; so[512] = s2; so[768] = s3;
    __syncthreads();
}

__device__ __forceinline__ void gla_sample_item(const Args& a, int it, float* lds) {
    const int tid = tid_opq(), b = it >> 2, h = it & 3, lane = tid & 63, wid = tid >> 6;
    float* qs = lds; float* ks = qs + 512; float* fs = ks + 512; float* vs = fs + 512; float* red = vs + 1024; float* rsum = red + 512;
    const bf16_t* proj = (const bf16_t*)(a.ws + WS_PROJ) + (size_t)(MP + b * 4) * NINP;
    { const int t = tid >> 7, dk = tid & 127; const bf16_t* row = proj + (size_t)t * NINP;
        fs[tid] = __expf(((const float*)(a.ws + WS_F))[(size_t)(MP + b * 4 + t) * 512 + h * 128 + dk]); qs[tid] = bf2f(row[C_Q + h * 128 + dk]) * 0.08838834764831845f; ks[tid] = bf2f(row[C_K + h * 128 + dk]); }
#pragma unroll
    for (int i = 0; i < 2; ++i) { const int idx = tid + i * 512, t = idx >> 8, d = idx & 255; vs[idx] = bf2f(proj[(size_t)t * NINP + C_V + h * 256 + d]); }
    const int dv = tid & 255, half = tid >> 8;
    float s[64];
    const float* sp = a.in[I_SGLA] + ((size_t)((b * 4 + h) * 128 + half * 64)) * 256 + dv;
#pragma unroll
    for (int j = 0; j < 64; ++j) s[j] = __builtin_nontemporal_load(sp + (size_t)j * 256);
    __syncthreads();
    float ov[4];
#pragma unroll
    for (int t = 0; t < 4; ++t) { const float v = vs[t * 256 + dv]; float po = 0.f;
#pragma unroll
        for (int j = 0; j < 64; j += 4) { const f32x4 f4 = *(const f32x4*)(fs + t * 128 + half * 64 + j), k4 = *(const f32x4*)(ks + t * 128 + half * 64 + j), q4 = *(const f32x4*)(qs + t * 128 + half * 64 + j);
#pragma unroll
            for (int e = 0; e < 4; ++e) { s[j + e] = f4[e] * s[j + e] + k4[e] * v; po += q4[e] * s[j + e]; } }
        red[t * 512 + half * 256 + dv] = po; ov[t] = po; }
    float* so = a.out + O_GLA_S + ((size_t)((b * 4 + h) * 128 + half * 64)) * 256 + dv;
#pragma unroll
    for (int j = 0; j < 64; ++j) __builtin_nontemporal_store(s[j], so + (size_t)j * 256);
    __syncthreads();
    float* rs2 = red + 2048;
#pragma unroll
    for (int t = 0; t < 4; ++t) { const float o = red[t * 512 + dv] + red[t * 512 + 256 + dv]; ov[t] = o; const float ss = wave_sum(o * o); if (lane == 0) rs2[t * 8 + wid] = ss; }
    __syncthreads();
    if (half == 0) {
#pragma unroll
        for (int t = 0; t < 4; ++t) { const float tot = (rs2[t * 8] + rs2[t * 8 + 1]) + (rs2[t * 8 + 2] + rs2[t * 8 + 3]); const float rstd = rsqrtf(tot * (1.0f / 256.0f) + 1e-6f);
            const float rg = bf2f(proj[(size_t)t * NINP + C_R + h * 256 + dv]);
            ((bf16_t*)(a.ws + WS_MIXIN))[(size_t)(MP + b * 4 + t) * D + 1024 + h * 256 + dv] = f2bf(ov[t] * rstd * a.in[I_GLAN][h * 256 + dv] * silu_f(rg)); } }
    __syncthreads();
}

struct RowRaw { u32x4 bg[2], c0[2], v0[2], c1[2], v1[2], c2[2], v2[2], g1a, g1b; };
__device__ __forceinline__ void rows_pre_load(const bf16_t* __restrict__ projb, int row, int lane, RowRaw& R) {
    const bool samp = row >= MP; const int t = samp ? ((row - MP) & 3) : (row & 2047);
    const bf16_t* pr = projb + (size_t)row * NINP; const int b1 = t >= 1 ? NINP : 0, b2 = t >= 2 ? 2 * NINP : 0;
#pragma unroll
    for (int i = 0; i < 2; ++i) { const int c = i * 512 + lane * 8;
        R.bg[i] = *(const u32x4*)(pr + C_BG + c); R.c2[i] = *(const u32x4*)(pr + C_CG + c); R.v2[i] = *(const u32x4*)(pr + C_VC + c);
        R.c1[i] = *(const u32x4*)(pr - b1 + C_CG + c); R.v1[i] = *(const u32x4*)(pr - b1 + C_VC + c);
        R.c0[i] = *(const u32x4*)(pr - b2 + C_CG + c); R.v0[i] = *(const u32x4*)(pr - b2 + C_VC + c); }
    R.g1a = *(const u32x4*)(pr + C_G1); R.g1b = *(const u32x4*)(pr + C_G1 + 8);
}
__device__ __forceinline__ void rows_pre_compute(const Args& a, int row, int lane, const RowRaw& R) {
    bf16_t* mix = (bf16_t*)(a.ws + WS_MIXIN); const float* cw = a.in[I_CONVW];
    const bool samp = row >= MP; const int t = samp ? ((row - MP) & 3) : (row & 2047), bi = samp ? ((row - MP) >> 2) : (row >> 11);
#pragma unroll
    for (int i = 0; i < 2; ++i) { const int c = i * 512 + lane * 8;
        float bg[8], cgv[8], vcv[8], u2[8], u1[8], u0[8];
        unpack8(R.bg[i], bg); unpack8(R.c2[i], cgv); unpack8(R.v2[i], vcv);
#pragma unroll
        for (int j = 0; j < 8; ++j) u2[j] = cgv[j] * vcv[j];
        if (t >= 1) { unpack8(R.c1[i], cgv); unpack8(R.v1[i], vcv);
#pragma unroll
            for (int j = 0; j < 8; ++j) u1[j] = cgv[j] * vcv[j]; }
        else if (samp) { const float* cp = a.in[I_CCONV] + (size_t)(bi * 2 + 1) * 1024 + c;
#pragma unroll
            for (int j = 0; j < 8; ++j) u1[j] = cp[j]; }
        else {
#pragma unroll
            for (int j = 0; j < 8; ++j) u1[j] = 0.f; }
        if (t >= 2) { unpack8(R.c0[i], cgv); unpack8(R.v0[i], vcv);
#pragma unroll
            for (int j = 0; j < 8; ++j) u0[j] = cgv[j] * vcv[j]; }
        else if (samp) { const float* cp = a.in[I_CCONV] + (size_t)(bi * 2 + t) * 1024 + c;
#pragma unroll
            for (int j = 0; j < 8; ++j) u0[j] = cp[j]; }
        else {
#pragma unroll
            for (int j = 0; j < 8; ++j) u0[j] = 0.f; }
        float o[8];
#pragma unroll
        for (int j = 0; j < 8; ++j) o[j] = bg[j] * (cw[c + j] * u0[j] + cw[1024 + c + j] * u1[j] + cw[2048 + c + j] * u2[j]);
        u32x4 w; w.x = pg8::cvt_pk_bf16(o[0], o[1]); w.y = pg8::cvt_pk_bf16(o[2], o[3]); w.z = pg8::cvt_pk_bf16(o[4], o[5]); w.w = pg8::cvt_pk_bf16(o[6], o[7]);
        *(u32x4*)(mix + (size_t)row * D + c) = w;
        float* cn = nullptr;
        if (!samp) { if (t >= 2046) cn = a.out + O_CONV_P + (size_t)(bi * 2 + (t - 2046)) * 1024 + c; }
        else { if (t >= 2) cn = a.out + O_CONV_S + (size_t)(bi * 2 + (t - 2)) * 1024 + c; }
        if (cn) {
#pragma unroll
            for (int j = 0; j < 8; ++j) cn[j] = u2[j]; }
    }
    {
        float g1[16]; { float t8[8]; unpack8(R.g1a, t8);
#pragma unroll
            for (int j = 0; j < 8; ++j) g1[j] = t8[j];
            unpack8(R.g1b, t8);
#pragma unroll
            for (int j = 0; j < 8; ++j) g1[8 + j] = t8[j]; }
        f32x4 z0 = *(const f32x4*)(a.in[I_BG] + lane * 8), z1 = *(const f32x4*)(a.in[I_BG] + lane * 8 + 4);
#pragma unroll
        for (int r = 0; r < 16; ++r) { z0 += *(const f32x4*)(a.in[I_WG2] + r * 512 + lane * 8) * g1[r]; z1 += *(const f32x4*)(a.in[I_WG2] + r * 512 + lane * 8 + 4) * g1[r]; }
        f32x4 f0, f1;
#pragma unroll
        for (int j = 0; j < 4; ++j) { f0[j] = log_forget(z0[j]); f1[j] = log_forget(z1[j]); }
        float* fo = (float*)(a.ws + WS_F) + (size_t)row * 512 + lane * 8; *(f32x4*)fo = f0; *(f32x4*)(fo + 4) = f1; }
}
__device__ __forceinline__ void phase_rows_pre(const Args& a) {
    const int lane = tid_opq() & 63, wid = tid_opq() >> 6;
    const bf16_t* projb = (const bf16_t*)(a.ws + WS_PROJ);
    const int per = (MROWS + (int)gridDim.x - 1) / (int)gridDim.x, base = blockIdx.x * per, lim = (base + per < MROWS) ? base + per : MROWS;
    int row = base + wid; if (row >= lim) return;
    RowRaw cur; rows_pre_load(projb, row, lane, cur);
    for (;;) {
        const int nrow = row + 8; const bool more = nrow < lim;
        RowRaw nxt; if (more) rows_pre_load(projb, nrow, lane, nxt); else nxt = cur;
        rows_pre_compute(a, row, lane, cur);
        if (!more) break;
        cur = nxt; row = nrow;
    }
}
__device__ __forceinline__ void phase_gla_norm(const Args& a) {
    const int lane = tid_opq() & 63, gw = blockIdx.x * 8 + (tid_opq() >> 6), nw = gridDim.x * 8;
    const bf16_t* projb = (const bf16_t*)(a.ws + WS_PROJ); bf16_t* mix = (bf16_t*)(a.ws + WS_MIXIN);
    for (int row = gw; row < MP; row += nw) {
        const bf16_t* pr = projb + (size_t)row * NINP;
        {
            const float* og = (const float*)(a.ws + WS_OG) + (size_t)row * 1024;
#pragma unroll
            for (int h = 0; h < 4; ++h) { const f32x4 o4 = *(const f32x4*)(og + h * 256 + lane * 4);
                const float ss = wave_sum((o4[0] * o4[0] + o4[1] * o4[1]) + (o4[2] * o4[2] + o4[3] * o4[3])); const float rstd = rsqrtf(ss * (1.0f / 256.0f) + 1e-6f);
                const f32x4 gn = *(const f32x4*)(a.in[I_GLAN] + h * 256 + lane * 4); const u32x2 rw = *(const u32x2*)(pr + C_R + h * 256 + lane * 4);
                const float r0 = bflo(rw.x), r1 = bfhi(rw.x), r2 = bflo(rw.y), r3 = bfhi(rw.y);
                u32x2 w; w.x = pg8::cvt_pk_bf16(o4[0] * rstd * gn[0] * silu_f(r0), o4[1] * rstd * gn[1] * silu_f(r1)); w.y = pg8::cvt_pk_bf16(o4[2] * rstd * gn[2] * silu_f(r2), o4[3] * rstd * gn[3] * silu_f(r3));
                *(u32x2*)(mix + (size_t)row * D + 1024 + h * 256 + lane * 4) = w; }
        }
    }
}

constexpr int GL_LDK = 72, GL_LDQ = 136;
__device__ __forceinline__ void gla_cum(const float* __restrict__ lf_base, int d, int qt, float* part, float (&cum)[16], float& Lval) {
    float run = 0.f;
#pragma unroll
    for (int jj = 0; jj < 16; ++jj) { run += lf_base[(size_t)(qt * 16 + jj) * 512 + d]; cum[jj] = run; }
    part[qt * 128 + d] = run;
    __syncthreads();
    const float p0 = part[d], p1 = part[128 + d], p2 = part[256 + d], p3 = part[384 + d];
    const float off = (qt > 0 ? p0 : 0.f) + (qt > 1 ? p1 : 0.f) + (qt > 2 ? p2 : 0.f);
#pragma unroll
    for (int jj = 0; jj < 16; ++jj) cum[jj] += off;
    Lval = (p0 + p1) + (p2 + p3);
}
__device__ __forceinline__ void gla_stage_vt(const bf16_t* __restrict__ proj_rows, int h, bf16_t* VT, int tid) {
    const int v = tid & 255, jh = tid >> 8; const bf16_t* src = proj_rows + (size_t)(jh * 32) * NINP + C_V + h * 256 + v;
#pragma unroll
    for (int q = 0; q < 4; ++q) { unsigned w[4];
#pragma unroll
        for (int e = 0; e < 4; ++e) { const unsigned lo = src[(size_t)(q * 8 + 2 * e) * NINP], hi = src[(size_t)(q * 8 + 2 * e + 1) * NINP]; w[e] = lo | (hi << 16); }
        u32x4 ww; ww.x = w[0]; ww.y = w[1]; ww.z = w[2]; ww.w = w[3]; *(u32x4*)(VT + v * GL_LDK + jh * 32 + q * 8) = ww; }
}
__device__ __forceinline__ void gla_pass_a(const Args& a, int item, unsigned char* ldsb) {
    const int tid = tid_opq(), lane = tid & 63, wid = tid >> 6, fr = lane & 15, fq = lane >> 4;
    const int b = item >> 7, h = (item >> 5) & 3, n = item & 31, row0 = b * 2048 + n * 64;
    bf16_t* KlT = (bf16_t*)ldsb; bf16_t* VT = KlT + 128 * GL_LDK; float* part = (float*)(VT + 256 * GL_LDK);
    const bf16_t* prow = (const bf16_t*)(a.ws + WS_PROJ) + (size_t)row0 * NINP;
    { const int d = tid & 127, qt = tid >> 7; float cum[16], Lv;
        gla_cum((const float*)(a.ws + WS_F) + (size_t)row0 * 512 + h * 128, d, qt, part, cum, Lv);
        const bf16_t* kp = prow + (size_t)(qt * 16) * NINP + C_K + h * 128 + d; unsigned w[8];
#pragma unroll
        for (int e = 0; e < 8; ++e) { const float k0 = bf2f(kp[(size_t)(2 * e) * NINP]) * __expf(Lv - cum[2 * e]), k1 = bf2f(kp[(size_t)(2 * e + 1) * NINP]) * __expf(Lv - cum[2 * e + 1]); w[e] = pg8::cvt_pk_bf16(k0, k1); }
        u32x4 w0, w1; w0.x = w[0]; w0.y = w[1]; w0.z = w[2]; w0.w = w[3]; w1.x = w[4]; w1.y = w[5]; w1.z = w[6]; w1.w = w[7];
        *(u32x4*)(KlT + d * GL_LDK + qt * 16) = w0; *(u32x4*)(KlT + d * GL_LDK + qt * 16 + 8) = w1;
        if (qt == 0) ((float*)(a.ws + WS_GU + GL_EL_OFF))[(size_t)item * 128 + d] = __expf(Lv); }
    gla_stage_vt(prow, h, VT, tid);
    __syncthreads();
    { const bf16x8 x0 = *(const bf16x8*)(KlT + (wid * 16 + fr) * GL_LDK + fq * 8), x1 = *(const bf16x8*)(KlT + (wid * 16 + fr) * GL_LDK + 32 + fq * 8);
        float* kc = (float*)(a.ws + WS_GU) + (size_t)item * 32768 + wid * 16 + 4 * fq;
#pragma unroll 4
        for (int vt = 0; vt < 16; ++vt) { const bf16x8 y0 = *(const bf16x8*)(VT + (vt * 16 + fr) * GL_LDK + fq * 8), y1 = *(const bf16x8*)(VT + (vt * 16 + fr) * GL_LDK + 32 + fq * 8);
            f32x4 acc = (f32x4){0.f, 0.f, 0.f, 0.f};
            acc = __builtin_amdgcn_mfma_f32_16x16x32_bf16(x0, y0, acc, 0, 0, 0); acc = __builtin_amdgcn_mfma_f32_16x16x32_bf16(x1, y1, acc, 0, 0, 0);
            *(f32x4*)(kc + (size_t)(vt * 16 + fr) * 128) = acc; } }
    __syncthreads();
}
__device__ __forceinline__ void gla_pass_b(const Args& a) {
    const float* KC = (const float*)(a.ws + WS_GU); const float* EL = (const float*)(a.ws + WS_GU + GL_EL_OFF); bf16_t* SST = (bf16_t*)(a.ws + WS_GU + GL_SST_OFF);
    for (int gid = blockIdx.x * 512 + tid_opq(); gid < 131072; gid += gridDim.x * 512) {
        const int bh = gid >> 13, v = (gid >> 5) & 255, d4 = (gid & 31) * 4;
        f32x4 s = (f32x4){0.f, 0.f, 0.f, 0.f};
#pragma unroll 8
        for (int n = 0; n < 32; ++n) { const int item = bh * 32 + n;
            const f32x4 kc = *(const f32x4*)(KC + (size_t)item * 32768 + v * 128 + d4), el = *(const f32x4*)(EL + (size_t)item * 128 + d4);
            u32x2 w; w.x = pg8::cvt_pk_bf16(s[0], s[1]); w.y = pg8::cvt_pk_bf16(s[2], s[3]); *(u32x2*)(SST + (size_t)item * 32768 + v * 128 + d4) = w;
            s = el * s + kc; }
        float* so = a.out + O_GLA_P + ((size_t)(bh * 128 + d4)) * 256 + v; so[0] = s[0]; so[256] = s[1]; so[512] = s[2]; so[768] = s[3];
    }
}
__device__ __forceinline__ void gla_pass_c(const Args& a, int item, unsigned char* ldsb) {
    const int tid = tid_opq(), lane = tid & 63, wid = tid >> 6, fr = lane & 15, fq = lane >> 4;
    const int b = item >> 7, h = (item >> 5) & 3, n = item & 31, row0 = b * 2048 + n * 64;
    bf16_t* Qd = (bf16_t*)ldsb; bf16_t* Kd = Qd + 64 * GL_LDQ; bf16_t* VT = Kd + 64 * GL_LDQ; bf16_t* SS = VT + 256 * GL_LDK; float* part = (float*)(SS + 256 * GL_LDQ); float* red = part + 512;
    const bf16_t* sst = (const bf16_t*)(a.ws + WS_GU + GL_SST_OFF) + (size_t)item * 32768;
    u32x4 sr[8];
#pragma unroll
    for (int i = 0; i < 8; ++i) sr[i] = *(const u32x4*)(sst + (size_t)(tid + 512 * i) * 8);
    const bf16_t* prow = (const bf16_t*)(a.ws + WS_PROJ) + (size_t)row0 * NINP;
    { const int d = tid & 127, qt = tid >> 7; float cum[16], Lv;
        const bf16_t* qp = prow + (size_t)(qt * 16) * NINP + C_Q + h * 128 + d; const bf16_t* kp = qp + (C_K - C_Q);
        bf16_t qraw[16], kraw[16];
#pragma unroll
        for (int jj = 0; jj < 16; ++jj) { qraw[jj] = qp[(size_t)jj * NINP]; kraw[jj] = kp[(size_t)jj * NINP]; }
        const int vv = tid & 255, jh = tid >> 8; const bf16_t* vsrc = prow + (size_t)(jh * 32) * NINP + C_V + h * 256 + vv; unsigned vw[16];
#pragma unroll
        for (int e = 0; e < 16; ++e) { const unsigned lo = vsrc[(size_t)(2 * e) * NINP], hi = vsrc[(size_t)(2 * e + 1) * NINP]; vw[e] = lo | (hi << 16); }
        gla_cum((const float*)(a.ws + WS_F) + (size_t)row0 * 512 + h * 128, d, qt, part, cum, Lv);
#pragma unroll
        for (int jj = 0; jj < 16; ++jj) { const float e = __expf(cum[jj]);
            Qd[(qt * 16 + jj) * GL_LDQ + d] = f2bf(bf2f(qraw[jj]) * 0.08838834764831845f * e);
            Kd[(qt * 16 + jj) * GL_LDQ + d] = f2bf(bf2f(kraw[jj]) * __builtin_amdgcn_rcpf(e)); }
#pragma unroll
        for (int q = 0; q < 4; ++q) { u32x4 ww; ww.x = vw[4 * q]; ww.y = vw[4 * q + 1]; ww.z = vw[4 * q + 2]; ww.w = vw[4 * q + 3]; *(u32x4*)(VT + vv * GL_LDK + jh * 32 + q * 8) = ww; } }
#pragma unroll
    for (int i = 0; i < 8; ++i) { const int id = tid + 512 * i; *(u32x4*)(SS + (id >> 4) * GL_LDQ + (id & 15) * 8) = sr[i]; }
    __syncthreads();
    const int it = wid >> 1, vh = wid & 1;
    bf16x8 qf[4];
#pragma unroll
    for (int ks = 0; ks < 4; ++ks) qf[ks] = *(const bf16x8*)(Qd + (it * 16 + fr) * GL_LDQ + ks * 32 + fq * 8);
    f32x4 aa[4];
#pragma unroll
    for (int jt = 0; jt < 4; ++jt) { f32x4 acc = (f32x4){0.f, 0.f, 0.f, 0.f};
        if (jt <= it) {
#pragma unroll
            for (int ks = 0; ks < 4; ++ks) { const bf16x8 kf = *(const bf16x8*)(Kd + (jt * 16 + fr) * GL_LDQ + ks * 32 + fq * 8); acc = __builtin_amdgcn_mfma_f32_16x16x32_bf16(kf, qf[ks], acc, 0, 0, 0); }
            if (jt == it) {
#pragma unroll
                for (int e = 0; e < 4; ++e) if (4 * fq + e > fr) acc[e] = 0.f; } }
        aa[jt] = acc; }
    bf16x8 pa[2];
#pragma unroll
    for (int s = 0; s < 2; ++s) { const u32x4 w = pg8::pack8(aa[2 * s], aa[2 * s + 1]); pa[s] = __builtin_bit_cast(bf16x8, w); }
    f32x4 o[8]; float ss = 0.f;
#pragma unroll
    for (int vt = 0; vt < 8; ++vt) { const int vrow = (vh * 8 + vt) * 16 + fr; f32x4 acc = (f32x4){0.f, 0.f, 0.f, 0.f};
#pragma unroll
        for (int s = 0; s < 2; ++s) { const u32x2 lo = *(const u32x2*)(VT + vrow * GL_LDK + 32 * s + 4 * fq), hi = *(const u32x2*)(VT + vrow * GL_LDK + 32 * s + 16 + 4 * fq);
            u32x4 w; w.x = lo.x; w.y = lo.y; w.z = hi.x; w.w = hi.y; acc = __builtin_amdgcn_mfma_f32_16x16x32_bf16(__builtin_bit_cast(bf16x8, w), pa[s], acc, 0, 0, 0); }
#pragma unroll
        for (int ks = 0; ks < 4; ++ks) { const bf16x8 sf = *(const bf16x8*)(SS + vrow * GL_LDQ + ks * 32 + fq * 8); acc = __builtin_amdgcn_mfma_f32_16x16x32_bf16(sf, qf[ks], acc, 0, 0, 0); }
        o[vt] = acc; ss += (acc[0] * acc[0] + acc[1] * acc[1]) + (acc[2] * acc[2] + acc[3] * acc[3]); }
    ss += __shfl_xor(ss, 16); ss += __shfl_xor(ss, 32);
    if (fq == 0) red[(it * 16 + fr) * 2 + vh] = ss;
    __syncthreads();
    { const float tot = red[(it * 16 + fr) * 2] + red[(it * 16 + fr) * 2 + 1]; const float rstd = rsqrtf(tot * (1.0f / 256.0f) + 1e-6f);
        const int row = row0 + it * 16 + fr; const bf16_t* rg = prow + (size_t)(it * 16 + fr) * NINP + C_R + h * 256; bf16_t* mo = (bf16_t*)(a.ws + WS_MIXIN) + (size_t)row * D + 1024 + h * 256;
#pragma unroll
        for (int vt = 0; vt < 8; ++vt) { const int v0 = (vh * 8 + vt) * 16 + 4 * fq; const f32x4 gn = *(const f32x4*)(a.in[I_GLAN] + h * 256 + v0); const u32x2 rw = *(const u32x2*)(rg + v0);
            u32x2 w; w.x = pg8::cvt_pk_bf16(o[vt][0] * rstd * gn[0] * silu_f(bflo(rw.x)), o[vt][1] * rstd * gn[1] * silu_f(bfhi(rw.x)));
            w.y = pg8::cvt_pk_bf16(o[vt][2] * rstd * gn[2] * silu_f(bflo(rw.y)), o[vt][3] * rstd * gn[3] * silu_f(bfhi(rw.y)));
            *(u32x2*)(mo + v0) = w; } }
    __syncthreads();
}

constexpr int XA_LDK = 136, XA_LDV = 264, XA_BUF = 128 * 264;
__device__ __forceinline__ void xattn_prompt_item(const Args& a, int it, unsigned char* ldsb) {
    const int tid = tid_opq(), lane = tid & 63, wid = tid >> 6, fr = lane & 15, fq = lane >> 4;
    const int b = it >> 6, h = (it >> 4) & 3, tt = it & 15;
    const int r0 = b * 2048 + tt * 128 + wid * 16;
    bf16_t* buf0 = (bf16_t*)ldsb; bf16_t* buf1 = buf0 + 34816;
    const bf16_t* qp = (const bf16_t*)(a.ws + WS_XN) + (size_t)(r0 + fr) * D + h * 512 + fq * 8;
    const bf16_t* kg = (const bf16_t*)(a.ws + WS_MKB) + (size_t)(b * 256) * D + h * 512;
    const bf16_t* vg = (const bf16_t*)(a.ws + WS_MVT) + (size_t)(b * 2048 + h * 512) * 256;
    u32x4 rs[8];
#pragma unroll
    for (int i = 0; i < 8; ++i) { const int id = tid + 512 * i, row = id >> 4, sg = id & 15; rs[i] = *(const u32x4*)(kg + (size_t)row * D + sg * 8); }
#pragma unroll
    for (int i = 0; i < 8; ++i) { const int id = tid + 512 * i, row = id >> 4, sg = id & 15; *(u32x4*)(buf0 + row * XA_LDK + sg * 8) = rs[i]; }
    __syncthreads();
    f32x4 st[16];
#pragma unroll
    for (int n = 0; n < 16; ++n) st[n] = (f32x4){0.f, 0.f, 0.f, 0.f};
#pragma unroll
    for (int c = 0; c < 4; ++c) {
        bf16_t* cur = (c & 1) ? buf1 : buf0; bf16_t* nxt = (c & 1) ? buf0 : buf1;
        if (c < 3) {
#pragma unroll
            for (int i = 0; i < 8; ++i) { const int id = tid + 512 * i, row = id >> 4, sg = id & 15; rs[i] = *(const u32x4*)(kg + (size_t)row * D + (c + 1) * 128 + sg * 8); } }
        else {
#pragma unroll
            for (int i = 0; i < 8; ++i) { const int id = tid + 512 * i, row = id >> 5, sg = id & 31; rs[i] = *(const u32x4*)(vg + (size_t)row * 256 + sg * 8); } }
        bf16x8 qf[4];
#pragma unroll
        for (int ks = 0; ks < 4; ++ks) qf[ks] = *(const bf16x8*)(qp + c * 128 + ks * 32);
#pragma unroll
        for (int n = 0; n < 16; ++n) {
#pragma unroll
            for (int ks = 0; ks < 4; ++ks) { const bf16x8 kf = *(const bf16x8*)(cur + (n * 16 + fr) * XA_LDK + ks * 32 + fq * 8); st[n] = __builtin_amdgcn_mfma_f32_16x16x32_bf16(kf, qf[ks], st[n], 0, 0, 0); } }
        if (c < 3) {
#pragma unroll
            for (int i = 0; i < 8; ++i) { const int id = tid + 512 * i, row = id >> 4, sg = id & 15; *(u32x4*)(nxt + row * XA_LDK + sg * 8) = rs[i]; } }
        else {
#pragma unroll
            for (int i = 0; i < 8; ++i) { const int id = tid + 512 * i, row = id >> 5, sg = id & 31; *(u32x4*)(nxt + row * XA_LDV + sg * 8) = rs[i]; } }
        __syncthreads();
    }
    float mx = -3.0e38f;
#pragma unroll
    for (int n = 0; n < 16; ++n) mx = fmaxf(fmaxf(fmaxf(st[n][0], st[n][1]), fmaxf(st[n][2], st[n][3])), mx);
    mx = fmaxf(mx, __shfl_xor(mx, 16)); mx = fmaxf(mx, __shfl_xor(mx, 32));
    float sum = 0.f;
#pragma unroll
    for (int n = 0; n < 16; ++n) {
#pragma unroll
        for (int e = 0; e < 4; ++e) { const float p = __expf(st[n][e] - mx); st[n][e] = p; sum += p; } }
    sum += __shfl_xor(sum, 16); sum += __shfl_xor(sum, 32);
    const float inv = 1.0f / sum;
    bf16x8 pf[8];
#pragma unroll
    for (int i = 0; i < 8; ++i) { u32x4 w = pg8::pack8(st[2 * i], st[2 * i + 1]); pf[i] = __builtin_bit_cast(bf16x8, w); }
    bf16_t* op = (bf16_t*)(a.ws + WS_MIXIN) + (size_t)(r0 + fr) * D + h * 512 + 4 * fq;
#pragma unroll
    for (int c = 0; c < 4; ++c) {
        bf16_t* cur = (c & 1) ? buf1 : buf0; bf16_t* nxt = (c & 1) ? buf0 : buf1;
        if (c < 3) {
#pragma unroll
            for (int i = 0; i < 8; ++i) { const int id = tid + 512 * i, row = id >> 5, sg = id & 31; rs[i] = *(const u32x4*)(vg + (size_t)((c + 1) * 128 + row) * 256 + sg * 8); } }
#pragma unroll
        for (int dt = 0; dt < 8; ++dt) { f32x4 acc = (f32x4){0.f, 0.f, 0.f, 0.f};
#pragma unroll
            for (int i = 0; i < 8; ++i) { const bf16x8 vf = *(const bf16x8*)(cur + (dt * 16 + fr) * XA_LDV + i * 32 + fq * 8); acc = __builtin_amdgcn_mfma_f32_16x16x32_bf16(vf, pf[i], acc, 0, 0, 0); }
            u32x2 w; w.x = pg8::cvt_pk_bf16(acc[0] * inv, acc[1] * inv); w.y = pg8::cvt_pk_bf16(acc[2] * inv, acc[3] * inv);
            *(u32x2*)(op + c * 128 + dt * 16) = w; }
        if (c < 3) {
#pragma unroll
            for (int i = 0; i < 8; ++i) { const int id = tid + 512 * i, row = id >> 5, sg = id & 31; *(u32x4*)(nxt + row * XA_LDV + sg * 8) = rs[i]; } }
        __syncthreads();
    }
}
__device__ __forceinline__ void xattn_sample_item(const Args& a, int it, float* lds) {
    const int tid = tid_opq(), lane = tid & 63, wid = tid >> 6, fr = lane & 15, fq = lane >> 4, b = it >> 2, h = it & 3;
    float* sc = lds; float* pT = lds + 1024; float* red = lds + 2048;
    const float* Kc = a.in[I_CMK] + ((size_t)b * 1024 + h) * 512; const float* Vc = a.in[I_CMV] + ((size_t)b * 1024 + h) * 512;
    const bf16_t* qb = (const bf16_t*)(a.ws + WS_XN) + (size_t)(MP + b * 4 + (fr & 3)) * D + h * 512 + fq * 8;
    bf16x8 qf[16];
#pragma unroll
    for (int ks = 0; ks < 16; ++ks) { u32x4 w = *(const u32x4*)(qb + ks * 32); if (fr >= 4) w = (u32x4){0u, 0u, 0u, 0u}; qf[ks] = __builtin_bit_cast(bf16x8, w); }
#pragma unroll
    for (int n = 0; n < 2; ++n) { f32x4 acc = (f32x4){0.f, 0.f, 0.f, 0.f}; const float* kr = Kc + (size_t)(wid * 32 + n * 16 + fr) * 2048 + fq * 8;
#pragma unroll
        for (int ks = 0; ks < 16; ++ks) { const f32x4 k0 = __builtin_nontemporal_load((const f32x4*)(kr + ks * 32)), k1 = __builtin_nontemporal_load((const f32x4*)(kr + ks * 32 + 4));
            const u32x4 w = pg8::pack8(k0, k1); acc = __builtin_amdgcn_mfma_f32_16x16x32_bf16(__builtin_bit_cast(bf16x8, w), qf[ks], acc, 0, 0, 0); }
        if (fr < 4) {
#pragma unroll
            for (int e = 0; e < 4; ++e) sc[fr * 256 + wid * 32 + n * 16 + 4 * fq + e] = acc[e]; } }
    __syncthreads();
    if (wid < 4) { f32x4 s4 = *(const f32x4*)(sc + wid * 256 + lane * 4); const float mx = wave_max(fmaxf(fmaxf(s4[0], s4[1]), fmaxf(s4[2], s4[3])));
        s4[0] = __expf(s4[0] - mx); s4[1] = __expf(s4[1] - mx); s4[2] = __expf(s4[2] - mx); s4[3] = __expf(s4[3] - mx);
        const float inv = 1.0f / wave_sum((s4[0] + s4[1]) + (s4[2] + s4[3])); s4 = s4 * inv;
#pragma unroll
        for (int e = 0; e < 4; ++e) pT[(lane * 4 + e) * 4 + wid] = s4[e]; }
    __syncthreads();
    { const int dq = tid & 127, kq = tid >> 7; f32x4 acc[4];
#pragma unroll
        for (int t = 0; t < 4; ++t) acc[t] = (f32x4){0.f, 0.f, 0.f, 0.f};
#pragma unroll 16
        for (int kk = 0; kk < 64; ++kk) { const int key = kq * 64 + kk; const f32x4 v = __builtin_nontemporal_load((const f32x4*)(Vc + (size_t)key * 2048 + dq * 4)); const f32x4 p4 = *(const f32x4*)(pT + key * 4);
#pragma unroll
            for (int t = 0; t < 4; ++t) acc[t] += v * p4[t]; }
#pragma unroll
        for (int t = 0; t < 4; ++t) *(f32x4*)(red + (kq * 4 + t) * 512 + dq * 4) = acc[t]; }
    __syncthreads();
    { const int dq = tid & 127, t = tid >> 7; f32x4 o = *(const f32x4*)(red + t * 512 + dq * 4);
#pragma unroll
        for (int kq = 1; kq < 4; ++kq) o += *(const f32x4*)(red + (kq * 4 + t) * 512 + dq * 4);
        u32x2 w; w.x = pg8::cvt_pk_bf16(o[0], o[1]); w.y = pg8::cvt_pk_bf16(o[2], o[3]);
        *(u32x2*)((bf16_t*)(a.ws + WS_MIXIN) + (size_t)(MP + b * 4 + t) * D + h * 512 + dq * 4) = w; }
    __syncthreads();
}

__device__ __forceinline__ void phase_act(const Args& a) {
    const bf16_t* gu = (const bf16_t*)(a.ws + WS_GU); bf16_t* act = (bf16_t*)(a.ws + WS_PROJ);
    const float* cw = a.in[I_FCW]; const float* cb = a.in[I_FCB];
    const int total = (256 + MSAMP) * 704;
    for (int idx = blockIdx.x * 512 + tid_opq(); idx < total; idx += gridDim.x * 512) {
        const int ri = idx / 704, c = (idx - ri * 704) * 8, row = ri < 256 ? (ri >> 1) * 64 + (ri & 1) : MP + (ri - 256);
        const bool samp = row >= MP; const int t = samp ? ((row - MP) & 3) : (row & 2047), bi = samp ? ((row - MP) >> 2) : (row >> 11);
        const bf16_t* gr = gu + (size_t)row * (2 * DFF) + c;
        float g2[8], g1[8], g0[8], uu[8];
        unpack8(*(const u32x4*)gr, g2); unpack8(*(const u32x4*)(gr + DFF), uu);
        if (t >= 1) unpack8(*(const u32x4*)(gr - 2 * DFF), g1);
        else if (samp) { const float* cp = a.in[I_CFFN] + (size_t)(bi * 2 + 1) * DFF + c;
#pragma unroll
            for (int j = 0; j < 8; ++j) g1[j] = cp[j]; }
        else {
#pragma unroll
            for (int j = 0; j < 8; ++j) g1[j] = 0.f; }
        if (t >= 2) unpack8(*(const u32x4*)(gr - 4 * DFF), g0);
        else if (samp) { const float* cp = a.in[I_CFFN] + (size_t)(bi * 2 + t) * DFF + c;
#pragma unroll
            for (int j = 0; j < 8; ++j) g0[j] = cp[j]; }
        else {
#pragma unroll
            for (int j = 0; j < 8; ++j) g0[j] = 0.f; }
        float o[8];
#pragma unroll
        for (int j = 0; j < 8; ++j) { const float x = cw[c + j] * g0[j] + cw[DFF + c + j] * g1[j] + cw[2 * DFF + c + j] * g2[j] + cb[c + j]; o[j] = silu_f(x) * uu[j]; }
        u32x4 w; w.x = pg8::cvt_pk_bf16(o[0], o[1]); w.y = pg8::cvt_pk_bf16(o[2], o[3]); w.z = pg8::cvt_pk_bf16(o[4], o[5]); w.w = pg8::cvt_pk_bf16(o[6], o[7]);
        *(u32x4*)(act + (size_t)row * DFF + c) = w;
    }
}

__device__ __forceinline__ void phase_final(const Args& a) {
    const int lane = tid_opq() & 63, gw = blockIdx.x * 8 + (tid_opq() >> 6), nw = gridDim.x * 8;
    const float* ssq = (const float*)(a.ws + WS_SSQ3); const float* g = a.in[I_NFIN];
    int row = gw; if (row >= MROWS) return;
    f32x4 gg[8];
#pragma unroll
    for (int i = 0; i < 8; ++i) gg[i] = *(const f32x4*)(g + (i * 64 + lane) * 4);
    f32x4 v[8]; float sq = lane < 32 ? ssq[(size_t)row * 32 + lane] : 0.f;
#pragma unroll
    for (int i = 0; i < 8; ++i) v[i] = *(const f32x4*)(a.out + O_Y + (size_t)row * D + (i * 64 + lane) * 4);
    for (;;) {
        const int nrow = row + nw; const bool more = nrow < MROWS;
        f32x4 nv[8]; float nsq = 0.f;
        if (more) { nsq = lane < 32 ? ssq[(size_t)nrow * 32 + lane] : 0.f;
#pragma unroll
            for (int i = 0; i < 8; ++i) nv[i] = *(const f32x4*)(a.out + O_Y + (size_t)nrow * D + (i * 64 + lane) * 4); }
        const float rs = rsqrtf(wave_sum(sq) * (1.0f / 2048.0f) + 1e-6f);
        float* y = a.out + O_Y + (size_t)row * D;
#pragma unroll
        for (int i = 0; i < 8; ++i) __builtin_nontemporal_store(v[i] * rs * gg[i], (f32x4*)(y + (i * 64 + lane) * 4));
        if (!more) break;
#pragma unroll
        for (int i = 0; i < 8; ++i) v[i] = nv[i];
        sq = nsq; row = nrow;
    }
}

struct SmallEpi { const float* res; const bf16_t* resb; const float* rgain; float* hout; bf16_t* hg; const float* gain; float* ssq; bf16_t* O; const float* ssq_in; float scale; };
template <int MODE, bool HG, bool RESBF = false, bool OUTF = true> __device__ __forceinline__ void small_gemm(const bf16_t* __restrict__ A, const bf16_t* __restrict__ Bt, int K, int row_base, const SmallEpi& E, unsigned char* ldsb) {
    const int tid = tid_opq(), lane = tid & 63, wid = tid >> 6, fr = lane & 15, fq = lane >> 4;
    constexpr int LDP = 68;
    float* part = (float*)ldsb;
    const int kslice = K >> 3, npair = kslice >> 6;
    for (int tile = blockIdx.x; tile < 256; tile += gridDim.x) {
        const int tm = tile >> 5, tn = tile & 31;
        const bf16_t* ap = A + (size_t)(tm * 64 + fr) * K + wid * kslice + fq * 16; const bf16_t* bp = Bt + (size_t)(tn * 64 + fr) * K + wid * kslice + fq * 16;
        f32x4 acc[4][4];
#pragma unroll
        for (int mi = 0; mi < 4; ++mi)
#pragma unroll
            for (int ni = 0; ni < 4; ++ni) acc[mi][ni] = (f32x4){0.f, 0.f, 0.f, 0.f};
        bf16x8 af[4][2], bf[4][2];
#pragma unroll
        for (int i = 0; i < 4; ++i) { af[i][0] = *(const bf16x8*)(ap + (size_t)(i * 16) * K); af[i][1] = *(const bf16x8*)(ap + (size_t)(i * 16) * K + 8);
            bf[i][0] = *(const bf16x8*)(bp + (size_t)(i * 16) * K); bf[i][1] = *(const bf16x8*)(bp + (size_t)(i * 16) * K + 8); }
        for (int p = 0; p < npair; ++p) {
            bf16x8 an[4][2], bn[4][2];
            const int pn = (p + 1 < npair) ? p + 1 : p;
#pragma unroll
            for (int i = 0; i < 4; ++i) { an[i][0] = *(const bf16x8*)(ap + (size_t)(i * 16) * K + pn * 64); an[i][1] = *(const bf16x8*)(ap + (size_t)(i * 16) * K + pn * 64 + 8);
                bn[i][0] = *(const bf16x8*)(bp + (size_t)(i * 16) * K + pn * 64); bn[i][1] = *(const bf16x8*)(bp + (size_t)(i * 16) * K + pn * 64 + 8); }
#pragma unroll
            for (int hh = 0; hh < 2; ++hh)
#pragma unroll
                for (int mi = 0; mi < 4; ++mi)
#pragma unroll
                    for (int ni = 0; ni < 4; ++ni) acc[mi][ni] = __builtin_amdgcn_mfma_f32_16x16x32_bf16(bf[ni][hh], af[mi][hh], acc[mi][ni], 0, 0, 0);
#pragma unroll
            for (int i = 0; i < 4; ++i) { af[i][0] = an[i][0]; af[i][1] = an[i][1]; bf[i][0] = bn[i][0]; bf[i][1] = bn[i][1]; }
        }
#pragma unroll
        for (int mi = 0; mi < 4; ++mi)
#pragma unroll
            for (int ni = 0; ni < 4; ++ni) *(f32x4*)(part + (size_t)wid * 64 * LDP + (mi * 16 + fr) * LDP + ni * 16 + 4 * fq) = acc[mi][ni];
        __syncthreads();
        const int rloc = tid >> 3, cc = (tid & 7) * 8, rl = tm * 64 + rloc, r = row_base + rl, c0 = tn * 64 + cc;
        f32x4 v0 = *(const f32x4*)(part + rloc * LDP + cc), v1 = *(const f32x4*)(part + rloc * LDP + cc + 4);
#pragma unroll
        for (int w = 1; w < 8; ++w) { v0 += *(const f32x4*)(part + (size_t)w * 64 * LDP + rloc * LDP + cc); v1 += *(const f32x4*)(part + (size_t)w * 64 * LDP + rloc * LDP + cc + 4); }
        if (MODE == 0) {
            f32x4 h0, h1;
            if (RESBF) { const u32x4 w = *(const u32x4*)(E.resb + (size_t)r * 2048 + c0); f32x4 q0 = *(const f32x4*)(E.rgain + c0), q1 = *(const f32x4*)(E.rgain + c0 + 4);
#pragma unroll
                for (int j = 0; j < 4; ++j) { q0[j] = __builtin_amdgcn_rcpf(q0[j]); q1[j] = __builtin_amdgcn_rcpf(q1[j]); }
                h0 = (f32x4){__uint_as_float(w.x << 16), __uint_as_float(w.x & 0xffff0000u), __uint_as_float(w.y << 16), __uint_as_float(w.y & 0xffff0000u)} * q0 + v0;
                h1 = (f32x4){__uint_as_float(w.z << 16), __uint_as_float(w.z & 0xffff0000u), __uint_as_float(w.w << 16), __uint_as_float(w.w & 0xffff0000u)} * q1 + v1; }
            else { const float* rp = E.res + (size_t)rl * 2048 + c0; h0 = *(const f32x4*)rp + v0; h1 = *(const f32x4*)(rp + 4) + v1; }
            if (OUTF) { float* hp = E.hout + (size_t)r * 2048 + c0; *(f32x4*)hp = h0; *(f32x4*)(hp + 4) = h1; }
            float ss = (h0[0] * h0[0] + h0[1] * h0[1]) + (h0[2] * h0[2] + h0[3] * h0[3]) + (h1[0] * h1[0] + h1[1] * h1[1]) + (h1[2] * h1[2] + h1[3] * h1[3]);
            if (HG) { const f32x4 g0 = *(const f32x4*)(E.gain + c0), g1 = *(const f32x4*)(E.gain + c0 + 4); *(u32x4*)(E.hg + (size_t)r * 2048 + c0) = pg8::pack8(h0 * g0, h1 * g1); }
            ss += dpp_f<0xB1>(ss); ss += dpp_f<0x4E>(ss); ss += dpp_f<0x141>(ss);
            if ((tid & 7) == 0) E.ssq[(size_t)r * 32 + tn] = ss;
        } else {
            const f32x4 pq = *(const f32x4*)(E.ssq_in + (size_t)r * 32 + (tid & 7) * 4); float sm = (pq[0] + pq[1]) + (pq[2] + pq[3]);
            sm += dpp_f<0xB1>(sm); sm += dpp_f<0x4E>(sm); sm += dpp_f<0x141>(sm);
            const float rs = rsqrtf(sm * (1.0f / 2048.0f) + 1e-6f) * E.scale;
            *(u32x4*)(E.O + (size_t)r * 2048 + c0) = pg8::pack8(v0 * rs, v1 * rs);
        }
        __syncthreads();
    }
}


template <class Epi> __device__ __forceinline__ void run_gemm(PG8_LAS unsigned char* lds, const bf16_t* A, const bf16_t* Bt, int M, int N, int K, int cshift, const Epi& E) {
    pg8::Gemm g; g.A = A; g.Bt = Bt; g.M = M; g.N = N; g.K = K;
    pg8::StaticOrder S; S.init(M, N, (int)gridDim.x, (int)((blockIdx.x + gridDim.x - (cshift % gridDim.x)) % gridDim.x));
    pg8::gemm_phase<Epi, pg8::StaticOrder, false>(lds, g, S, E, nullptr);
}

#ifndef REP_SYNC
#define REP_SYNC 0
#endif
#ifndef REP_P0
#define REP_P0 0
#endif
#ifndef REP_P4
#define REP_P4 0
#endif
#ifndef REP_P9
#define REP_P9 0
#endif
#ifndef REP_P1
#define REP_P1 0
#endif
#ifndef REP_P3
#define REP_P3 0
#endif
#ifndef REP_SM
#define REP_SM 0
#endif
#ifndef REP_GA
#define REP_GA 0
#endif
#ifndef REP_GS
#define REP_GS 0
#endif
#ifndef REP_GB
#define REP_GB 0
#endif
#ifndef REP_GC
#define REP_GC 0
#endif
#ifndef REP_P1B
#define REP_P1B 0
#endif
#ifndef REP_P5
#define REP_P5 0
#endif
#ifndef REP_P7
#define REP_P7 0
#endif
#define GSYNC() do { xcd_barrier(xbar); if (REP_SYNC) xcd_barrier(xbar); } while (0)
__global__ void __launch_bounds__(512, 2) mk_fwd(Args a) {
    extern __shared__ __attribute__((aligned(16))) unsigned char shm[];
    cg::grid_group grid = cg::this_grid();
    PG8_LAS unsigned char* lds = (PG8_LAS unsigned char*)shm;
    float* ldsf = (float*)shm;
    unsigned char* ws = a.ws;
    volatile LAS unsigned* xst = (volatile LAS unsigned*)(lds + LDS_BYTES - 16);
    if (threadIdx.x < 4) xst[threadIdx.x] = 0u;
    __syncthreads();
    XcdBarrier xbar = xcd_barrier_post((unsigned*)(ws + WS_BAR), xst);
    for (int rep = 0; rep <= REP_P0; ++rep) { phase_prep(a, ldsf); if (REP_P0) __syncthreads(); }
    if (a.ws == nullptr) grid.sync();
    GSYNC();
    for (int rep1 = 0; rep1 <= REP_P1; ++rep1)
    { pg8::EpiProj E; E.O = (bf16_t*)(ws + WS_PROJ); E.ldc = NINP;
      run_gemm(lds, (const bf16_t*)(ws + WS_XN), (const bf16_t*)(ws + WS_WT_IN), MROWS, NINP, D, 0, E); }
    { pg8::EpiKV E; E.outk = a.out + O_MK; E.outv = a.out + O_MV; E.mkb = (bf16_t*)(ws + WS_MKB); E.mvt = (bf16_t*)(ws + WS_MVT);
      run_gemm(lds, (const bf16_t*)(ws + WS_MEMN), (const bf16_t*)(ws + WS_WT_XKV), 1024, 4096, D, (MROWS / 256) * (NINP / 256), E); }
    __syncthreads();
    phase_transposes(a, ldsf, TT_EARLY, TT_TOTAL, (unsigned*)(ws + WS_BAR) + XCD_BAR_WORDS + 1, (volatile int*)(ldsf + 64 * 257 + 8));
    GSYNC();
    for (int rep = 0; rep <= REP_P1B; ++rep) phase_rows_pre(a);
    GSYNC();
    for (int rep = 0; rep <= REP_GA; ++rep)
    for (int it = blockIdx.x; it < 512; it += gridDim.x) gla_pass_a(a, it, shm);
    for (int rep = 0; rep <= REP_GS; ++rep)
    for (int it = blockIdx.x; it < 512; it += gridDim.x) gla_sample_item(a, it, ldsf);
    GSYNC();
    for (int rep = 0; rep <= REP_GB; ++rep) { gla_pass_b(a); if (REP_GB) __syncthreads(); }
    GSYNC();
    for (int rep = 0; rep <= REP_GC; ++rep)
    for (int it = blockIdx.x; it < 512; it += gridDim.x) gla_pass_c(a, it, shm);
    GSYNC();
    for (int rep3 = 0; rep3 <= REP_P3; ++rep3)
    { pg8::EpiRes<false, true, false> E{}; E.res0 = a.in[I_XP]; E.res1 = a.in[I_XS]; E.split = MP; E.hg = (bf16_t*)(ws + WS_HG); E.gain = a.in[I_NX]; E.ssq = (float*)(ws + WS_SSQ1);
      run_gemm(lds, (const bf16_t*)(ws + WS_MIXIN), (const bf16_t*)(ws + WS_WT_OUT), MP, D, D, 0, E);
      SmallEpi SE{}; SE.res = a.in[I_XS]; SE.hg = E.hg; SE.gain = E.gain; SE.ssq = E.ssq;
      small_gemm<0, true, false, false>((const bf16_t*)(ws + WS_MIXIN) + (size_t)MP * D, (const bf16_t*)(ws + WS_WT_OUT), D, MP, SE, shm); }
    GSYNC();
    for (int rep4 = 0; rep4 <= REP_P4; ++rep4)
    { pg8::EpiScale<false> E; E.O = (bf16_t*)(ws + WS_XN); E.ldc = D; E.ssq = (const float*)(ws + WS_SSQ1); E.scale = 0.044194173824159216f; E.ffn_p = nullptr; E.ffn_s = nullptr;
      run_gemm(lds, (const bf16_t*)(ws + WS_HG), (const bf16_t*)(ws + WS_WT_XQ), MP, D, D, 0, E);
      SmallEpi SE{}; SE.O = E.O; SE.ssq_in = E.ssq; SE.scale = E.scale;
      for (int rep = 0; rep <= REP_SM; ++rep) small_gemm<1, false>((const bf16_t*)(ws + WS_HG) + (size_t)MP * D, (const bf16_t*)(ws + WS_WT_XQ), D, MP, SE, shm); }
    GSYNC();
    for (int rep = 0; rep <= REP_P5; ++rep) {
    for (int it = blockIdx.x; it < 256; it += gridDim.x) { const int x = it & 7, j = it >> 3; xattn_prompt_item(a, (gridDim.x == 256) ? ((x * 2 + (j >> 4)) * 16 + (j & 15)) : it, shm); }
    for (int it = blockIdx.x; it < 512; it += gridDim.x) xattn_sample_item(a, it, ldsf); }
    GSYNC();
    { pg8::EpiRes<true, true, false> E{}; E.resb = (const bf16_t*)(ws + WS_HG); E.rgain = a.in[I_NX]; E.hg = (bf16_t*)(ws + WS_HG); E.gain = a.in[I_NF]; E.ssq = (float*)(ws + WS_SSQ2);
      run_gemm(lds, (const bf16_t*)(ws + WS_MIXIN), (const bf16_t*)(ws + WS_WT_XO), MP, D, D, 0, E);
      SmallEpi SE{}; SE.resb = E.resb; SE.rgain = E.rgain; SE.hg = E.hg; SE.gain = E.gain; SE.ssq = E.ssq;
      small_gemm<0, true, true, false>((const bf16_t*)(ws + WS_MIXIN) + (size_t)MP * D, (const bf16_t*)(ws + WS_WT_XO), D, MP, SE, shm); }
    GSYNC();
    for (int rep = 0; rep <= REP_P7; ++rep)
    { pg8::EpiFfn E; E.act = (bf16_t*)(ws + WS_PROJ); E.GU = (bf16_t*)(ws + WS_GU); E.ssq = (const float*)(ws + WS_SSQ2); E.cw = a.in[I_FCW]; E.cb = a.in[I_FCB]; E.ffn_p = a.out + O_FFN_P; E.ffn_s = a.out + O_FFN_S;
      run_gemm(lds, (const bf16_t*)(ws + WS_HG), (const bf16_t*)(ws + WS_WT_FGU), MROWS, 2 * DFF, D, 0, E); }
    GSYNC();
    phase_act(a);
    GSYNC();
    for (int rep9 = 0; rep9 <= REP_P9; ++rep9)
    { pg8::EpiRes<true, false, true> E{}; E.resb = (const bf16_t*)(ws + WS_HG); E.rgain = a.in[I_NF]; E.hout = a.out + O_Y; E.ssq = (float*)(ws + WS_SSQ3);
      run_gemm(lds, (const bf16_t*)(ws + WS_PROJ), (const bf16_t*)(ws + WS_WT_FD), MP, D, DFF, 0, E);
      SmallEpi SE{}; SE.resb = E.resb; SE.rgain = E.rgain; SE.hout = E.hout; SE.ssq = E.ssq;
      small_gemm<0, false, true, true>((const bf16_t*)(ws + WS_PROJ) + (size_t)MP * DFF, (const bf16_t*)(ws + WS_WT_FD), DFF, MP, SE, shm); }
    GSYNC();
    phase_final(a);
}

extern "C" void kernel_launch(void* const* d_in, const int* in_sizes, int n_in, void* d_out, int out_size, void* d_ws, size_t ws_size, hipStream_t stream) {
    static int grid = 0;
    if (grid == 0) {
        if (n_in != 28 || ws_size < WS_END) { fprintf(stderr, "kernel_launch: unexpected n_in %d or ws_size %zu (< %zu)\n", n_in, ws_size, (size_t)WS_END); grid = -1; return; }
        int dev = 0, cus = 0, per_cu = 0;
        (void)hipGetDevice(&dev); (void)hipDeviceGetAttribute(&cus, hipDeviceAttributeMultiprocessorCount, dev);
        (void)hipFuncSetAttribute((const void*)mk_fwd, hipFuncAttributeMaxDynamicSharedMemorySize, LDS_BYTES);
        (void)hipOccupancyMaxActiveBlocksPerMultiprocessor(&per_cu, (const void*)mk_fwd, 512, LDS_BYTES);
        if (per_cu < 1) { fprintf(stderr, "kernel_launch: occupancy query says %d blocks/CU\n", per_cu); grid = -1; return; }
        grid = cus;
    }
    if (grid < 0) return;
    Args a{};
    for (int i = 0; i < 28; ++i) a.in[i] = (const float*)d_in[i];
    a.out = (float*)d_out; a.ws = (unsigned char*)d_ws;
    if (hipMemsetAsync((unsigned char*)d_ws + WS_BAR, 0, (size_t)(XCD_BAR_WORDS + 64) * 4, stream) != hipSuccess) { fprintf(stderr, "kernel_launch: memset of barrier words failed\n"); return; }
    void* args[] = {&a};
    hipError_t e = hipLaunchCooperativeKernel((const void*)mk_fwd, dim3(grid), dim3(512), args, LDS_BYTES, stream);
    if (e != hipSuccess) fprintf(stderr, "cooperative launch failed: %s (grid %d)\n", hipGetErrorString(e), grid);
}
```

```cpp
#include <hip/hip_runtime.h>
#include <hip/hip_cooperative_groups.h>
#include <cstdio>
namespace cg = cooperative_groups;

__device__ __forceinline__ int tid_opq() { int t = threadIdx.x; asm volatile("" : "+v"(t)); return t; }
namespace pg8 {
#define PG8_LAS __attribute__((address_space(3)))
typedef unsigned short bf16_t;
typedef short bf16x8 __attribute__((ext_vector_type(8)));
typedef float f32x4 __attribute__((ext_vector_type(4)));
typedef unsigned u32x4 __attribute__((ext_vector_type(4)));
constexpr int BM = 256, BK = 64, HALF = 128, HTB = HALF * BK * 2  , STAGE_BYTES = 8 * HTB, NXCD = 8, WGM = 8;

__host__ __device__ __forceinline__ int lds_byte(int r, int c) { const int st = (r >> 4) * 2 + (c >> 5), rr = r & 15, cc = c & 31, ob = rr * 64 + cc * 2; return st * 1024 + (ob ^ (((ob >> 9) & 1) << 5)); }
__host__ __device__ __forceinline__ void stage_rc(int b, int& R, int& C) { const int st = b / 1024, sb = b % 1024, swz = sb ^ (((sb >> 9) & 1) << 5); R = (st >> 1) * 16 + swz / 64; C = (st & 1) * 32 + (swz % 64) / 2; }
__host__ __device__ __forceinline__ int perm32(int rho) { const int n = rho >> 4, i = rho & 15; return 8 * (i >> 2) + 4 * n + (i & 3); }

struct Unit { int pm, pn; };
struct Gemm { const bf16_t* A; const bf16_t* Bt; int M, N, K; };

struct StaticOrder {
    int nM, nN, nwg, G, c;
    __host__ __device__ void init(int M, int N, int G_, int c_) { nM = M / BM; nN = N / BM; nwg = nM * nN; G = G_; c = c_; }
    __host__ __device__ bool next(int i, Unit& u) const {
        const long L = (long)i * G + c; if (L >= nwg) return false;
        int wgid = (int)L; { const int q = nwg / NXCD, r = nwg % NXCD, xcd = wgid % NXCD, off = wgid / NXCD; wgid = (xcd < r ? xcd * (q + 1) : r * (q + 1) + (xcd - r) * q) + off; }
        const int nig = WGM * nN, gid = wgid / nig, fm = gid * WGM, gsz = (nM - fm) < WGM ? (nM - fm) : WGM;
        u.pm = fm + ((wgid % nig) % gsz); u.pn = (wgid % nig) / gsz; return true;
    }
    __device__ __forceinline__ void a_ready(const Unit&) const {}
    __device__ __forceinline__ void done(const Unit&) const {}
};
typedef unsigned u32x2 __attribute__((ext_vector_type(2)));
__device__ __forceinline__ unsigned cvt_pk_bf16(float lo, float hi) { unsigned r; asm volatile("v_cvt_pk_bf16_f32 %0, %1, %2" : "=v"(r) : "v"(lo), "v"(hi)); return r; }
__device__ __forceinline__ u32x4 pack8(const f32x4 v0, const f32x4 v1) { u32x4 w; w.x = cvt_pk_bf16(v0[0], v0[1]); w.y = cvt_pk_bf16(v0[2], v0[3]); w.z = cvt_pk_bf16(v1[0], v1[1]); w.w = cvt_pk_bf16(v1[2], v1[3]); return w; }

struct EpiProj {
    static constexpr bool PERM = true, AFTER_DRAIN = false;
    bf16_t* O; int ldc;
    __device__ __forceinline__ void operator()(const f32x4 (&acc)[2][2][4][2], const Unit& u, int wr, int wc, int fr, int fq) const {
        const int row0 = u.pm * BM + wr * 64 + fr, col0 = u.pn * BM + wc * 32 + 8 * fq;
#pragma unroll
        for (int ai = 0; ai < 2; ++ai)
#pragma unroll
            for (int m = 0; m < 4; ++m) { bf16_t* rowp = O + (size_t)(row0 + ai * HALF + m * 16) * ldc + col0;
#pragma unroll
                for (int bj = 0; bj < 2; ++bj) *(u32x4*)(rowp + bj * HALF) = pack8(acc[ai][bj][m][0], acc[ai][bj][m][1]); }
    }
};

struct EpiKV {
    static constexpr bool PERM = false, AFTER_DRAIN = false;
    float* outk; float* outv; bf16_t* mkb; bf16_t* mvt;
    __device__ __forceinline__ void operator()(const f32x4 (&acc)[2][2][4][2], const Unit& u, int wr, int wc, int fr, int fq) const {
        const int row0 = u.pm * BM + wr * 64 + fr, col0 = (u.pn & 7) * BM + wc * 32 + 4 * fq;
        const bool isv = u.pn >= 8;
#pragma unroll
        for (int ai = 0; ai < 2; ++ai)
#pragma unroll
            for (int m = 0; m < 4; ++m) { const int r = row0 + ai * HALF + m * 16;
                const int bb = r >> 8, key = r & 255, pos = (key & ~31) + 8 * ((key >> 2) & 3) + 4 * ((key >> 4) & 1) + (key & 3);
#pragma unroll
                for (int bj = 0; bj < 2; ++bj)
#pragma unroll
                    for (int n = 0; n < 2; ++n) { const int c = col0 + bj * HALF + n * 16; const f32x4 v = acc[ai][bj][m][n];
                        if (!isv) { __builtin_nontemporal_store(v, (f32x4*)(outk + (size_t)r * 2048 + c)); u32x2 w; w.x = cvt_pk_bf16(v[0], v[1]); w.y = cvt_pk_bf16(v[2], v[3]); *(u32x2*)(mkb + (size_t)r * 2048 + c) = w; }
                        else { __builtin_nontemporal_store(v, (f32x4*)(outv + (size_t)r * 2048 + c)); const unsigned w0 = cvt_pk_bf16(v[0], v[1]), w1 = cvt_pk_bf16(v[2], v[3]);
                            bf16_t* tp = mvt + ((size_t)(bb * 2048 + c)) * 256 + pos;
                            tp[0] = (bf16_t)(w0 & 0xffffu); tp[256] = (bf16_t)(w0 >> 16); tp[512] = (bf16_t)(w1 & 0xffffu); tp[768] = (bf16_t)(w1 >> 16); } } }
    }
};

template <bool RESBF, bool HG, bool OUTF> struct EpiRes {
    static constexpr bool PERM = true, AFTER_DRAIN = false;
    const float* res0; const float* res1; int split; const bf16_t* resb; const float* rgain; float* hout; bf16_t* hg; const float* gain; float* ssq;
    __device__ __forceinline__ void operator()(const f32x4 (&acc)[2][2][4][2], const Unit& u, int wr, int wc, int fr, int fq) const {
        const int row0 = u.pm * BM + wr * 64 + fr, col0 = u.pn * BM + wc * 32 + 8 * fq;
        float ss[2][4];
#pragma unroll
        for (int ai = 0; ai < 2; ++ai)
#pragma unroll
            for (int m = 0; m < 4; ++m) ss[ai][m] = 0.f;
#pragma unroll
        for (int bj = 0; bj < 2; ++bj) { const int c = col0 + bj * HALF;
            f32x4 g0, g1, q0, q1;
            if (HG) { g0 = *(const f32x4*)(gain + c); g1 = *(const f32x4*)(gain + c + 4); }
            if (RESBF) { q0 = *(const f32x4*)(rgain + c); q1 = *(const f32x4*)(rgain + c + 4);
#pragma unroll
                for (int j = 0; j < 4; ++j) { q0[j] = __builtin_amdgcn_rcpf(q0[j]); q1[j] = __builtin_amdgcn_rcpf(q1[j]); } }
#pragma unroll
            for (int ai = 0; ai < 2; ++ai) {
                u32x4 rw[4]; f32x4 ra[4], rb[4];
#pragma unroll
                for (int m = 0; m < 4; ++m) { const int r = row0 + ai * HALF + m * 16;
                    if (RESBF) rw[m] = *(const u32x4*)(resb + (size_t)r * 2048 + c);
                    else { const float* rp = (r < split ? res0 + (size_t)r * 2048 : res1 + (size_t)(r - split) * 2048) + c; ra[m] = __builtin_nontemporal_load((const f32x4*)rp); rb[m] = __builtin_nontemporal_load((const f32x4*)(rp + 4)); } }
#pragma unroll
                for (int m = 0; m < 4; ++m) { const int r = row0 + ai * HALF + m * 16;
                    f32x4 h0, h1;
                    if (RESBF) { const u32x4 w = rw[m];
                        h0 = (f32x4){__uint_as_float(w.x << 16), __uint_as_float(w.x & 0xffff0000u), __uint_as_float(w.y << 16), __uint_as_float(w.y & 0xffff0000u)} * q0 + acc[ai][bj][m][0];
                        h1 = (f32x4){__uint_as_float(w.z << 16), __uint_as_float(w.z & 0xffff0000u), __uint_as_float(w.w << 16), __uint_as_float(w.w & 0xffff0000u)} * q1 + acc[ai][bj][m][1]; }
                    else { h0 = ra[m] + acc[ai][bj][m][0]; h1 = rb[m] + acc[ai][bj][m][1]; }
                    ss[ai][m] += (h0[0] * h0[0] + h0[1] * h0[1]) + (h0[2] * h0[2] + h0[3] * h0[3]) + (h1[0] * h1[0] + h1[1] * h1[1]) + (h1[2] * h1[2] + h1[3] * h1[3]);
                    if (OUTF) { float* hp = hout + (size_t)r * 2048 + c; *(f32x4*)hp = h0; *(f32x4*)(hp + 4) = h1; }
                    if (HG) *(u32x4*)(hg + (size_t)r * 2048 + c) = pack8(h0 * g0, h1 * g1); }
                __builtin_amdgcn_sched_barrier(0); } }
#pragma unroll
        for (int ai = 0; ai < 2; ++ai)
#pragma unroll
            for (int m = 0; m < 4; ++m) { float s = ss[ai][m]; s += __shfl_xor(s, 16); s += __shfl_xor(s, 32);
                if (fq == 0) ssq[(size_t)(row0 + ai * HALF + m * 16) * 32 + u.pn * 4 + wc] = s; }
    }
};

template <bool FFN> struct EpiScale {
    static constexpr bool PERM = true, AFTER_DRAIN = false;
    bf16_t* O; int ldc; const float* ssq; float scale; float* ffn_p; float* ffn_s;
    __device__ __forceinline__ void operator()(const f32x4 (&acc)[2][2][4][2], const Unit& u, int wr, int wc, int fr, int fq) const {
        const int row0 = u.pm * BM + wr * 64 + fr, col0 = u.pn * BM + wc * 32 + 8 * fq;
#pragma unroll
        for (int ai = 0; ai < 2; ++ai)
#pragma unroll
            for (int m = 0; m < 4; ++m) { const int r = row0 + ai * HALF + m * 16;
                const f32x4* sp = (const f32x4*)(ssq + (size_t)r * 32 + fq * 8); const f32x4 p0 = sp[0], p1 = sp[1];
                float s = ((p0[0] + p0[1]) + (p0[2] + p0[3])) + ((p1[0] + p1[1]) + (p1[2] + p1[3]));
                s += __shfl_xor(s, 16); s += __shfl_xor(s, 32);
                const float rs = rsqrtf(s * (1.0f / 2048.0f) + 1e-6f) * scale;
                bf16_t* rowp = O + (size_t)r * ldc + col0;
                float* dst = nullptr;
                if (FFN && u.pn < 22) {
                    if (r < 8192) { const int t = r & 2047; if (t >= 2046) dst = ffn_p + (size_t)((r >> 11) * 2 + (t - 2046)) * 5632; }
                    else { const int rr = r - 8192, t = rr & 3; if (t >= 2) dst = ffn_s + (size_t)((rr >> 2) * 2 + (t - 2)) * 5632; } }
#pragma unroll
                for (int bj = 0; bj < 2; ++bj) { const f32x4 v0 = acc[ai][bj][m][0] * rs, v1 = acc[ai][bj][m][1] * rs;
                    *(u32x4*)(rowp + bj * HALF) = pack8(v0, v1);
                    if (FFN) { if (dst) { *(f32x4*)(dst + col0 + bj * HALF) = v0; *(f32x4*)(dst + col0 + bj * HALF + 4) = v1; } } } }
    }
};

struct EpiFfn {
    static constexpr bool PERM = true, AFTER_DRAIN = false;
    bf16_t* act; bf16_t* GU; const float* ssq; const float* cw; const float* cb; float* ffn_p; float* ffn_s;
    template <int N> __device__ __forceinline__ static float ror(float x) { return __int_as_float(__builtin_amdgcn_update_dpp(0, __float_as_int(x), 0x120 + N, 0xf, 0xf, false)); }
    template <int N> __device__ __forceinline__ static f32x4 rot(const f32x4 v) { f32x4 r; r[0] = ror<N>(v[0]); r[1] = ror<N>(v[1]); r[2] = ror<N>(v[2]); r[3] = ror<N>(v[3]); return r; }
    __device__ __forceinline__ void operator()(const f32x4 (&acc)[2][2][4][2], const Unit& u, int wr, int wc, int fr, int fq) const {
        const int row0 = u.pm * BM + wr * 64 + fr, ch0 = u.pn * 128 + wc * 32 + 8 * fq;
        if (u.pm >= 32) {
#pragma unroll
            for (int ai = 0; ai < 2; ++ai)
#pragma unroll
                for (int m = 0; m < 4; ++m) { const int r = row0 + ai * HALF + m * 16;
                    const f32x4* sp = (const f32x4*)(ssq + (size_t)r * 32); float s = 0.f;
#pragma unroll
                    for (int i = 0; i < 8; ++i) { const f32x4 v = sp[i]; s += (v[0] + v[1]) + (v[2] + v[3]); }
                    const float rs = rsqrtf(s * (1.0f / 2048.0f) + 1e-6f);
                    const f32x4 g0 = acc[ai][0][m][0] * rs, g1 = acc[ai][0][m][1] * rs;
                    *(u32x4*)(GU + (size_t)r * 11264 + ch0) = pack8(g0, g1); *(u32x4*)(GU + (size_t)r * 11264 + 5632 + ch0) = pack8(acc[ai][1][m][0] * rs, acc[ai][1][m][1] * rs);
                    const int rr = r - 8192, t = rr & 3;
                    if (t >= 2) { float* dst = ffn_s + (size_t)((rr >> 2) * 2 + (t - 2)) * 5632 + ch0; *(f32x4*)dst = g0; *(f32x4*)(dst + 4) = g1; } }
            return; }
        float rsv[2][4];
#pragma unroll
        for (int ai = 0; ai < 2; ++ai)
#pragma unroll
            for (int m = 0; m < 4; ++m) { const f32x4* sp = (const f32x4*)(ssq + (size_t)(row0 + ai * HALF + m * 16) * 32 + fq * 8); const f32x4 v0 = sp[0], v1 = sp[1];
                float s = ((v0[0] + v0[1]) + (v0[2] + v0[3])) + ((v1[0] + v1[1]) + (v1[2] + v1[3]));
                s += __shfl_xor(s, 16); s += __shfl_xor(s, 32);
                rsv[ai][m] = rsqrtf(s * (1.0f / 2048.0f) + 1e-6f); }
#pragma unroll
        for (int n = 0; n < 2; ++n) { const int ch = ch0 + 4 * n;
            const f32x4 w0 = *(const f32x4*)(cw + ch), w1 = *(const f32x4*)(cw + 5632 + ch), w2 = *(const f32x4*)(cw + 11264 + ch), bz = *(const f32x4*)(cb + ch);
#pragma unroll
            for (int ai = 0; ai < 2; ++ai) {
                f32x4 q1, q2;
#pragma unroll
                for (int m = 0; m < 4; ++m) { const int r = row0 + ai * HALF + m * 16; const float rs = rsv[ai][m];
                    const f32x4 g = acc[ai][0][m][n] * rs, uu = acc[ai][1][m][n] * rs;
                    const f32x4 r1 = rot<1>(g), r2 = rot<2>(g);
                    f32x4 p1 = r1, p2 = r2;
                    if (m > 0) { if (fr < 1) p1 = q1; if (fr < 2) p2 = q2; }
                    q1 = r1; q2 = r2;
                    u32x2 w;
                    if (m == 0 && fr < 2) {
                        w.x = cvt_pk_bf16(g[0], g[1]); w.y = cvt_pk_bf16(g[2], g[3]); *(u32x2*)(GU + (size_t)r * 11264 + ch) = w;
                        w.x = cvt_pk_bf16(uu[0], uu[1]); w.y = cvt_pk_bf16(uu[2], uu[3]); *(u32x2*)(GU + (size_t)r * 11264 + 5632 + ch) = w; }
                    else {
                        const f32x4 x = w0 * p2 + w1 * p1 + w2 * g + bz; f32x4 o;
#pragma unroll
                        for (int j = 0; j < 4; ++j) o[j] = x[j] * __builtin_amdgcn_rcpf(1.0f + __expf(-x[j])) * uu[j];
                        w.x = cvt_pk_bf16(o[0], o[1]); w.y = cvt_pk_bf16(o[2], o[3]); *(u32x2*)(act + (size_t)r * 5632 + ch) = w; }
                    if (m == 3 && fr >= 14) {
                        w.x = cvt_pk_bf16(g[0], g[1]); w.y = cvt_pk_bf16(g[2], g[3]); *(u32x2*)(GU + (size_t)r * 11264 + ch) = w;
                        const int t = r & 2047; if (t >= 2046) *(f32x4*)(ffn_p + (size_t)((r >> 11) * 2 + (t - 2046)) * 5632 + ch) = g; }
                    __builtin_amdgcn_sched_barrier(0); } } }
    }
};

template <class Epi, class Sched, bool STAMP = false>
__device__ __forceinline__ void gemm_phase(PG8_LAS unsigned char* lds, const Gemm g, const Sched& S, const Epi& E, unsigned long long* stamps) {
    const int tid = ::tid_opq(), wid = __builtin_amdgcn_readfirstlane(tid >> 6), lane = tid & 63, wr = wid >> 2, wc = wid & 3, fr = lane & 15, fq = lane >> 4;
    const int K = g.K, nt = K / BK;
    int ts_lo = 0, ts_hi = 0, nts = 0; const unsigned long long rt_entry = STAMP ? (unsigned long long)wall_clock64() : 0ull;
#define PG8_STAMP() do { if (STAMP && wid == 0 && nts < 64) { const unsigned long long _c = (unsigned long long)clock64(); \
        ts_lo = (lane == nts) ? (int)(unsigned)_c : ts_lo; ts_hi = (lane == nts) ? (int)(unsigned)(_c >> 32) : ts_hi; ++nts; } } while (0)
    PG8_STAMP();
    unsigned voffA[2], voffB[2];
#pragma unroll
    for (int i = 0; i < 2; ++i) { int R, C; stage_rc(tid * 16 + i * 8192, R, C); const int Rb = Epi::PERM ? ((R & ~31) + perm32(R & 31)) : R;
        voffA[i] = (unsigned)(R * K + C) * 2u; voffB[i] = (unsigned)(Rb * K + C) * 2u; }
    const size_t kstep = (size_t)(BK * 2);
    const size_t hstep = (size_t)HALF * K * 2;
    const size_t tstep = 2 * hstep;
    const unsigned ldsw = (unsigned)wid * 1024u;
    const int aoff = lds_byte(wr * 64 + fr, fq * 8), boff = lds_byte(wc * 32 + fr, fq * 8);
#define PG8_SA(b, h) (((b) * 2 + (h)) * HTB)
#define PG8_SB(b, h) ((4 + (b) * 2 + (h)) * HTB)
#define PG8_STAGE(bufoff, gbase, voff) do { _Pragma("unroll") for (int _i = 0; _i < 2; ++_i) \
        __builtin_amdgcn_global_load_lds((const unsigned*)((const char*)(gbase) + (voff)[_i]), (PG8_LAS unsigned*)(lds + (bufoff) + ldsw + _i * 8192), 16, 0, 0); } while (0)
#define PG8_LDA(dst, b, h) do { _Pragma("unroll") for (int m = 0; m < 4; ++m) _Pragma("unroll") for (int k = 0; k < 2; ++k) dst[m][k] = *(const PG8_LAS bf16x8*)(lds + PG8_SA(b, h) + aoff + m * 2048 + k * 1024); } while (0)
#define PG8_LDB(dst, b, h) do { _Pragma("unroll") for (int n = 0; n < 2; ++n) _Pragma("unroll") for (int k = 0; k < 2; ++k) dst[n][k] = *(const PG8_LAS bf16x8*)(lds + PG8_SB(b, h) + boff + n * 2048 + k * 1024); } while (0)
#define PG8_MMA(ai, bj, At, Bt) do { __builtin_amdgcn_s_setprio(1); _Pragma("unroll") for (int m = 0; m < 4; ++m) _Pragma("unroll") for (int n = 0; n < 2; ++n) _Pragma("unroll") for (int k = 0; k < 2; ++k) \
        acc[ai][bj][m][n] = __builtin_amdgcn_mfma_f32_16x16x32_bf16(Bt[n][k], At[m][k], acc[ai][bj][m][n], 0, 0, 0); __builtin_amdgcn_s_setprio(0); } while (0)
#define PG8_WAIT_V(n) asm volatile("s_waitcnt vmcnt(" #n ")" ::: "memory")
#define PG8_WAIT_L(n) asm volatile("s_waitcnt lgkmcnt(" #n ")" ::: "memory")
#define PG8_BAR __builtin_amdgcn_s_barrier()
#define PG8_SCHED __builtin_amdgcn_sched_barrier(0)
    Unit cur, nxt; int ui = 0;
    if (!S.next(0, cur)) return;
    f32x4 acc[2][2][4][2];
#pragma unroll
    for (int a = 0; a < 2; ++a)
#pragma unroll
        for (int b = 0; b < 2; ++b)
#pragma unroll
            for (int m = 0; m < 4; ++m)
#pragma unroll
                for (int n = 0; n < 2; ++n) acc[a][b][m][n] = (f32x4){0.f, 0.f, 0.f, 0.f};
    bf16x8 At[4][2], B0[2][2], B1[2][2];
    const char* cA = (const char*)g.A + (size_t)cur.pm * tstep; const char* cB = (const char*)g.Bt + (size_t)cur.pn * tstep;
    S.a_ready(cur);
    PG8_STAGE(PG8_SB(0, 0), cB, voffB); PG8_STAGE(PG8_SA(0, 0), cA, voffA); PG8_STAGE(PG8_SB(0, 1), cB + hstep, voffB); PG8_STAGE(PG8_SA(0, 1), cA + hstep, voffA);
    if (wr == 1) PG8_BAR;
    PG8_WAIT_V(4); PG8_BAR;
    PG8_STAGE(PG8_SB(1, 0), cB + kstep, voffB); PG8_STAGE(PG8_SA(1, 0), cA + kstep, voffA); PG8_STAGE(PG8_SB(1, 1), cB + hstep + kstep, voffB);
    PG8_WAIT_V(6); PG8_BAR;
    PG8_STAMP();
    for (;;) {
        const bool has_next = S.next(ui + 1, nxt);
        const char* nA = has_next ? (const char*)g.A + (size_t)nxt.pm * tstep : cA; const char* nB = has_next ? (const char*)g.Bt + (size_t)nxt.pn * tstep : cB;
        for (int t = 0; t < nt; t += 2) {
            const bool last = (t == nt - 2);
            const char* a1 = cA + (size_t)(t + 1) * kstep;
            const char* a2 = last ? nA : cA + (size_t)(t + 2) * kstep; const char* b2 = last ? nB : cB + (size_t)(t + 2) * kstep;
            const char* a3 = a2 + kstep; const char* b3 = b2 + kstep;
            if (last && has_next) S.a_ready(nxt);
            PG8_LDB(B0, 0, 0); PG8_SCHED; PG8_LDA(At, 0, 0); PG8_STAGE(PG8_SA(1, 1), a1 + hstep, voffA);
            PG8_WAIT_L(8); PG8_BAR; PG8_WAIT_L(0); PG8_MMA(0, 0, At, B0); PG8_BAR; PG8_SCHED;
            PG8_LDB(B1, 0, 1); PG8_STAGE(PG8_SB(0, 0), b2, voffB);
            PG8_BAR; PG8_WAIT_L(0); PG8_MMA(0, 1, At, B1); PG8_BAR;
            PG8_LDA(At, 0, 1); PG8_STAGE(PG8_SA(0, 0), a2, voffA);
            PG8_BAR; PG8_WAIT_L(0); PG8_MMA(1, 0, At, B0); PG8_BAR; PG8_SCHED;
            PG8_STAGE(PG8_SB(0, 1), b2 + hstep, voffB);
            PG8_WAIT_V(6); PG8_BAR; PG8_MMA(1, 1, At, B1); PG8_BAR;
            PG8_LDB(B0, 1, 0); PG8_SCHED; PG8_LDA(At, 1, 0); PG8_STAGE(PG8_SA(0, 1), a2 + hstep, voffA);
            PG8_WAIT_L(8); PG8_BAR; PG8_WAIT_L(0); PG8_MMA(0, 0, At, B0); PG8_BAR; PG8_SCHED;
            PG8_LDB(B1, 1, 1); PG8_STAGE(PG8_SB(1, 0), b3, voffB);
            PG8_BAR; PG8_WAIT_L(0); PG8_MMA(0, 1, At, B1); PG8_BAR;
            PG8_LDA(At, 1, 1); PG8_STAGE(PG8_SA(1, 0), a3, voffA);
            PG8_BAR; PG8_WAIT_L(0); PG8_MMA(1, 0, At, B0); PG8_BAR; PG8_SCHED;
            PG8_STAGE(PG8_SB(1, 1), b3 + hstep, voffB);
            PG8_WAIT_V(6); PG8_BAR; PG8_MMA(1, 1, At, B1); PG8_BAR;
        }
        PG8_STAMP();
        if constexpr (!Epi::AFTER_DRAIN) { E(acc, cur, wr, wc, fr, fq); S.done(cur); }
        PG8_STAMP();
        if (!has_next) break;
#pragma unroll
        for (int a = 0; a < 2; ++a)
#pragma unroll
            for (int b = 0; b < 2; ++b)
#pragma unroll
                for (int m = 0; m < 4; ++m)
#pragma unroll
                    for (int n = 0; n < 2; ++n) acc[a][b][m][n] = (f32x4){0.f, 0.f, 0.f, 0.f};
        cur = nxt; cA = nA; cB = nB; ++ui;
    }
    PG8_WAIT_V(0);
    if (wr == 0) PG8_BAR;
    PG8_BAR;
    if constexpr (Epi::AFTER_DRAIN) { E.fused(acc, cur, wr, wc, fr, fq, lds, wid, lane); S.done(cur); }
    PG8_STAMP();
    if (STAMP && wid == 0) { stamps[lane] = lane < nts ? (((unsigned long long)(unsigned)ts_hi << 32) | (unsigned)ts_lo) : 0ull;
        if (lane == 62) stamps[62] = rt_entry; if (lane == 63) stamps[63] = (unsigned long long)wall_clock64(); }
#undef PG8_STAMP
#undef PG8_SA
#undef PG8_SB
#undef PG8_STAGE
#undef PG8_LDA
#undef PG8_LDB
#undef PG8_MMA
#undef PG8_WAIT_V
#undef PG8_WAIT_L
#undef PG8_BAR
#undef PG8_SCHED
}
}
#define XB_TMO      128
#define XB_XCNT(j)  (256  + 64 * (j))
#define XB_XSUB(j)  (1280 + 64 * (j))
#define XB_XGEN(j)  (2304 + 64 * (j))
#define XB_TOP      3328
#define XB_TOPGEN   3392
#define XCD_BAR_WORDS 3456
#define XB_SPIN_CAP (1u << 18)
#define LAS __attribute__((address_space(3)))

__device__ __forceinline__ unsigned xb_ld(unsigned* p)              { return __hip_atomic_load(p, __ATOMIC_RELAXED, __HIP_MEMORY_SCOPE_AGENT); }
__device__ __forceinline__ unsigned xb_add(unsigned* p, unsigned v) { return __hip_atomic_fetch_add(p, v, __ATOMIC_RELAXED, __HIP_MEMORY_SCOPE_AGENT); }
__device__ __forceinline__ unsigned xb_xcc_id() { return (unsigned)__builtin_amdgcn_s_getreg((3 << 11) | 20) & 0xFu; }
#define XB_SPIN(cond, bar) do { unsigned _sp = 0; while (cond) { __builtin_amdgcn_s_sleep(1); \
    if ((++_sp & 255u) == 0u) { if (xb_ld(&(bar)[XB_TMO])) break; if (_sp > XB_SPIN_CAP) { atomicAdd(&(bar)[XB_TMO], 1u); break; } } } } while (0)

struct XcdBarrier {
    unsigned* bar; unsigned x;
    volatile LAS unsigned* st;
};

__device__ __forceinline__ XcdBarrier xcd_barrier_post(unsigned* bar, volatile LAS unsigned* st) {
    XcdBarrier b; b.bar = bar; b.x = xb_xcc_id(); b.st = st;
    if (threadIdx.x == 0) (void)xb_add(&bar[XB_XCNT(b.x)], 1u);
    return b;
}
__device__ __forceinline__ void xcd_barrier_complete(unsigned* bar, unsigned x, unsigned& nloc, unsigned& nx) {
    const unsigned G = gridDim.x * gridDim.y * gridDim.z;
    unsigned sum, cnt, mine, sp = 0u;
    for (;;) {
        sum = 0u; cnt = 0u; mine = 0u;
#pragma unroll
        for (unsigned j = 0; j < 16; ++j) { const unsigned c = xb_ld(&bar[XB_XCNT(j)]); sum += c; cnt += (c > 0u) ? 1u : 0u; mine = (j == x) ? c : mine; }
        if (sum == G) break;
        __builtin_amdgcn_s_sleep(1);
        if ((++sp & 255u) == 0u) { if (xb_ld(&bar[XB_TMO])) break; if (sp > XB_SPIN_CAP) { atomicAdd(&bar[XB_TMO], 1u); break; } }
    }
    nloc = mine > 0u ? mine : 1u; nx = cnt > 0u ? cnt : 1u;
}

__device__ __forceinline__ void xcd_barrier(const XcdBarrier& b) {
    asm volatile("s_waitcnt vmcnt(0)" ::: "memory");
    __syncthreads();
    if (threadIdx.x == 0) {
        unsigned* bar = b.bar;
        __builtin_amdgcn_s_waitcnt(0);
        unsigned nloc = b.st[0], nx = b.st[1];
        if (nloc == 0u) { xcd_barrier_complete(bar, b.x, nloc, nx); b.st[0] = nloc; b.st[1] = nx; }
        const unsigned old = xb_add(&bar[XB_XSUB(b.x)], 1u);
        const unsigned gen = old / nloc;
        if (old + 1u == (gen + 1u) * nloc) {
            __builtin_amdgcn_fence(__ATOMIC_RELEASE, "agent");
            asm volatile("s_waitcnt vmcnt(0)" ::: "memory");
            const unsigned og = xb_add(&bar[XB_TOP], 1u);
            const unsigned tg = og / nx;
            if (og + 1u == (tg + 1u) * nx) xb_add(&bar[XB_TOPGEN], 1u);
            else XB_SPIN(xb_ld(&bar[XB_TOPGEN]) == tg, bar);
            __builtin_amdgcn_fence(__ATOMIC_ACQUIRE, "agent");
            xb_add(&bar[XB_XGEN(b.x)], 1u);
            asm volatile("s_waitcnt vmcnt(0)" ::: "memory");
        } else {
            XB_SPIN(xb_ld(&bar[XB_XGEN(b.x)]) == gen, bar);
            __builtin_amdgcn_fence(__ATOMIC_ACQUIRE, "agent");
            asm volatile("s_waitcnt vmcnt(0)" ::: "memory");
        }
    }
    __syncthreads();
}

using pg8::bf16_t; using pg8::f32x4; using pg8::u32x4; using pg8::u32x2; using pg8::bf16x8;
constexpr int D = 2048, MP = 8192, MSAMP = 512, MROWS = 8704, NINP = 6400, NIN = 6160, DFF = 5632;
constexpr int C_BG = 0, C_CG = 1024, C_VC = 2048, C_Q = 3072, C_K = 3584, C_V = 4096, C_R = 5120, C_G1 = 6144;
constexpr size_t al256(size_t x) { return (x + 255) & ~(size_t)255; }
constexpr size_t WS_WT_IN = 0;
constexpr size_t WS_WT_OUT = WS_WT_IN + al256((size_t)NINP * D * 2);
constexpr size_t WS_WT_XQ = WS_WT_OUT + al256((size_t)D * D * 2);
constexpr size_t WS_WT_XO = WS_WT_XQ + al256((size_t)D * D * 2);
constexpr size_t WS_WT_XKV = WS_WT_XO + al256((size_t)D * D * 2);
constexpr size_t WS_WT_FGU = WS_WT_XKV + al256((size_t)2 * D * D * 2);
constexpr size_t WS_WT_FD = WS_WT_FGU + al256((size_t)2 * DFF * D * 2);
constexpr size_t WS_XN = WS_WT_FD + al256((size_t)D * DFF * 2);
constexpr size_t WS_MEMN = WS_XN + al256((size_t)MROWS * D * 2);
constexpr size_t WS_PROJ = WS_MEMN + al256((size_t)1024 * D * 2);
constexpr size_t WS_MIXIN = WS_PROJ + al256((size_t)MROWS * NINP * 2);
constexpr size_t WS_H = WS_MIXIN + al256((size_t)MROWS * D * 2);
constexpr size_t WS_HG = WS_H + al256((size_t)MROWS * D * 4);
constexpr size_t WS_MKB = WS_HG + al256((size_t)MROWS * D * 2);
constexpr size_t WS_MVT = WS_MKB + al256((size_t)1024 * D * 2);
constexpr size_t WS_OG = WS_MVT + al256((size_t)1024 * D * 2);
constexpr size_t WS_GU = WS_OG + al256((size_t)MP * 1024 * 4);
constexpr size_t WS_SSQ1 = WS_GU + al256((size_t)MROWS * 2 * DFF * 2);
constexpr size_t WS_SSQ2 = WS_SSQ1 + al256((size_t)MROWS * 32 * 4);
constexpr size_t WS_SSQ3 = WS_SSQ2 + al256((size_t)MROWS * 32 * 4);
constexpr size_t WS_F = WS_SSQ3 + al256((size_t)MROWS * 32 * 4);
constexpr size_t WS_BAR = WS_F + al256((size_t)MROWS * 512 * 4);
constexpr size_t WS_END = WS_BAR + al256((size_t)(XCD_BAR_WORDS + 64) * 4);
constexpr size_t O_Y = 0, O_CONV_P = 17825792, O_GLA_P = 17833984, O_FFN_P = 18358272, O_MK = 18403328, O_MV = 20500480, O_CONV_S = 22597632, O_GLA_S = 22859776, O_FFN_S = 39636992;
constexpr int LDS_BYTES = 147456;
constexpr size_t GL_SST_OFF = 67108864, GL_EL_OFF = 67108864 + 33554432;

struct Args { const float* in[28]; float* out; unsigned char* ws; };
enum { I_XP = 0, I_XS, I_MEM, I_CCONV, I_SGLA, I_CFFN, I_CMK, I_CMV, I_NMIX, I_WIN, I_CONVW, I_WG2, I_BG, I_GLAN, I_WOUT, I_NX, I_NMEM, I_WXQ, I_WXK, I_WXV, I_WXO, I_NF, I_WFG, I_WFU, I_FCW, I_FCB, I_WFD, I_NFIN };

__device__ __forceinline__ float bflo(unsigned w) { return __uint_as_float(w << 16); }
__device__ __forceinline__ float bfhi(unsigned w) { return __uint_as_float(w & 0xffff0000u); }
__device__ __forceinline__ float bf2f(bf16_t b) { return __uint_as_float(((unsigned)b) << 16); }
__device__ __forceinline__ bf16_t f2bf(float f) { unsigned u = __float_as_uint(f); u += 0x7FFFu + ((u >> 16) & 1u); return (bf16_t)(u >> 16); }
__device__ __forceinline__ float silu_f(float x) { return x * __builtin_amdgcn_rcpf(1.0f + __expf(-x)); }
__device__ __forceinline__ float log_forget(float z) { const float ls = fminf(z, 0.f) - __logf(1.0f + __expf(-fabsf(z))); return ls * 0.0625f; }
template <int CTRL> __device__ __forceinline__ float dpp_f(float x) { return __int_as_float(__builtin_amdgcn_update_dpp(0, __float_as_int(x), CTRL, 0xf, 0xf, false)); }
__device__ __forceinline__ float rdl(float x, int l) { return __int_as_float(__builtin_amdgcn_readlane(__float_as_int(x), l)); }
__device__ __forceinline__ float wave_sum(float v) {
    v += dpp_f<0xB1>(v);
    v += dpp_f<0x4E>(v);
    v += dpp_f<0x141>(v);
    v += dpp_f<0x140>(v);
    return (rdl(v, 0) + rdl(v, 16)) + (rdl(v, 32) + rdl(v, 48)); }
__device__ __forceinline__ float wave_max(float v) {
    v = fmaxf(v, dpp_f<0xB1>(v)); v = fmaxf(v, dpp_f<0x4E>(v)); v = fmaxf(v, dpp_f<0x141>(v)); v = fmaxf(v, dpp_f<0x140>(v));
    return fmaxf(fmaxf(rdl(v, 0), rdl(v, 16)), fmaxf(rdl(v, 32), rdl(v, 48))); }
__device__ __forceinline__ void unpack8(const u32x4 w, float (&f)[8]) { f[0] = bflo(w.x); f[1] = bfhi(w.x); f[2] = bflo(w.y); f[3] = bfhi(w.y); f[4] = bflo(w.z); f[5] = bfhi(w.z); f[6] = bflo(w.w); f[7] = bfhi(w.w); }

constexpr int TT_WIN = 800, TT_SQ = 256, TT_FF = 704, TT_TOTAL = 800 + 5 * 256 + 3 * 704;
__device__ __forceinline__ void tr_decode(const Args& a, int gi, const float*& src, bf16_t*& dst, int& K, int& N, int& k0, int& n0, int& ilv) {
    unsigned char* ws = a.ws; int nkt; ilv = 0;
    if (gi < TT_WIN) { src = a.in[I_WIN]; dst = (bf16_t*)(ws + WS_WT_IN); K = D; N = NIN; nkt = 32; }
    else { gi -= TT_WIN;
        if (gi < 5 * TT_SQ) { const int j = gi >> 8; gi &= 255; K = D; N = D; nkt = 32;
            { const float* p0 = a.in[I_WXK]; const float* p1 = a.in[I_WXV]; const float* p2 = a.in[I_WOUT]; const float* p3 = a.in[I_WXQ]; const float* p4 = a.in[I_WXO];
              src = j == 0 ? p0 : j == 1 ? p1 : j == 2 ? p2 : j == 3 ? p3 : p4; }
            dst = (bf16_t*)(ws + (j <= 1 ? WS_WT_XKV : j == 2 ? WS_WT_OUT : j == 3 ? WS_WT_XQ : WS_WT_XO)) + (j == 1 ? (size_t)D * D : 0); }
        else { gi -= 5 * TT_SQ;
            if (gi < TT_FF) { src = a.in[I_WFG]; dst = (bf16_t*)(ws + WS_WT_FGU); K = D; N = DFF; nkt = 32; ilv = 1; }
            else if (gi < 2 * TT_FF) { gi -= TT_FF; src = a.in[I_WFU]; dst = (bf16_t*)(ws + WS_WT_FGU); K = D; N = DFF; nkt = 32; ilv = 2; }
            else { gi -= 2 * TT_FF; src = a.in[I_WFD]; dst = (bf16_t*)(ws + WS_WT_FD); K = DFF; N = D; nkt = 88; } } }
    k0 = (gi % nkt) * 64; n0 = (gi / nkt) * 256;
}
constexpr int TT_EARLY = TT_WIN + 2 * TT_SQ;
__device__ __forceinline__ void phase_transposes(const Args& a, float* tile, int lo, int hi, unsigned* ctr, volatile int* qslot) {
    const int tid = tid_opq(), r = tid >> 6, c4 = (tid & 63) * 4;
    int gi;
    if (ctr) { if (tid == 0) *qslot = lo + (int)atomicAdd(ctr, 1u); __syncthreads(); gi = *qslot; __syncthreads(); } else gi = lo + blockIdx.x;
    if (gi >= hi) return;
    const float* src; bf16_t* dst; int K, N, k0, n0, ilv; f32x4 v[8];
    tr_decode(a, gi, src, dst, K, N, k0, n0, ilv);
#pragma unroll
    for (int i = 0; i < 8; ++i) { v[i] = (f32x4){0.f, 0.f, 0.f, 0.f}; if (n0 + c4 < N) v[i] = __builtin_nontemporal_load((const f32x4*)(src + (size_t)(k0 + r + 8 * i) * N + n0 + c4)); }
    for (;;) {
#pragma unroll
        for (int i = 0; i < 8; ++i) { float* tp = tile + (r + 8 * i) * 257 + c4; tp[0] = v[i][0]; tp[1] = v[i][1]; tp[2] = v[i][2]; tp[3] = v[i][3]; }
        if (ctr && tid == 0) *qslot = lo + (int)atomicAdd(ctr, 1u);
        __syncthreads();
        const int nrow = n0 + (tid >> 1);
        bf16_t* cdst = dst + (size_t)(ilv ? ((nrow >> 7) * 256 + (nrow & 127) + (ilv == 2 ? 128 : 0)) : nrow) * K + k0 + (tid & 1) * 32;
        gi = ctr ? *qslot : gi + (int)gridDim.x; const bool more = gi < hi;
        if (more) { tr_decode(a, gi, src, dst, K, N, k0, n0, ilv);
#pragma unroll
            for (int i = 0; i < 8; ++i) { v[i] = (f32x4){0.f, 0.f, 0.f, 0.f}; if (n0 + c4 < N) v[i] = __builtin_nontemporal_load((const f32x4*)(src + (size_t)(k0 + r + 8 * i) * N + n0 + c4)); } }
        { const float* tp = tile + ((tid & 1) * 32) * 257 + (tid >> 1);
#pragma unroll
            for (int q = 0; q < 4; ++q) { u32x4 w; w.x = pg8::cvt_pk_bf16(tp[(q * 8 + 0) * 257], tp[(q * 8 + 1) * 257]); w.y = pg8::cvt_pk_bf16(tp[(q * 8 + 2) * 257], tp[(q * 8 + 3) * 257]);
                w.z = pg8::cvt_pk_bf16(tp[(q * 8 + 4) * 257], tp[(q * 8 + 5) * 257]); w.w = pg8::cvt_pk_bf16(tp[(q * 8 + 6) * 257], tp[(q * 8 + 7) * 257]);
                *(u32x4*)(cdst + q * 8) = w; } }
        __syncthreads();
        if (!more) break;
    }
}
__device__ __forceinline__ const float* prep_row_src(const Args& a, int row) { return row < MP ? a.in[I_XP] + (size_t)row * D : row < MROWS ? a.in[I_XS] + (size_t)(row - MP) * D : a.in[I_MEM] + (size_t)(row - MROWS) * D; }
__device__ __forceinline__ void phase_prep(const Args& a, float* lds) {
    unsigned char* ws = a.ws;
    phase_transposes(a, lds, 0, TT_EARLY, nullptr, nullptr);
    const int lane = tid_opq() & 63, gw = blockIdx.x * 8 + (tid_opq() >> 6), nw = gridDim.x * 8;
    int row = gw; if (row >= MROWS + 1024) return;
    f32x4 v[8];
    { const float* x = prep_row_src(a, row);
#pragma unroll
      for (int i = 0; i < 8; ++i) v[i] = __builtin_nontemporal_load((const f32x4*)(x + (i * 64 + lane) * 4)); }
    for (;;) {
        const int nrow = row + nw; const bool more = nrow < MROWS + 1024;
        f32x4 nv[8];
        if (more) { const float* x = prep_row_src(a, nrow);
#pragma unroll
            for (int i = 0; i < 8; ++i) nv[i] = __builtin_nontemporal_load((const f32x4*)(x + (i * 64 + lane) * 4)); }
        float ss = 0.f;
#pragma unroll
        for (int i = 0; i < 8; ++i) ss += (v[i][0] * v[i][0] + v[i][1] * v[i][1]) + (v[i][2] * v[i][2] + v[i][3] * v[i][3]);
        ss = wave_sum(ss); const float rs = rsqrtf(ss * (1.0f / 2048.0f) + 1e-6f);
        const float* gain = row < MROWS ? a.in[I_NMIX] : a.in[I_NMEM];
        bf16_t* o = row < MROWS ? (bf16_t*)(ws + WS_XN) + (size_t)row * D : (bf16_t*)(ws + WS_MEMN) + (size_t)(row - MROWS) * D;
#pragma unroll
        for (int i = 0; i < 8; ++i) { const f32x4 g = *(const f32x4*)(gain + (i * 64 + lane) * 4); u32x2 w; w.x = pg8::cvt_pk_bf16(v[i][0] * rs * g[0], v[i][1] * rs * g[1]); w.y = pg8::cvt_pk_bf16(v[i][2] * rs * g[2], v[i][3] * rs * g[3]);
            *(u32x2*)(o + (i * 64 + lane) * 4) = w; }
        if (!more) break;
#pragma unroll
        for (int i = 0; i < 8; ++i) v[i] = nv[i];
        row = nrow;
    }
}


__device__ __forceinline__ void gla_prompt_item(const Args& a, int item, float* lds) {
    const int tid = tid_opq(), b = item >> 6, h = (item >> 4) & 3, sl = item & 15;
    float* qs = lds; float* ks = qs + 4096; float* fs = ks + 4096; float* vs = fs + 4096; float* opart = vs + 512;
    const bf16_t* proj = (const bf16_t*)(a.ws + WS_PROJ) + (size_t)(b * 2048) * NINP;
    const float* Fg = (const float*)(a.ws + WS_F) + (size_t)(b * 2048) * 512 + h * 128;
    float* og = (float*)(a.ws + WS_OG);
    const int tt = tid >> 4, sub = tid & 15;
    const int dv = tid & 15, dkg = tid >> 4;
    float s0 = 0.f, s1 = 0.f, s2 = 0.f, s3 = 0.f;
    u32x4 rq, rk; f32x4 rf0, rf1; bf16_t rv;
    { const bf16_t* row = proj + (size_t)tt * NINP; rq = *(const u32x4*)(row + C_Q + h * 128 + sub * 8); rk = *(const u32x4*)(row + C_K + h * 128 + sub * 8);
      rf0 = *(const f32x4*)(Fg + (size_t)tt * 512 + sub * 8); rf1 = *(const f32x4*)(Fg + (size_t)tt * 512 + sub * 8 + 4); rv = row[C_V + h * 256 + sl * 16 + sub]; }
    for (int n = 0; n < 64; ++n) {
        { float qf[8], kf[8]; unpack8(rq, qf); unpack8(rk, kf);
            float* fp = fs + tt * 128 + sub * 8; float* qp = qs + tt * 128 + sub * 8; float* kp = ks + tt * 128 + sub * 8;
            *(f32x4*)fp = rf0; *(f32x4*)(fp + 4) = rf1;
            *(f32x4*)qp = (f32x4){qf[0], qf[1], qf[2], qf[3]} * 0.08838834764831845f; *(f32x4*)(qp + 4) = (f32x4){qf[4], qf[5], qf[6], qf[7]} * 0.08838834764831845f;
            *(f32x4*)kp = (f32x4){kf[0], kf[1], kf[2], kf[3]}; *(f32x4*)(kp + 4) = (f32x4){kf[4], kf[5], kf[6], kf[7]};
            vs[tt * 16 + sub] = bf2f(rv); }
        __syncthreads();
        if (n + 1 < 64) { const bf16_t* row = proj + (size_t)((n + 1) * 32 + tt) * NINP; rq = *(const u32x4*)(row + C_Q + h * 128 + sub * 8); rk = *(const u32x4*)(row + C_K + h * 128 + sub * 8);
            const float* fr_ = Fg + (size_t)((n + 1) * 32 + tt) * 512 + sub * 8; rf0 = *(const f32x4*)fr_; rf1 = *(const f32x4*)(fr_ + 4); rv = row[C_V + h * 256 + sl * 16 + sub]; }
#pragma unroll 8
        for (int t = 0; t < 32; ++t) {
            const f32x4 f4 = *(const f32x4*)(fs + t * 128 + dkg * 4), k4 = *(const f32x4*)(ks + t * 128 + dkg * 4), q4 = *(const f32x4*)(qs + t * 128 + dkg * 4); const float v = vs[t * 16 + dv];
            s0 = f4[0] * s0 + k4[0] * v; s1 = f4[1] * s1 + k4[1] * v; s2 = f4[2] * s2 + k4[2] * v; s3 = f4[3] * s3 + k4[3] * v;
            opart[dkg * 528 + t * 16 + dv] = (q4[0] * s0 + q4[1] * s1) + (q4[2] * s2 + q4[3] * s3); }
        __syncthreads();
        { float o = 0.f;
#pragma unroll 8
            for (int g = 0; g < 32; ++g) o += opart[g * 528 + tid];
            og[(size_t)(b * 2048 + n * 32 + (tid >> 4)) * 1024 + h * 256 + sl * 16 + (tid & 15)] = o; }
    }
    float* so = a.out + O_GLA_P + ((size_t)((b * 4 + h) * 128 + dkg * 4)) * 256 + sl * 16 + dv;
    so[0] = s0; so[256] = s1; so[512] = s2; so[768] = s3;
    __syncthreads();
}

__device__ __forceinline__ void gla_sample_item(const Args& a, int it, float* lds) {
    const int tid = tid_opq(), b = it >> 2, h = it & 3, lane = tid & 63, wid = tid >> 6;
    float* qs = lds; float* ks = qs + 512; float* fs = ks + 512; float* vs = fs + 512; float* red = vs + 1024; float* rsum = red + 512;
    const bf16_t* proj = (const bf16_t*)(a.ws + WS_PROJ) + (size_t)(MP + b * 4) * NINP;
    { const int t = tid >> 7, dk = tid & 127; const bf16_t* row = proj + (size_t)t * NINP;
        fs[tid] = __expf(((const float*)(a.ws + WS_F))[(size_t)(MP + b * 4 + t) * 512 + h * 128 + dk]); qs[tid] = bf2f(row[C_Q + h * 128 + dk]) * 0.08838834764831845f; ks[tid] = bf2f(row[C_K + h * 128 + dk]); }
#pragma unroll
    for (int i = 0; i < 2; ++i) { const int idx = tid + i * 512, t = idx >> 8, d = idx & 255; vs[idx] = bf2f(proj[(size_t)t * NINP + C_V + h * 256 + d]); }
    const int dv = tid & 255, half = tid >> 8;
    float s[64];
    const float* sp = a.in[I_SGLA] + ((size_t)((b * 4 + h) * 128 + half * 64)) * 256 + dv;
#pragma unroll
    for (int j = 0; j < 64; ++j) s[j] = __builtin_nontemporal_load(sp + (size_t)j * 256);
    __syncthreads();
    float ov[4];
#pragma unroll
    for (int t = 0; t < 4; ++t) { const float v = vs[t * 256 + dv]; float po = 0.f;
#pragma unroll
        for (int j = 0; j < 64; j += 4) { const f32x4 f4 = *(const f32x4*)(fs + t * 128 + half * 64 + j), k4 = *(const f32x4*)(ks + t * 128 + half * 64 + j), q4 = *(const f32x4*)(qs + t * 128 + half * 64 + j);
#pragma unroll
            for (int e = 0; e < 4; ++e) { s[j + e] = f4[e] * s[j + e] + k4[e] * v; po += q4[e] * s[j + e]; } }
        red[t * 512 + half * 256 + dv] = po; ov[t] = po; }
    float* so = a.out + O_GLA_S + ((size_t)((b * 4 + h) * 128 + half * 64)) * 256 + dv;
#pragma unroll
    for (int j = 0; j < 64; ++j) __builtin_nontemporal_store(s[j], so + (size_t)j * 256);
    __syncthreads();
    float* rs2 = red + 2048;
#pragma unroll
    for (int t = 0; t < 4; ++t) { const float o = red[t * 512 + dv] + red[t * 512 + 256 + dv]; ov[t] = o; const float ss = wave_sum(o * o); if (lane == 0) rs2[t * 8 + wid] = ss; }
    __syncthreads();
    if (half == 0) {
#pragma unroll
        for (int t = 0; t < 4; ++t) { const float tot = (rs2[t * 8] + rs2[t * 8 + 1]) + (rs2[t * 8 + 2] + rs2[t * 8 + 3]); const float rstd = rsqrtf(tot * (1.0f / 256.0f) + 1e-6f);
            const float rg = bf2f(proj[(size_t)t * NINP + C_R + h * 256 + dv]);
            ((bf16_t*)(a.ws + WS_MIXIN))[(size_t)(MP + b * 4 + t) * D + 1024 + h * 256 + dv] = f2bf(ov[t] * rstd * a.in[I_GLAN][h * 256 + dv] * silu_f(rg)); } }
    __syncthreads();
}

struct RowRaw { u32x4 bg[2], c0[2], v0[2], c1[2], v1[2], c2[2], v2[2], g1a, g1b; };
__device__ __forceinline__ void rows_pre_load(const bf16_t* __restrict__ projb, int row, int lane, RowRaw& R) {
    const bool samp = row >= MP; const int t = samp ? ((row - MP) & 3) : (row & 2047);
    const bf16_t* pr = projb + (size_t)row * NINP; const int b1 = t >= 1 ? NINP : 0, b2 = t >= 2 ? 2 * NINP : 0;
#pragma unroll
    for (int i = 0; i < 2; ++i) { const int c = i * 512 + lane * 8;
        R.bg[i] = *(const u32x4*)(pr + C_BG + c); R.c2[i] = *(const u32x4*)(pr + C_CG + c); R.v2[i] = *(const u32x4*)(pr + C_VC + c);
        R.c1[i] = *(const u32x4*)(pr - b1 + C_CG + c); R.v1[i] = *(const u32x4*)(pr - b1 + C_VC + c);
        R.c0[i] = *(const u32x4*)(pr - b2 + C_CG + c); R.v0[i] = *(const u32x4*)(pr - b2 + C_VC + c); }
    R.g1a = *(const u32x4*)(pr + C_G1); R.g1b = *(const u32x4*)(pr + C_G1 + 8);
}
__device__ __forceinline__ void rows_pre_compute(const Args& a, int row, int lane, const RowRaw& R) {
    bf16_t* mix = (bf16_t*)(a.ws + WS_MIXIN); const float* cw = a.in[I_CONVW];
    const bool samp = row >= MP; const int t = samp ? ((row - MP) & 3) : (row & 2047), bi = samp ? ((row - MP) >> 2) : (row >> 11);
#pragma unroll
    for (int i = 0; i < 2; ++i) { const int c = i * 512 + lane * 8;
        float bg[8], cgv[8], vcv[8], u2[8], u1[8], u0[8];
        unpack8(R.bg[i], bg); unpack8(R.c2[i], cgv); unpack8(R.v2[i], vcv);
#pragma unroll
        for (int j = 0; j < 8; ++j) u2[j] = cgv[j] * vcv[j];
        if (t >= 1) { unpack8(R.c1[i], cgv); unpack8(R.v1[i], vcv);
#pragma unroll
            for (int j = 0; j < 8; ++j) u1[j] = cgv[j] * vcv[j]; }
        else if (samp) { const float* cp = a.in[I_CCONV] + (size_t)(bi * 2 + 1) * 1024 + c;
#pragma unroll
            for (int j = 0; j < 8; ++j) u1[j] = cp[j]; }
        else {
#pragma unroll
            for (int j = 0; j < 8; ++j) u1[j] = 0.f; }
        if (t >= 2) { unpack8(R.c0[i], cgv); unpack8(R.v0[i], vcv);
#pragma unroll
            for (int j = 0; j < 8; ++j) u0[j] = cgv[j] * vcv[j]; }
        else if (samp) { const float* cp = a.in[I_CCONV] + (size_t)(bi * 2 + t) * 1024 + c;
#pragma unroll
            for (int j = 0; j < 8; ++j) u0[j] = cp[j]; }
        else {
#pragma unroll
            for (int j = 0; j < 8; ++j) u0[j] = 0.f; }
        float o[8];
#pragma unroll
        for (int j = 0; j < 8; ++j) o[j] = bg[j] * (cw[c + j] * u0[j] + cw[1024 + c + j] * u1[j] + cw[2048 + c + j] * u2[j]);
        u32x4 w; w.x = pg8::cvt_pk_bf16(o[0], o[1]); w.y = pg8::cvt_pk_bf16(o[2], o[3]); w.z = pg8::cvt_pk_bf16(o[4], o[5]); w.w = pg8::cvt_pk_bf16(o[6], o[7]);
        *(u32x4*)(mix + (size_t)row * D + c) = w;
        float* cn = nullptr;
        if (!samp) { if (t >= 2046) cn = a.out + O_CONV_P + (size_t)(bi * 2 + (t - 2046)) * 1024 + c; }
        else { if (t >= 2) cn = a.out + O_CONV_S + (size_t)(bi * 2 + (t - 2)) * 1024 + c; }
        if (cn) {
#pragma unroll
            for (int j = 0; j < 8; ++j) cn[j] = u2[j]; }
    }
    {
        float g1[16]; { float t8[8]; unpack8(R.g1a, t8);
#pragma unroll
            for (int j = 0; j < 8; ++j) g1[j] = t8[j];
            unpack8(R.g1b, t8);
#pragma unroll
            for (int j = 0; j < 8; ++j) g1[8 + j] = t8[j]; }
        f32x4 z0 = *(const f32x4*)(a.in[I_BG] + lane * 8), z1 = *(const f32x4*)(a.in[I_BG] + lane * 8 + 4);
#pragma unroll
        for (int r = 0; r < 16; ++r) { z0 += *(const f32x4*)(a.in[I_WG2] + r * 512 + lane * 8) * g1[r]; z1 += *(const f32x4*)(a.in[I_WG2] + r * 512 + lane * 8 + 4) * g1[r]; }
        f32x4 f0, f1;
#pragma unroll
        for (int j = 0; j < 4; ++j) { f0[j] = log_forget(z0[j]); f1[j] = log_forget(z1[j]); }
        float* fo = (float*)(a.ws + WS_F) + (size_t)row * 512 + lane * 8; *(f32x4*)fo = f0; *(f32x4*)(fo + 4) = f1; }
}
__device__ __forceinline__ void phase_rows_pre(const Args& a) {
    const int lane = tid_opq() & 63, wid = tid_opq() >> 6;
    const bf16_t* projb = (const bf16_t*)(a.ws + WS_PROJ);
    const int per = (MROWS + (int)gridDim.x - 1) / (int)gridDim.x, base = blockIdx.x * per, lim = (base + per < MROWS) ? base + per : MROWS;
    int row = base + wid; if (row >= lim) return;
    RowRaw cur; rows_pre_load(projb, row, lane, cur);
    for (;;) {
        const int nrow = row + 8; const bool more = nrow < lim;
        RowRaw nxt; if (more) rows_pre_load(projb, nrow, lane, nxt); else nxt = cur;
        rows_pre_compute(a, row, lane, cur);
        if (!more) break;
        cur = nxt; row = nrow;
    }
}
__device__ __forceinline__ void phase_gla_norm(const Args& a) {
    const int lane = tid_opq() & 63, gw = blockIdx.x * 8 + (tid_opq() >> 6), nw = gridDim.x * 8;
    const bf16_t* projb = (const bf16_t*)(a.ws + WS_PROJ); bf16_t* mix = (bf16_t*)(a.ws + WS_MIXIN);
    for (int row = gw; row < MP; row += nw) {
        const bf16_t* pr = projb + (size_t)row * NINP;
        {
            const float* og = (const float*)(a.ws + WS_OG) + (size_t)row * 1024;
#pragma unroll
            for (int h = 0; h < 4; ++h) { const f32x4 o4 = *(const f32x4*)(og + h * 256 + lane * 4);
                const float ss = wave_sum((o4[0] * o4[0] + o4[1] * o4[1]) + (o4[2] * o4[2] + o4[3] * o4[3])); const float rstd = rsqrtf(ss * (1.0f / 256.0f) + 1e-6f);
                const f32x4 gn = *(const f32x4*)(a.in[I_GLAN] + h * 256 + lane * 4); const u32x2 rw = *(const u32x2*)(pr + C_R + h * 256 + lane * 4);
                const float r0 = bflo(rw.x), r1 = bfhi(rw.x), r2 = bflo(rw.y), r3 = bfhi(rw.y);
                u32x2 w; w.x = pg8::cvt_pk_bf16(o4[0] * rstd * gn[0] * silu_f(r0), o4[1] * rstd * gn[1] * silu_f(r1)); w.y = pg8::cvt_pk_bf16(o4[2] * rstd * gn[2] * silu_f(r2), o4[3] * rstd * gn[3] * silu_f(r3));
                *(u32x2*)(mix + (size_t)row * D + 1024 + h * 256 + lane * 4) = w; }
        }
    }
}

constexpr int GL_LDK = 72, GL_LDQ = 136;
__device__ __forceinline__ void gla_cum(const float* __restrict__ lf_base, int d, int qt, float* part, float (&cum)[16], float& Lval) {
    float run = 0.f;
#pragma unroll
    for (int jj = 0; jj < 16; ++jj) { run += lf_base[(size_t)(qt * 16 + jj) * 512 + d]; cum[jj] = run; }
    part[qt * 128 + d] = run;
    __syncthreads();
    const float p0 = part[d], p1 = part[128 + d], p2 = part[256 + d], p3 = part[384 + d];
    const float off = (qt > 0 ? p0 : 0.f) + (qt > 1 ? p1 : 0.f) + (qt > 2 ? p2 : 0.f);
#pragma unroll
    for (int jj = 0; jj < 16; ++jj) cum[jj] += off;
    Lval = (p0 + p1) + (p2 + p3);
}
__device__ __forceinline__ void gla_stage_vt(const bf16_t* __restrict__ proj_rows, int h, bf16_t* VT, int tid) {
    const int v = tid & 255, jh = tid >> 8; const bf16_t* src = proj_rows + (size_t)(jh * 32) * NINP + C_V + h * 256 + v;
#pragma unroll
    for (int q = 0; q < 4; ++q) { unsigned w[4];
#pragma unroll
        for (int e = 0; e < 4; ++e) { const unsigned lo = src[(size_t)(q * 8 + 2 * e) * NINP], hi = src[(size_t)(q * 8 + 2 * e + 1) * NINP]; w[e] = lo | (hi << 16); }
        u32x4 ww; ww.x = w[0]; ww.y = w[1]; ww.z = w[2]; ww.w = w[3]; *(u32x4*)(VT + v * GL_LDK + jh * 32 + q * 8) = ww; }
}
__device__ __forceinline__ void gla_pass_a(const Args& a, int item, unsigned char* ldsb) {
    const int tid = tid_opq(), lane = tid & 63, wid = tid >> 6, fr = lane & 15, fq = lane >> 4;
    const int b = item >> 7, h = (item >> 5) & 3, n = item & 31, row0 = b * 2048 + n * 64;
    bf16_t* KlT = (bf16_t*)ldsb; bf16_t* VT = KlT + 128 * GL_LDK; float* part = (float*)(VT + 256 * GL_LDK);
    const bf16_t* prow = (const bf16_t*)(a.ws + WS_PROJ) + (size_t)row0 * NINP;
    { const int d = tid & 127, qt = tid >> 7; float cum[16], Lv;
        gla_cum((const float*)(a.ws + WS_F) + (size_t)row0 * 512 + h * 128, d, qt, part, cum, Lv);
        const bf16_t* kp = prow + (size_t)(qt * 16) * NINP + C_K + h * 128 + d; unsigned w[8];
#pragma unroll
        for (int e = 0; e < 8; ++e) { const float k0 = bf2f(kp[(size_t)(2 * e) * NINP]) * __expf(Lv - cum[2 * e]), k1 = bf2f(kp[(size_t)(2 * e + 1) * NINP]) * __expf(Lv - cum[2 * e + 1]); w[e] = pg8::cvt_pk_bf16(k0, k1); }
        u32x4 w0, w1; w0.x = w[0]; w0.y = w[1]; w0.z = w[2]; w0.w = w[3]; w1.x = w[4]; w1.y = w[5]; w1.z = w[6]; w1.w = w[7];
        *(u32x4*)(KlT + d * GL_LDK + qt * 16) = w0; *(u32x4*)(KlT + d * GL_LDK + qt * 16 + 8) = w1;
        if (qt == 0) ((float*)(a.ws + WS_GU + GL_EL_OFF))[(size_t)item * 128 + d] = __expf(Lv); }
    gla_stage_vt(prow, h, VT, tid);
    __syncthreads();
    { const bf16x8 x0 = *(const bf16x8*)(KlT + (wid * 16 + fr) * GL_LDK + fq * 8), x1 = *(const bf16x8*)(KlT + (wid * 16 + fr) * GL_LDK + 32 + fq * 8);
        float* kc = (float*)(a.ws + WS_GU) + (size_t)item * 32768 + wid * 16 + 4 * fq;
#pragma unroll 4
        for (int vt = 0; vt < 16; ++vt) { const bf16x8 y0 = *(const bf16x8*)(VT + (vt * 16 + fr) * GL_LDK + fq * 8), y1 = *(const bf16x8*)(VT + (vt * 16 + fr) * GL_LDK + 32 + fq * 8);
            f32x4 acc = (f32x4){0.f, 0.f, 0.f, 0.f};
            acc = __builtin_amdgcn_mfma_f32_16x16x32_bf16(x0, y0, acc, 0, 0, 0); acc = __builtin_amdgcn_mfma_f32_16x16x32_bf16(x1, y1, acc, 0, 0, 0);
            *(f32x4*)(kc + (size_t)(vt * 16 + fr) * 128) = acc; } }
    __syncthreads();
}
__device__ __forceinline__ void gla_pass_b(const Args& a) {
    const float* KC = (const float*)(a.ws + WS_GU); const float* EL = (const float*)(a.ws + WS_GU + GL_EL_OFF); bf16_t* SST = (bf16_t*)(a.ws + WS_GU + GL_SST_OFF);
    for (int gid = blockIdx.x * 512 + tid_opq(); gid < 131072; gid += gridDim.x * 512) {
        const int bh = gid >> 13, v = (gid >> 5) & 255, d4 = (gid & 31) * 4;
        f32x4 s = (f32x4){0.f, 0.f, 0.f, 0.f};
#pragma unroll 8
        for (int n = 0; n < 32; ++n) { const int item = bh * 32 + n;
            const f32x4 kc = *(const f32x4*)(KC + (size_t)item * 32768 + v * 128 + d4), el = *(const f32x4*)(EL + (size_t)item * 128 + d4);
            u32x2 w; w.x = pg8::cvt_pk_bf16(s[0], s[1]); w.y = pg8::cvt_pk_bf16(s[2], s[3]); *(u32x2*)(SST + (size_t)item * 32768 + v * 128 + d4) = w;
            s = el * s + kc; }
        float* so = a.out + O_GLA_P + ((size_t)(bh * 128 + d4)) * 256 + v; so[0] = s[0]; so[256] = s[1]; so[512] = s[2]; so[768] = s[3];
    }
}
__device__ __forceinline__ void gla_pass_c(const Args& a, int item, unsigned char* ldsb) {
    const int tid = tid_opq(), lane = tid & 63, wid = tid >> 6, fr = lane & 15, fq = lane >> 4;
    const int b = item >> 7, h = (item >> 5) & 3, n = item & 31, row0 = b * 2048 + n * 64;
    bf16_t* Qd = (bf16_t*)ldsb; bf16_t* Kd = Qd + 64 * GL_LDQ; bf16_t* VT = Kd + 64 * GL_LDQ; bf16_t* SS = VT + 256 * GL_LDK; float* part = (float*)(SS + 256 * GL_LDQ); float* red = part + 512;
    const bf16_t* sst = (const bf16_t*)(a.ws + WS_GU + GL_SST_OFF) + (size_t)item * 32768;
    u32x4 sr[8];
#pragma unroll
    for (int i = 0; i < 8; ++i) sr[i] = *(const u32x4*)(sst + (size_t)(tid + 512 * i) * 8);
    const bf16_t* prow = (const bf16_t*)(a.ws + WS_PROJ) + (size_t)row0 * NINP;
    { const int d = tid & 127, qt = tid >> 7; float cum[16], Lv;
        const bf16_t* qp = prow + (size_t)(qt * 16) * NINP + C_Q + h * 128 + d; const bf16_t* kp = qp + (C_K - C_Q);
        bf16_t qraw[16], kraw[16];
#pragma unroll
        for (int jj = 0; jj < 16; ++jj) { qraw[jj] = qp[(size_t)jj * NINP]; kraw[jj] = kp[(size_t)jj * NINP]; }
        const int vv = tid & 255, jh = tid >> 8; const bf16_t* vsrc = prow + (size_t)(jh * 32) * NINP + C_V + h * 256 + vv; unsigned vw[16];
#pragma unroll
        for (int e = 0; e < 16; ++e) { const unsigned lo = vsrc[(size_t)(2 * e) * NINP], hi = vsrc[(size_t)(2 * e + 1) * NINP]; vw[e] = lo | (hi << 16); }
        gla_cum((const float*)(a.ws + WS_F) + (size_t)row0 * 512 + h * 128, d, qt, part, cum, Lv);
#pragma unroll
        for (int jj = 0; jj < 16; ++jj) { const float e = __expf(cum[jj]);
            const unsigned qk = pg8::cvt_pk_bf16(bf2f(qraw[jj]) * 0.08838834764831845f * e, bf2f(kraw[jj]) * __builtin_amdgcn_rcpf(e));
            Qd[(qt * 16 + jj) * GL_LDQ + d] = (bf16_t)(qk & 0xffffu); Kd[(qt * 16 + jj) * GL_LDQ + d] = (bf16_t)(qk >> 16); }
#pragma unroll
        for (int q = 0; q < 4; ++q) { u32x4 ww; ww.x = vw[4 * q]; ww.y = vw[4 * q + 1]; ww.z = vw[4 * q + 2]; ww.w = vw[4 * q + 3]; *(u32x4*)(VT + vv * GL_LDK + jh * 32 + q * 8) = ww; } }
#pragma unroll
    for (int i = 0; i < 8; ++i) { const int id = tid + 512 * i; *(u32x4*)(SS + (id >> 4) * GL_LDQ + (id & 15) * 8) = sr[i]; }
    __syncthreads();
    const int it = wid >> 1, vh = wid & 1;
    bf16x8 qf[4];
#pragma unroll
    for (int ks = 0; ks < 4; ++ks) qf[ks] = *(const bf16x8*)(Qd + (it * 16 + fr) * GL_LDQ + ks * 32 + fq * 8);
    f32x4 aa[4];
#pragma unroll
    for (int jt = 0; jt < 4; ++jt) { f32x4 acc = (f32x4){0.f, 0.f, 0.f, 0.f};
        if (jt <= it) {
#pragma unroll
            for (int ks = 0; ks < 4; ++ks) { const bf16x8 kf = *(const bf16x8*)(Kd + (jt * 16 + fr) * GL_LDQ + ks * 32 + fq * 8); acc = __builtin_amdgcn_mfma_f32_16x16x32_bf16(kf, qf[ks], acc, 0, 0, 0); }
            if (jt == it) {
#pragma unroll
                for (int e = 0; e < 4; ++e) if (4 * fq + e > fr) acc[e] = 0.f; } }
        aa[jt] = acc; }
    bf16x8 pa[2];
#pragma unroll
    for (int s = 0; s < 2; ++s) { const u32x4 w = pg8::pack8(aa[2 * s], aa[2 * s + 1]); pa[s] = __builtin_bit_cast(bf16x8, w); }
    f32x4 o[8]; float ss = 0.f;
#pragma unroll
    for (int vt = 0; vt < 8; ++vt) { const int vrow = (vh * 8 + vt) * 16 + fr; f32x4 acc = (f32x4){0.f, 0.f, 0.f, 0.f};
#pragma unroll
        for (int s = 0; s < 2; ++s) { const u32x2 lo = *(const u32x2*)(VT + vrow * GL_LDK + 32 * s + 4 * fq), hi = *(const u32x2*)(VT + vrow * GL_LDK + 32 * s + 16 + 4 * fq);
            u32x4 w; w.x = lo.x; w.y = lo.y; w.z = hi.x; w.w = hi.y; acc = __builtin_amdgcn_mfma_f32_16x16x32_bf16(__builtin_bit_cast(bf16x8, w), pa[s], acc, 0, 0, 0); }
#pragma unroll
        for (int ks = 0; ks < 4; ++ks) { const bf16x8 sf = *(const bf16x8*)(SS + vrow * GL_LDQ + ks * 32 + fq * 8); acc = __builtin_amdgcn_mfma_f32_16x16x32_bf16(sf, qf[ks], acc, 0, 0, 0); }
        o[vt] = acc; ss += (acc[0] * acc[0] + acc[1] * acc[1]) + (acc[2] * acc[2] + acc[3] * acc[3]); }
    ss += __shfl_xor(ss, 16); ss += __shfl_xor(ss, 32);
    if (fq == 0) red[(it * 16 + fr) * 2 + vh] = ss;
    __syncthreads();
    { const float tot = red[(it * 16 + fr) * 2] + red[(it * 16 + fr) * 2 + 1]; const float rstd = rsqrtf(tot * (1.0f / 256.0f) + 1e-6f);
        const int row = row0 + it * 16 + fr; const bf16_t* rg = prow + (size_t)(it * 16 + fr) * NINP + C_R + h * 256; bf16_t* mo = (bf16_t*)(a.ws + WS_MIXIN) + (size_t)row * D + 1024 + h * 256;
#pragma unroll
        for (int vt = 0; vt < 8; ++vt) { const int v0 = (vh * 8 + vt) * 16 + 4 * fq; const f32x4 gn = *(const f32x4*)(a.in[I_GLAN] + h * 256 + v0); const u32x2 rw = *(const u32x2*)(rg + v0);
            u32x2 w; w.x = pg8::cvt_pk_bf16(o[vt][0] * rstd * gn[0] * silu_f(bflo(rw.x)), o[vt][1] * rstd * gn[1] * silu_f(bfhi(rw.x)));
            w.y = pg8::cvt_pk_bf16(o[vt][2] * rstd * gn[2] * silu_f(bflo(rw.y)), o[vt][3] * rstd * gn[3] * silu_f(bfhi(rw.y)));
            *(u32x2*)(mo + v0) = w; } }
    __syncthreads();
}

constexpr int XA_LDK = 136, XA_LDV = 264, XA_BUF = 128 * 264;
__device__ __forceinline__ void xattn_prompt_item(const Args& a, int it, unsigned char* ldsb) {
    const int tid = tid_opq(), lane = tid & 63, wid = tid >> 6, fr = lane & 15, fq = lane >> 4;
    const int b = it >> 6, h = (it >> 4) & 3, tt = it & 15;
    const int r0 = b * 2048 + tt * 128 + wid * 16;
    bf16_t* buf0 = (bf16_t*)ldsb; bf16_t* buf1 = buf0 + 34816;
    const bf16_t* qp = (const bf16_t*)(a.ws + WS_XN) + (size_t)(r0 + fr) * D + h * 512 + fq * 8;
    const bf16_t* kg = (const bf16_t*)(a.ws + WS_MKB) + (size_t)(b * 256) * D + h * 512;
    const bf16_t* vg = (const bf16_t*)(a.ws + WS_MVT) + (size_t)(b * 2048 + h * 512) * 256;
    u32x4 rs[8];
#pragma unroll
    for (int i = 0; i < 8; ++i) { const int id = tid + 512 * i, row = id >> 4, sg = id & 15; rs[i] = *(const u32x4*)(kg + (size_t)row * D + sg * 8); }
#pragma unroll
    for (int i = 0; i < 8; ++i) { const int id = tid + 512 * i, row = id >> 4, sg = id & 15; *(u32x4*)(buf0 + row * XA_LDK + sg * 8) = rs[i]; }
    __syncthreads();
    f32x4 st[16];
#pragma unroll
    for (int n = 0; n < 16; ++n) st[n] = (f32x4){0.f, 0.f, 0.f, 0.f};
#pragma unroll
    for (int c = 0; c < 4; ++c) {
        bf16_t* cur = (c & 1) ? buf1 : buf0; bf16_t* nxt = (c & 1) ? buf0 : buf1;
        if (c < 3) {
#pragma unroll
            for (int i = 0; i < 8; ++i) { const int id = tid + 512 * i, row = id >> 4, sg = id & 15; rs[i] = *(const u32x4*)(kg + (size_t)row * D + (c + 1) * 128 + sg * 8); } }
        else {
#pragma unroll
            for (int i = 0; i < 8; ++i) { const int id = tid + 512 * i, row = id >> 5, sg = id & 31; rs[i] = *(const u32x4*)(vg + (size_t)row * 256 + sg * 8); } }
        bf16x8 qf[4];
#pragma unroll
        for (int ks = 0; ks < 4; ++ks) qf[ks] = *(const bf16x8*)(qp + c * 128 + ks * 32);
#pragma unroll
        for (int n = 0; n < 16; ++n) {
#pragma unroll
            for (int ks = 0; ks < 4; ++ks) { const bf16x8 kf = *(const bf16x8*)(cur + (n * 16 + fr) * XA_LDK + ks * 32 + fq * 8); st[n] = __builtin_amdgcn_mfma_f32_16x16x32_bf16(kf, qf[ks], st[n], 0, 0, 0); } }
        if (c < 3) {
#pragma unroll
            for (int i = 0; i < 8; ++i) { const int id = tid + 512 * i, row = id >> 4, sg = id & 15; *(u32x4*)(nxt + row * XA_LDK + sg * 8) = rs[i]; } }
        else {
#pragma unroll
            for (int i = 0; i < 8; ++i) { const int id = tid + 512 * i, row = id >> 5, sg = id & 31; *(u32x4*)(nxt + row * XA_LDV + sg * 8) = rs[i]; } }
        __syncthreads();
    }
    float mx = -3.0e38f;
#pragma unroll
    for (int n = 0; n < 16; ++n) mx = fmaxf(fmaxf(fmaxf(st[n][0], st[n][1]), fmaxf(st[n][2], st[n][3])), mx);
    mx = fmaxf(mx, __shfl_xor(mx, 16)); mx = fmaxf(mx, __shfl_xor(mx, 32));
    float sum = 0.f;
#pragma unroll
    for (int n = 0; n < 16; ++n) {
#pragma unroll
        for (int e = 0; e < 4; ++e) { const float p = __expf(st[n][e] - mx); st[n][e] = p; sum += p; } }
    sum += __shfl_xor(sum, 16); sum += __shfl_xor(sum, 32);
    const float inv = 1.0f / sum;
    bf16x8 pf[8];
#pragma unroll
    for (int i = 0; i < 8; ++i) { u32x4 w = pg8::pack8(st[2 * i], st[2 * i + 1]); pf[i] = __builtin_bit_cast(bf16x8, w); }
    bf16_t* op = (bf16_t*)(a.ws + WS_MIXIN) + (size_t)(r0 + fr) * D + h * 512 + 4 * fq;
#pragma unroll
    for (int c = 0; c < 4; ++c) {
        bf16_t* cur = (c & 1) ? buf1 : buf0; bf16_t* nxt = (c & 1) ? buf0 : buf1;
        if (c < 3) {
#pragma unroll
            for (int i = 0; i < 8; ++i) { const int id = tid + 512 * i, row = id >> 5, sg = id & 31; rs[i] = *(const u32x4*)(vg + (size_t)((c + 1) * 128 + row) * 256 + sg * 8); } }
#pragma unroll
        for (int dt = 0; dt < 8; ++dt) { f32x4 acc = (f32x4){0.f, 0.f, 0.f, 0.f};
#pragma unroll
            for (int i = 0; i < 8; ++i) { const bf16x8 vf = *(const bf16x8*)(cur + (dt * 16 + fr) * XA_LDV + i * 32 + fq * 8); acc = __builtin_amdgcn_mfma_f32_16x16x32_bf16(vf, pf[i], acc, 0, 0, 0); }
            u32x2 w; w.x = pg8::cvt_pk_bf16(acc[0] * inv, acc[1] * inv); w.y = pg8::cvt_pk_bf16(acc[2] * inv, acc[3] * inv);
            *(u32x2*)(op + c * 128 + dt * 16) = w; }
        if (c < 3) {
#pragma unroll
            for (int i = 0; i < 8; ++i) { const int id = tid + 512 * i, row = id >> 5, sg = id & 31; *(u32x4*)(nxt + row * XA_LDV + sg * 8) = rs[i]; } }
        __syncthreads();
    }
}
__device__ __forceinline__ void xattn_sample_item(const Args& a, int it, float* lds) {
    const int tid = tid_opq(), lane = tid & 63, wid = tid >> 6, fr = lane & 15, fq = lane >> 4, b = it >> 2, h = it & 3;
    float* sc = lds; float* pT = lds + 1024; float* red = lds + 2048;
    const float* Kc = a.in[I_CMK] + ((size_t)b * 1024 + h) * 512; const float* Vc = a.in[I_CMV] + ((size_t)b * 1024 + h) * 512;
    const bf16_t* qb = (const bf16_t*)(a.ws + WS_XN) + (size_t)(MP + b * 4 + (fr & 3)) * D + h * 512 + fq * 8;
    bf16x8 qf[16];
#pragma unroll
    for (int ks = 0; ks < 16; ++ks) { u32x4 w = *(const u32x4*)(qb + ks * 32); if (fr >= 4) w = (u32x4){0u, 0u, 0u, 0u}; qf[ks] = __builtin_bit_cast(bf16x8, w); }
#pragma unroll
    for (int n = 0; n < 2; ++n) { f32x4 acc = (f32x4){0.f, 0.f, 0.f, 0.f}; const float* kr = Kc + (size_t)(wid * 32 + n * 16 + fr) * 2048 + fq * 8;
#pragma unroll
        for (int ks = 0; ks < 16; ++ks) { const f32x4 k0 = __builtin_nontemporal_load((const f32x4*)(kr + ks * 32)), k1 = __builtin_nontemporal_load((const f32x4*)(kr + ks * 32 + 4));
            const u32x4 w = pg8::pack8(k0, k1); acc = __builtin_amdgcn_mfma_f32_16x16x32_bf16(__builtin_bit_cast(bf16x8, w), qf[ks], acc, 0, 0, 0); }
        if (fr < 4) {
#pragma unroll
            for (int e = 0; e < 4; ++e) sc[fr * 256 + wid * 32 + n * 16 + 4 * fq + e] = acc[e]; } }
    __syncthreads();
    if (wid < 4) { f32x4 s4 = *(const f32x4*)(sc + wid * 256 + lane * 4); const float mx = wave_max(fmaxf(fmaxf(s4[0], s4[1]), fmaxf(s4[2], s4[3])));
        s4[0] = __expf(s4[0] - mx); s4[1] = __expf(s4[1] - mx); s4[2] = __expf(s4[2] - mx); s4[3] = __expf(s4[3] - mx);
        const float inv = 1.0f / wave_sum((s4[0] + s4[1]) + (s4[2] + s4[3])); s4 = s4 * inv;
#pragma unroll
        for (int e = 0; e < 4; ++e) pT[(lane * 4 + e) * 4 + wid] = s4[e]; }
    __syncthreads();
    { const int dq = tid & 127, kq = tid >> 7; f32x4 acc[4];
#pragma unroll
        for (int t = 0; t < 4; ++t) acc[t] = (f32x4){0.f, 0.f, 0.f, 0.f};
#pragma unroll 16
        for (int kk = 0; kk < 64; ++kk) { const int key = kq * 64 + kk; const f32x4 v = __builtin_nontemporal_load((const f32x4*)(Vc + (size_t)key * 2048 + dq * 4)); const f32x4 p4 = *(const f32x4*)(pT + key * 4);
#pragma unroll
            for (int t = 0; t < 4; ++t) acc[t] += v * p4[t]; }
#pragma unroll
        for (int t = 0; t < 4; ++t) *(f32x4*)(red + (kq * 4 + t) * 512 + dq * 4) = acc[t]; }
    __syncthreads();
    { const int dq = tid & 127, t = tid >> 7; f32x4 o = *(const f32x4*)(red + t * 512 + dq * 4);
#pragma unroll
        for (int kq = 1; kq < 4; ++kq) o += *(const f32x4*)(red + (kq * 4 + t) * 512 + dq * 4);
        u32x2 w; w.x = pg8::cvt_pk_bf16(o[0], o[1]); w.y = pg8::cvt_pk_bf16(o[2], o[3]);
        *(u32x2*)((bf16_t*)(a.ws + WS_MIXIN) + (size_t)(MP + b * 4 + t) * D + h * 512 + dq * 4) = w; }
    __syncthreads();
}

__device__ __forceinline__ void phase_act(const Args& a) {
    const bf16_t* gu = (const bf16_t*)(a.ws + WS_GU); bf16_t* act = (bf16_t*)(a.ws + WS_PROJ);
    const float* cw = a.in[I_FCW]; const float* cb = a.in[I_FCB];
    const int total = (256 + MSAMP) * 704;
    for (int idx = blockIdx.x * 512 + tid_opq(); idx < total; idx += gridDim.x * 512) {
        const int ri = idx / 704, c = (idx - ri * 704) * 8, row = ri < 256 ? (ri >> 1) * 64 + (ri & 1) : MP + (ri - 256);
        const bool samp = row >= MP; const int t = samp ? ((row - MP) & 3) : (row & 2047), bi = samp ? ((row - MP) >> 2) : (row >> 11);
        const bf16_t* gr = gu + (size_t)row * (2 * DFF) + c;
        float g2[8], g1[8], g0[8], uu[8];
        unpack8(*(const u32x4*)gr, g2); unpack8(*(const u32x4*)(gr + DFF), uu);
        if (t >= 1) unpack8(*(const u32x4*)(gr - 2 * DFF), g1);
        else if (samp) { const float* cp = a.in[I_CFFN] + (size_t)(bi * 2 + 1) * DFF + c;
#pragma unroll
            for (int j = 0; j < 8; ++j) g1[j] = cp[j]; }
        else {
#pragma unroll
            for (int j = 0; j < 8; ++j) g1[j] = 0.f; }
        if (t >= 2) unpack8(*(const u32x4*)(gr - 4 * DFF), g0);
        else if (samp) { const float* cp = a.in[I_CFFN] + (size_t)(bi * 2 + t) * DFF + c;
#pragma unroll
            for (int j = 0; j < 8; ++j) g0[j] = cp[j]; }
        else {
#pragma unroll
            for (int j = 0; j < 8; ++j) g0[j] = 0.f; }
        float o[8];
#pragma unroll
        for (int j = 0; j < 8; ++j) { const float x = cw[c + j] * g0[j] + cw[DFF + c + j] * g1[j] + cw[2 * DFF + c + j] * g2[j] + cb[c + j]; o[j] = silu_f(x) * uu[j]; }
        u32x4 w; w.x = pg8::cvt_pk_bf16(o[0], o[1]); w.y = pg8::cvt_pk_bf16(o[2], o[3]); w.z = pg8::cvt_pk_bf16(o[4], o[5]); w.w = pg8::cvt_pk_bf16(o[6], o[7]);
        *(u32x4*)(act + (size_t)row * DFF + c) = w;
    }
}

__device__ __forceinline__ void phase_final(const Args& a) {
    const int lane = tid_opq() & 63, gw = blockIdx.x * 8 + (tid_opq() >> 6), nw = gridDim.x * 8;
    const float* ssq = (const float*)(a.ws + WS_SSQ3); const float* g = a.in[I_NFIN];
    int row = gw; if (row >= MROWS) return;
    f32x4 gg[8];
#pragma unroll
    for (int i = 0; i < 8; ++i) gg[i] = *(const f32x4*)(g + (i * 64 + lane) * 4);
    f32x4 v[8]; float sq = lane < 32 ? ssq[(size_t)row * 32 + lane] : 0.f;
#pragma unroll
    for (int i = 0; i < 8; ++i) v[i] = *(const f32x4*)(a.out + O_Y + (size_t)row * D + (i * 64 + lane) * 4);
    for (;;) {
        const int nrow = row + nw; const bool more = nrow < MROWS;
        f32x4 nv[8]; float nsq = 0.f;
        if (more) { nsq = lane < 32 ? ssq[(size_t)nrow * 32 + lane] : 0.f;
#pragma unroll
            for (int i = 0; i < 8; ++i) nv[i] = *(const f32x4*)(a.out + O_Y + (size_t)nrow * D + (i * 64 + lane) * 4); }
        const float rs = rsqrtf(wave_sum(sq) * (1.0f / 2048.0f) + 1e-6f);
        float* y = a.out + O_Y + (size_t)row * D;
#pragma unroll
        for (int i = 0; i < 8; ++i) __builtin_nontemporal_store(v[i] * rs * gg[i], (f32x4*)(y + (i * 64 + lane) * 4));
        if (!more) break;
#pragma unroll
        for (int i = 0; i < 8; ++i) v[i] = nv[i];
        sq = nsq; row = nrow;
    }
}

struct SmallEpi { const float* res; const bf16_t* resb; const float* rgain; float* hout; bf16_t* hg; const float* gain; float* ssq; bf16_t* O; const float* ssq_in; float scale; };
template <int MODE, bool HG, bool RESBF = false, bool OUTF = true> __device__ __forceinline__ void small_gemm(const bf16_t* __restrict__ A, const bf16_t* __restrict__ Bt, int K, int row_base, const SmallEpi& E, unsigned char* ldsb) {
    const int tid = tid_opq(), lane = tid & 63, wid = tid >> 6, fr = lane & 15, fq = lane >> 4;
    constexpr int LDP = 68;
    float* part = (float*)ldsb;
    const int kslice = K >> 3, npair = kslice >> 6;
    for (int tile = blockIdx.x; tile < 256; tile += gridDim.x) {
        const int tm = tile >> 5, tn = tile & 31;
        const bf16_t* ap = A + (size_t)(tm * 64 + fr) * K + wid * kslice + fq * 16; const bf16_t* bp = Bt + (size_t)(tn * 64 + fr) * K + wid * kslice + fq * 16;
        f32x4 acc[4][4];
#pragma unroll
        for (int mi = 0; mi < 4; ++mi)
#pragma unroll
            for (int ni = 0; ni < 4; ++ni) acc[mi][ni] = (f32x4){0.f, 0.f, 0.f, 0.f};
        bf16x8 af[4][2], bf[4][2];
#pragma unroll
        for (int i = 0; i < 4; ++i) { af[i][0] = *(const bf16x8*)(ap + (size_t)(i * 16) * K); af[i][1] = *(const bf16x8*)(ap + (size_t)(i * 16) * K + 8);
            bf[i][0] = *(const bf16x8*)(bp + (size_t)(i * 16) * K); bf[i][1] = *(const bf16x8*)(bp + (size_t)(i * 16) * K + 8); }
        for (int p = 0; p < npair; ++p) {
            bf16x8 an[4][2], bn[4][2];
            const int pn = (p + 1 < npair) ? p + 1 : p;
#pragma unroll
            for (int i = 0; i < 4; ++i) { an[i][0] = *(const bf16x8*)(ap + (size_t)(i * 16) * K + pn * 64); an[i][1] = *(const bf16x8*)(ap + (size_t)(i * 16) * K + pn * 64 + 8);
                bn[i][0] = *(const bf16x8*)(bp + (size_t)(i * 16) * K + pn * 64); bn[i][1] = *(const bf16x8*)(bp + (size_t)(i * 16) * K + pn * 64 + 8); }
#pragma unroll
            for (int hh = 0; hh < 2; ++hh)
#pragma unroll
                for (int mi = 0; mi < 4; ++mi)
#pragma unroll
                    for (int ni = 0; ni < 4; ++ni) acc[mi][ni] = __builtin_amdgcn_mfma_f32_16x16x32_bf16(bf[ni][hh], af[mi][hh], acc[mi][ni], 0, 0, 0);
#pragma unroll
            for (int i = 0; i < 4; ++i) { af[i][0] = an[i][0]; af[i][1] = an[i][1]; bf[i][0] = bn[i][0]; bf[i][1] = bn[i][1]; }
        }
#pragma unroll
        for (int mi = 0; mi < 4; ++mi)
#pragma unroll
            for (int ni = 0; ni < 4; ++ni) *(f32x4*)(part + (size_t)wid * 64 * LDP + (mi * 16 + fr) * LDP + ni * 16 + 4 * fq) = acc[mi][ni];
        __syncthreads();
        const int rloc = tid >> 3, cc = (tid & 7) * 8, rl = tm * 64 + rloc, r = row_base + rl, c0 = tn * 64 + cc;
        f32x4 v0 = *(const f32x4*)(part + rloc * LDP + cc), v1 = *(const f32x4*)(part + rloc * LDP + cc + 4);
#pragma unroll
        for (int w = 1; w < 8; ++w) { v0 += *(const f32x4*)(part + (size_t)w * 64 * LDP + rloc * LDP + cc); v1 += *(const f32x4*)(part + (size_t)w * 64 * LDP + rloc * LDP + cc + 4); }
        if (MODE == 0) {
            f32x4 h0, h1;
            if (RESBF) { const u32x4 w = *(const u32x4*)(E.resb + (size_t)r * 2048 + c0); f32x4 q0 = *(const f32x4*)(E.rgain + c0), q1 = *(const f32x4*)(E.rgain + c0 + 4);
#pragma unroll
                for (int j = 0; j < 4; ++j) { q0[j] = __builtin_amdgcn_rcpf(q0[j]); q1[j] = __builtin_amdgcn_rcpf(q1[j]); }
                h0 = (f32x4){__uint_as_float(w.x << 16), __uint_as_float(w.x & 0xffff0000u), __uint_as_float(w.y << 16), __uint_as_float(w.y & 0xffff0000u)} * q0 + v0;
                h1 = (f32x4){__uint_as_float(w.z << 16), __uint_as_float(w.z & 0xffff0000u), __uint_as_float(w.w << 16), __uint_as_float(w.w & 0xffff0000u)} * q1 + v1; }
            else { const float* rp = E.res + (size_t)rl * 2048 + c0; h0 = *(const f32x4*)rp + v0; h1 = *(const f32x4*)(rp + 4) + v1; }
            if (OUTF) { float* hp = E.hout + (size_t)r * 2048 + c0; *(f32x4*)hp = h0; *(f32x4*)(hp + 4) = h1; }
            float ss = (h0[0] * h0[0] + h0[1] * h0[1]) + (h0[2] * h0[2] + h0[3] * h0[3]) + (h1[0] * h1[0] + h1[1] * h1[1]) + (h1[2] * h1[2] + h1[3] * h1[3]);
            if (HG) { const f32x4 g0 = *(const f32x4*)(E.gain + c0), g1 = *(const f32x4*)(E.gain + c0 + 4); *(u32x4*)(E.hg + (size_t)r * 2048 + c0) = pg8::pack8(h0 * g0, h1 * g1); }
            ss += dpp_f<0xB1>(ss); ss += dpp_f<0x4E>(ss); ss += dpp_f<0x141>(ss);
            if ((tid & 7) == 0) E.ssq[(size_t)r * 32 + tn] = ss;
        } else {
            const f32x4 pq = *(const f32x4*)(E.ssq_in + (size_t)r * 32 + (tid & 7) * 4); float sm = (pq[0] + pq[1]) + (pq[2] + pq[3]);
            sm += dpp_f<0xB1>(sm); sm += dpp_f<0x4E>(sm); sm += dpp_f<0x141>(sm);
            const float rs = rsqrtf(sm * (1.0f / 2048.0f) + 1e-6f) * E.scale;
            *(u32x4*)(E.O + (size_t)r * 2048 + c0) = pg8::pack8(v0 * rs, v1 * rs);
        }
        __syncthreads();
    }
}


template <class Epi> __device__ __forceinline__ void run_gemm(PG8_LAS unsigned char* lds, const bf16_t* A, const bf16_t* Bt, int M, int N, int K, int cshift, const Epi& E) {
    pg8::Gemm g; g.A = A; g.Bt = Bt; g.M = M; g.N = N; g.K = K;
    pg8::StaticOrder S; S.init(M, N, (int)gridDim.x, (int)((blockIdx.x + gridDim.x - (cshift % gridDim.x)) % gridDim.x));
    pg8::gemm_phase<Epi, pg8::StaticOrder, false>(lds, g, S, E, nullptr);
}

#ifndef REP_SYNC
#define REP_SYNC 0
#endif
#ifndef REP_P0
#define REP_P0 0
#endif
#ifndef REP_P4
#define REP_P4 0
#endif
#ifndef REP_P9
#define REP_P9 0
#endif
#ifndef REP_P1
#define REP_P1 0
#endif
#ifndef REP_P3
#define REP_P3 0
#endif
#ifndef REP_SM
#define REP_SM 0
#endif
#ifndef REP_GA
#define REP_GA 0
#endif
#ifndef REP_GS
#define REP_GS 0
#endif
#ifndef REP_GB
#define REP_GB 0
#endif
#ifndef REP_GC
#define REP_GC 0
#endif
#ifndef REP_P1B
#define REP_P1B 0
#endif
#ifndef REP_P5
#define REP_P5 0
#endif
#ifndef REP_P7
#define REP_P7 0
#endif
#define GSYNC() do { xcd_barrier(xbar); if (REP_SYNC) xcd_barrier(xbar); } while (0)
__global__ void __launch_bounds__(512, 2) mk_fwd(Args a) {
    extern __shared__ __attribute__((aligned(16))) unsigned char shm[];
    cg::grid_group grid = cg::this_grid();
    PG8_LAS unsigned char* lds = (PG8_LAS unsigned char*)shm;
    float* ldsf = (float*)shm;
    unsigned char* ws = a.ws;
    volatile LAS unsigned* xst = (volatile LAS unsigned*)(lds + LDS_BYTES - 16);
    if (threadIdx.x < 4) xst[threadIdx.x] = 0u;
    __syncthreads();
    XcdBarrier xbar = xcd_barrier_post((unsigned*)(ws + WS_BAR), xst);
    for (int rep = 0; rep <= REP_P0; ++rep) { phase_prep(a, ldsf); if (REP_P0) __syncthreads(); }
    if (a.ws == nullptr) grid.sync();
    GSYNC();
    for (int rep1 = 0; rep1 <= REP_P1; ++rep1)
    { pg8::EpiProj E; E.O = (bf16_t*)(ws + WS_PROJ); E.ldc = NINP;
      run_gemm(lds, (const bf16_t*)(ws + WS_XN), (const bf16_t*)(ws + WS_WT_IN), MROWS, NINP, D, 0, E); }
    { pg8::EpiKV E; E.outk = a.out + O_MK; E.outv = a.out + O_MV; E.mkb = (bf16_t*)(ws + WS_MKB); E.mvt = (bf16_t*)(ws + WS_MVT);
      run_gemm(lds, (const bf16_t*)(ws + WS_MEMN), (const bf16_t*)(ws + WS_WT_XKV), 1024, 4096, D, (MROWS / 256) * (NINP / 256), E); }
    __syncthreads();
    phase_transposes(a, ldsf, TT_EARLY, TT_TOTAL, (unsigned*)(ws + WS_BAR) + XCD_BAR_WORDS + 1, (volatile int*)(ldsf + 64 * 257 + 8));
    GSYNC();
    for (int rep = 0; rep <= REP_P1B; ++rep) phase_rows_pre(a);
    GSYNC();
    for (int rep = 0; rep <= REP_GA; ++rep)
    for (int it = blockIdx.x; it < 512; it += gridDim.x) gla_pass_a(a, it, shm);
    for (int rep = 0; rep <= REP_GS; ++rep)
    for (int it = blockIdx.x; it < 512; it += gridDim.x) gla_sample_item(a, it, ldsf);
    GSYNC();
    for (int rep = 0; rep <= REP_GB; ++rep) { gla_pass_b(a); if (REP_GB) __syncthreads(); }
    GSYNC();
    for (int rep = 0; rep <= REP_GC; ++rep)
    for (int it = blockIdx.x; it < 512; it += gridDim.x) gla_pass_c(a, it, shm);
    GSYNC();
    for (int rep3 = 0; rep3 <= REP_P3; ++rep3)
    { pg8::EpiRes<false, true, false> E{}; E.res0 = a.in[I_XP]; E.res1 = a.in[I_XS]; E.split = MP; E.hg = (bf16_t*)(ws + WS_HG); E.gain = a.in[I_NX]; E.ssq = (float*)(ws + WS_SSQ1);
      run_gemm(lds, (const bf16_t*)(ws + WS_MIXIN), (const bf16_t*)(ws + WS_WT_OUT), MP, D, D, 0, E);
      SmallEpi SE{}; SE.res = a.in[I_XS]; SE.hg = E.hg; SE.gain = E.gain; SE.ssq = E.ssq;
      small_gemm<0, true, false, false>((const bf16_t*)(ws + WS_MIXIN) + (size_t)MP * D, (const bf16_t*)(ws + WS_WT_OUT), D, MP, SE, shm); }
    GSYNC();
    for (int rep4 = 0; rep4 <= REP_P4; ++rep4)
    { pg8::EpiScale<false> E; E.O = (bf16_t*)(ws + WS_XN); E.ldc = D; E.ssq = (const float*)(ws + WS_SSQ1); E.scale = 0.044194173824159216f; E.ffn_p = nullptr; E.ffn_s = nullptr;
      run_gemm(lds, (const bf16_t*)(ws + WS_HG), (const bf16_t*)(ws + WS_WT_XQ), MP, D, D, 0, E);
      SmallEpi SE{}; SE.O = E.O; SE.ssq_in = E.ssq; SE.scale = E.scale;
      for (int rep = 0; rep <= REP_SM; ++rep) small_gemm<1, false>((const bf16_t*)(ws + WS_HG) + (size_t)MP * D, (const bf16_t*)(ws + WS_WT_XQ), D, MP, SE, shm); }
    GSYNC();
    for (int rep = 0; rep <= REP_P5; ++rep) {
    for (int it = blockIdx.x; it < 256; it += gridDim.x) { const int x = it & 7, j = it >> 3; xattn_prompt_item(a, (gridDim.x == 256) ? ((x * 2 + (j >> 4)) * 16 + (j & 15)) : it, shm); }
    for (int it = blockIdx.x; it < 512; it += gridDim.x) xattn_sample_item(a, it, ldsf); }
    GSYNC();
    { pg8::EpiRes<true, true, false> E{}; E.resb = (const bf16_t*)(ws + WS_HG); E.rgain = a.in[I_NX]; E.hg = (bf16_t*)(ws + WS_HG); E.gain = a.in[I_NF]; E.ssq = (float*)(ws + WS_SSQ2);
      run_gemm(lds, (const bf16_t*)(ws + WS_MIXIN), (const bf16_t*)(ws + WS_WT_XO), MP, D, D, 0, E);
      SmallEpi SE{}; SE.resb = E.resb; SE.rgain = E.rgain; SE.hg = E.hg; SE.gain = E.gain; SE.ssq = E.ssq;
      small_gemm<0, true, true, false>((const bf16_t*)(ws + WS_MIXIN) + (size_t)MP * D, (const bf16_t*)(ws + WS_WT_XO), D, MP, SE, shm); }
    GSYNC();
    for (int rep = 0; rep <= REP_P7; ++rep)
    { pg8::EpiFfn E; E.act = (bf16_t*)(ws + WS_PROJ); E.GU = (bf16_t*)(ws + WS_GU); E.ssq = (const float*)(ws + WS_SSQ2); E.cw = a.in[I_FCW]; E.cb = a.in[I_FCB]; E.ffn_p = a.out + O_FFN_P; E.ffn_s = a.out + O_FFN_S;
      run_gemm(lds, (const bf16_t*)(ws + WS_HG), (const bf16_t*)(ws + WS_WT_FGU), MROWS, 2 * DFF, D, 0, E); }
    GSYNC();
    phase_act(a);
    GSYNC();
    for (int rep9 = 0; rep9 <= REP_P9; ++rep9)
    { pg8::EpiRes<true, false, true> E{}; E.resb = (const bf16_t*)(ws + WS_HG); E.rgain = a.in[I_NF]; E.hout = a.out + O_Y; E.ssq = (float*)(ws + WS_SSQ3);
      run_gemm(lds, (const bf16_t*)(ws + WS_PROJ), (const bf16_t*)(ws + WS_WT_FD), MP, D, DFF, 0, E);
      SmallEpi SE{}; SE.resb = E.resb; SE.rgain = E.rgain; SE.hout = E.hout; SE.ssq = E.ssq;
      small_gemm<0, false, true, true>((const bf16_t*)(ws + WS_PROJ) + (size_t)MP * DFF, (const bf16_t*)(ws + WS_WT_FD), DFF, MP, SE, shm); }
    GSYNC();
    phase_final(a);
}

extern "C" void kernel_launch(void* const* d_in, const int* in_sizes, int n_in, void* d_out, int out_size, void* d_ws, size_t ws_size, hipStream_t stream) {
    static int grid = 0;
    if (grid == 0) {
        if (n_in != 28 || ws_size < WS_END) { fprintf(stderr, "kernel_launch: unexpected n_in %d or ws_size %zu (< %zu)\n", n_in, ws_size, (size_t)WS_END); grid = -1; return; }
        int dev = 0, cus = 0, per_cu = 0;
        (void)hipGetDevice(&dev); (void)hipDeviceGetAttribute(&cus, hipDeviceAttributeMultiprocessorCount, dev);
        (void)hipFuncSetAttribute((const void*)mk_fwd, hipFuncAttributeMaxDynamicSharedMemorySize, LDS_BYTES);
        (void)hipOccupancyMaxActiveBlocksPerMultiprocessor(&per_cu, (const void*)mk_fwd, 512, LDS_BYTES);
        if (per_cu < 1) { fprintf(stderr, "kernel_launch: occupancy query says %d blocks/CU\n", per_cu); grid = -1; return; }
        grid = cus;
    }
    if (grid < 0) return;
    Args a{};
    for (int i = 0; i < 28; ++i) a.in[i] = (const float*)d_in[i];
    a.out = (float*)d_out; a.ws = (unsigned char*)d_ws;
    if (hipMemsetAsync((unsigned char*)d_ws + WS_BAR, 0, (size_t)(XCD_BAR_WORDS + 64) * 4, stream) != hipSuccess) { fprintf(stderr, "kernel_launch: memset of barrier words failed\n"); return; }
    void* args[] = {&a};
    hipError_t e = hipLaunchCooperativeKernel((const void*)mk_fwd, dim3(grid), dim3(512), args, LDS_BYTES, stream);
    if (e != hipSuccess) fprintf(stderr, "cooperative launch failed: %s (grid %d)\n", hipGetErrorString(e), grid);
}
```

```cpp
#include <hip/hip_runtime.h>
#include <hip/hip_cooperative_groups.h>
#include <cstdio>
namespace cg = cooperative_groups;

__device__ __forceinline__ int tid_opq() { int t = threadIdx.x; asm volatile("" : "+v"(t)); return t; }
namespace pg8 {
#define PG8_LAS __attribute__((address_space(3)))
typedef unsigned short bf16_t;
typedef short bf16x8 __attribute__((ext_vector_type(8)));
typedef float f32x4 __attribute__((ext_vector_type(4)));
typedef unsigned u32x4 __attribute__((ext_vector_type(4)));
constexpr int BM = 256, BK = 64, HALF = 128, HTB = HALF * BK * 2  , STAGE_BYTES = 8 * HTB, NXCD = 8, WGM = 8;

__host__ __device__ __forceinline__ int lds_byte(int r, int c) { const int st = (r >> 4) * 2 + (c >> 5), rr = r & 15, cc = c & 31, ob = rr * 64 + cc * 2; return st * 1024 + (ob ^ (((ob >> 9) & 1) << 5)); }
__host__ __device__ __forceinline__ void stage_rc(int b, int& R, int& C) { const int st = b / 1024, sb = b % 1024, swz = sb ^ (((sb >> 9) & 1) << 5); R = (st >> 1) * 16 + swz / 64; C = (st & 1) * 32 + (swz % 64) / 2; }
__host__ __device__ __forceinline__ int perm32(int rho) { const int n = rho >> 4, i = rho & 15; return 8 * (i >> 2) + 4 * n + (i & 3); }

struct Unit { int pm, pn; };
struct Gemm { const bf16_t* A; const bf16_t* Bt; int M, N, K; };

struct StaticOrder {
    int nM, nN, nwg, G, c;
    __host__ __device__ void init(int M, int N, int G_, int c_) { nM = M / BM; nN = N / BM; nwg = nM * nN; G = G_; c = c_; }
    __host__ __device__ bool next(int i, Unit& u) const {
        const long L = (long)i * G + c; if (L >= nwg) return false;
        int wgid = (int)L; { const int q = nwg / NXCD, r = nwg % NXCD, xcd = wgid % NXCD, off = wgid / NXCD; wgid = (xcd < r ? xcd * (q + 1) : r * (q + 1) + (xcd - r) * q) + off; }
        const int nig = WGM * nN, gid = wgid / nig, fm = gid * WGM, gsz = (nM - fm) < WGM ? (nM - fm) : WGM;
        u.pm = fm + ((wgid % nig) % gsz); u.pn = (wgid % nig) / gsz; return true;
    }
    __device__ __forceinline__ void a_ready(const Unit&) const {}
    __device__ __forceinline__ void done(const Unit&) const {}
};
typedef unsigned u32x2 __attribute__((ext_vector_type(2)));
__device__ __forceinline__ unsigned cvt_pk_bf16(float lo, float hi) { unsigned r; asm volatile("v_cvt_pk_bf16_f32 %0, %1, %2" : "=v"(r) : "v"(lo), "v"(hi)); return r; }
__device__ __forceinline__ u32x4 pack8(const f32x4 v0, const f32x4 v1) { u32x4 w; w.x = cvt_pk_bf16(v0[0], v0[1]); w.y = cvt_pk_bf16(v0[2], v0[3]); w.z = cvt_pk_bf16(v1[0], v1[1]); w.w = cvt_pk_bf16(v1[2], v1[3]); return w; }

struct EpiProj {
    static constexpr bool PERM = true, AFTER_DRAIN = false;
    bf16_t* O; int ldc;
    __device__ __forceinline__ void operator()(const f32x4 (&acc)[2][2][4][2], const Unit& u, int wr, int wc, int fr, int fq) const {
        const int row0 = u.pm * BM + wr * 64 + fr, col0 = u.pn * BM + wc * 32 + 8 * fq;
#pragma unroll
        for (int ai = 0; ai < 2; ++ai)
#pragma unroll
            for (int m = 0; m < 4; ++m) { bf16_t* rowp = O + (size_t)(row0 + ai * HALF + m * 16) * ldc + col0;
#pragma unroll
                for (int bj = 0; bj < 2; ++bj) *(u32x4*)(rowp + bj * HALF) = pack8(acc[ai][bj][m][0], acc[ai][bj][m][1]); }
    }
};

struct EpiKV {
    static constexpr bool PERM = false, AFTER_DRAIN = false;
    float* outk; float* outv; bf16_t* mkb; bf16_t* mvt;
    __device__ __forceinline__ void operator()(const f32x4 (&acc)[2][2][4][2], const Unit& u, int wr, int wc, int fr, int fq) const {
        const int row0 = u.pm * BM + wr * 64 + fr, col0 = (u.pn & 7) * BM + wc * 32 + 4 * fq;
        const bool isv = u.pn >= 8;
#pragma unroll
        for (int ai = 0; ai < 2; ++ai)
#pragma unroll
            for (int m = 0; m < 4; ++m) { const int r = row0 + ai * HALF + m * 16;
                const int bb = r >> 8, key = r & 255, pos = (key & ~31) + 8 * ((key >> 2) & 3) + 4 * ((key >> 4) & 1) + (key & 3);
#pragma unroll
                for (int bj = 0; bj < 2; ++bj)
#pragma unroll
                    for (int n = 0; n < 2; ++n) { const int c = col0 + bj * HALF + n * 16; const f32x4 v = acc[ai][bj][m][n];
                        if (!isv) { __builtin_nontemporal_store(v, (f32x4*)(outk + (size_t)r * 2048 + c)); u32x2 w; w.x = cvt_pk_bf16(v[0], v[1]); w.y = cvt_pk_bf16(v[2], v[3]); *(u32x2*)(mkb + (size_t)r * 2048 + c) = w; }
                        else { __builtin_nontemporal_store(v, (f32x4*)(outv + (size_t)r * 2048 + c)); const unsigned w0 = cvt_pk_bf16(v[0], v[1]), w1 = cvt_pk_bf16(v[2], v[3]);
                            bf16_t* tp = mvt + ((size_t)(bb * 2048 + c)) * 256 + pos;
                            tp[0] = (bf16_t)(w0 & 0xffffu); tp[256] = (bf16_t)(w0 >> 16); tp[512] = (bf16_t)(w1 & 0xffffu); tp[768] = (bf16_t)(w1 >> 16); } } }
    }
};

template <bool RESBF, bool HG, bool OUTF> struct EpiRes {
    static constexpr bool PERM = true, AFTER_DRAIN = false;
    const float* res0; const float* res1; int split; const bf16_t* resb; const float* rgain; float* hout; bf16_t* hg; const float* gain; float* ssq;
    __device__ __forceinline__ void operator()(const f32x4 (&acc)[2][2][4][2], const Unit& u, int wr, int wc, int fr, int fq) const {
        const int row0 = u.pm * BM + wr * 64 + fr, col0 = u.pn * BM + wc * 32 + 8 * fq;
        float ss[2][4];
#pragma unroll
        for (int ai = 0; ai < 2; ++ai)
#pragma unroll
            for (int m = 0; m < 4; ++m) ss[ai][m] = 0.f;
#pragma unroll
        for (int bj = 0; bj < 2; ++bj) { const int c = col0 + bj * HALF;
            f32x4 g0, g1, q0, q1;
            if (HG) { g0 = *(const f32x4*)(gain + c); g1 = *(const f32x4*)(gain + c + 4); }
            if (RESBF) { q0 = *(const f32x4*)(rgain + c); q1 = *(const f32x4*)(rgain + c + 4);
#pragma unroll
                for (int j = 0; j < 4; ++j) { q0[j] = __builtin_amdgcn_rcpf(q0[j]); q1[j] = __builtin_amdgcn_rcpf(q1[j]); } }
#pragma unroll
            for (int ai = 0; ai < 2; ++ai) {
                u32x4 rw[4]; f32x4 ra[4], rb[4];
#pragma unroll
                for (int m = 0; m < 4; ++m) { const int r = row0 + ai * HALF + m * 16;
                    if (RESBF) rw[m] = *(const u32x4*)(resb + (size_t)r * 2048 + c);
                    else { const float* rp = (r < split ? res0 + (size_t)r * 2048 : res1 + (size_t)(r - split) * 2048) + c; ra[m] = __builtin_nontemporal_load((const f32x4*)rp); rb[m] = __builtin_nontemporal_load((const f32x4*)(rp + 4)); } }
#pragma unroll
                for (int m = 0; m < 4; ++m) { const int r = row0 + ai * HALF + m * 16;
                    f32x4 h0, h1;
                    if (RESBF) { const u32x4 w = rw[m];
                        h0 = (f32x4){__uint_as_float(w.x << 16), __uint_as_float(w.x & 0xffff0000u), __uint_as_float(w.y << 16), __uint_as_float(w.y & 0xffff0000u)} * q0 + acc[ai][bj][m][0];
                        h1 = (f32x4){__uint_as_float(w.z << 16), __uint_as_float(w.z & 0xffff0000u), __uint_as_float(w.w << 16), __uint_as_float(w.w & 0xffff0000u)} * q1 + acc[ai][bj][m][1]; }
                    else { h0 = ra[m] + acc[ai][bj][m][0]; h1 = rb[m] + acc[ai][bj][m][1]; }
                    ss[ai][m] += (h0[0] * h0[0] + h0[1] * h0[1]) + (h0[2] * h0[2] + h0[3] * h0[3]) + (h1[0] * h1[0] + h1[1] * h1[1]) + (h1[2] * h1[2] + h1[3] * h1[3]);
                    if (OUTF) { float* hp = hout + (size_t)r * 2048 + c; *(f32x4*)hp = h0; *(f32x4*)(hp + 4) = h1; }
                    if (HG) *(u32x4*)(hg + (size_t)r * 2048 + c) = pack8(h0 * g0, h1 * g1); }
                __builtin_amdgcn_sched_barrier(0); } }
#pragma unroll
        for (int ai = 0; ai < 2; ++ai)
#pragma unroll
            for (int m = 0; m < 4; ++m) { float s = ss[ai][m]; s += __shfl_xor(s, 16); s += __shfl_xor(s, 32);
                if (fq == 0) ssq[(size_t)(row0 + ai * HALF + m * 16) * 32 + u.pn * 4 + wc] = s; }
    }
};

template <bool FFN> struct EpiScale {
    static constexpr bool PERM = true, AFTER_DRAIN = false;
    bf16_t* O; int ldc; const float* ssq; float scale; float* ffn_p; float* ffn_s;
    __device__ __forceinline__ void operator()(const f32x4 (&acc)[2][2][4][2], const Unit& u, int wr, int wc, int fr, int fq) const {
        const int row0 = u.pm * BM + wr * 64 + fr, col0 = u.pn * BM + wc * 32 + 8 * fq;
#pragma unroll
        for (int ai = 0; ai < 2; ++ai)
#pragma unroll
            for (int m = 0; m < 4; ++m) { const int r = row0 + ai * HALF + m * 16;
                const f32x4* sp = (const f32x4*)(ssq + (size_t)r * 32 + fq * 8); const f32x4 p0 = sp[0], p1 = sp[1];
                float s = ((p0[0] + p0[1]) + (p0[2] + p0[3])) + ((p1[0] + p1[1]) + (p1[2] + p1[3]));
                s += __shfl_xor(s, 16); s += __shfl_xor(s, 32);
                const float rs = rsqrtf(s * (1.0f / 2048.0f) + 1e-6f) * scale;
                bf16_t* rowp = O + (size_t)r * ldc + col0;
                float* dst = nullptr;
                if (FFN && u.pn < 22) {
                    if (r < 8192) { const int t = r & 2047; if (t >= 2046) dst = ffn_p + (size_t)((r >> 11) * 2 + (t - 2046)) * 5632; }
                    else { const int rr = r - 8192, t = rr & 3; if (t >= 2) dst = ffn_s + (size_t)((rr >> 2) * 2 + (t - 2)) * 5632; } }
#pragma unroll
                for (int bj = 0; bj < 2; ++bj) { const f32x4 v0 = acc[ai][bj][m][0] * rs, v1 = acc[ai][bj][m][1] * rs;
                    *(u32x4*)(rowp + bj * HALF) = pack8(v0, v1);
                    if (FFN) { if (dst) { *(f32x4*)(dst + col0 + bj * HALF) = v0; *(f32x4*)(dst + col0 + bj * HALF + 4) = v1; } } } }
    }
};

struct EpiFfn {
    static constexpr bool PERM = true, AFTER_DRAIN = false;
    bf16_t* act; bf16_t* GU; const float* ssq; const float* cw; const float* cb; float* ffn_p; float* ffn_s;
    template <int N> __device__ __forceinline__ static float ror(float x) { return __int_as_float(__builtin_amdgcn_update_dpp(0, __float_as_int(x), 0x120 + N, 0xf, 0xf, false)); }
    template <int N> __device__ __forceinline__ static f32x4 rot(const f32x4 v) { f32x4 r; r[0] = ror<N>(v[0]); r[1] = ror<N>(v[1]); r[2] = ror<N>(v[2]); r[3] = ror<N>(v[3]); return r; }
    __device__ __forceinline__ void operator()(const f32x4 (&acc)[2][2][4][2], const Unit& u, int wr, int wc, int fr, int fq) const {
        const int row0 = u.pm * BM + wr * 64 + fr, ch0 = u.pn * 128 + wc * 32 + 8 * fq;
        if (u.pm >= 32) {
#pragma unroll
            for (int ai = 0; ai < 2; ++ai)
#pragma unroll
                for (int m = 0; m < 4; ++m) { const int r = row0 + ai * HALF + m * 16;
                    const f32x4* sp = (const f32x4*)(ssq + (size_t)r * 32); float s = 0.f;
#pragma unroll
                    for (int i = 0; i < 8; ++i) { const f32x4 v = sp[i]; s += (v[0] + v[1]) + (v[2] + v[3]); }
                    const float rs = rsqrtf(s * (1.0f / 2048.0f) + 1e-6f);
                    const f32x4 g0 = acc[ai][0][m][0] * rs, g1 = acc[ai][0][m][1] * rs;
                    *(u32x4*)(GU + (size_t)r * 11264 + ch0) = pack8(g0, g1); *(u32x4*)(GU + (size_t)r * 11264 + 5632 + ch0) = pack8(acc[ai][1][m][0] * rs, acc[ai][1][m][1] * rs);
                    const int rr = r - 8192, t = rr & 3;
                    if (t >= 2) { float* dst = ffn_s + (size_t)((rr >> 2) * 2 + (t - 2)) * 5632 + ch0; *(f32x4*)dst = g0; *(f32x4*)(dst + 4) = g1; } }
            return; }
        float rsv[2][4];
#pragma unroll
        for (int ai = 0; ai < 2; ++ai)
#pragma unroll
            for (int m = 0; m < 4; ++m) { const f32x4* sp = (const f32x4*)(ssq + (size_t)(row0 + ai * HALF + m * 16) * 32 + fq * 8); const f32x4 v0 = sp[0], v1 = sp[1];
                float s = ((v0[0] + v0[1]) + (v0[2] + v0[3])) + ((v1[0] + v1[1]) + (v1[2] + v1[3]));
                s += __shfl_xor(s, 16); s += __shfl_xor(s, 32);
                rsv[ai][m] = rsqrtf(s * (1.0f / 2048.0f) + 1e-6f); }
#pragma unroll
        for (int n = 0; n < 2; ++n) { const int ch = ch0 + 4 * n;
            const f32x4 w0 = *(const f32x4*)(cw + ch), w1 = *(const f32x4*)(cw + 5632 + ch), w2 = *(const f32x4*)(cw + 11264 + ch), bz = *(const f32x4*)(cb + ch);
#pragma unroll
            for (int ai = 0; ai < 2; ++ai) {
                f32x4 q1, q2;
#pragma unroll
                for (int m = 0; m < 4; ++m) { const int r = row0 + ai * HALF + m * 16; const float rs = rsv[ai][m];
                    const f32x4 g = acc[ai][0][m][n] * rs, uu = acc[ai][1][m][n] * rs;
                    const f32x4 r1 = rot<1>(g), r2 = rot<2>(g);
                    f32x4 p1 = r1, p2 = r2;
                    if (m > 0) { if (fr < 1) p1 = q1; if (fr < 2) p2 = q2; }
                    q1 = r1; q2 = r2;
                    u32x2 w;
                    if (m == 0 && fr < 2) {
                        w.x = cvt_pk_bf16(g[0], g[1]); w.y = cvt_pk_bf16(g[2], g[3]); *(u32x2*)(GU + (size_t)r * 11264 + ch) = w;
                        w.x = cvt_pk_bf16(uu[0], uu[1]); w.y = cvt_pk_bf16(uu[2], uu[3]); *(u32x2*)(GU + (size_t)r * 11264 + 5632 + ch) = w; }
                    else {
                        const f32x4 x = w0 * p2 + w1 * p1 + w2 * g + bz; f32x4 o;
#pragma unroll
                        for (int j = 0; j < 4; ++j) o[j] = x[j] * __builtin_amdgcn_rcpf(1.0f + __expf(-x[j])) * uu[j];
                        w.x = cvt_pk_bf16(o[0], o[1]); w.y = cvt_pk_bf16(o[2], o[3]); *(u32x2*)(act + (size_t)r * 5632 + ch) = w; }
                    if (m == 3 && fr >= 14) {
                        w.x = cvt_pk_bf16(g[0], g[1]); w.y = cvt_pk_bf16(g[2], g[3]); *(u32x2*)(GU + (size_t)r * 11264 + ch) = w;
                        const int t = r & 2047; if (t >= 2046) *(f32x4*)(ffn_p + (size_t)((r >> 11) * 2 + (t - 2046)) * 5632 + ch) = g; }
                    __builtin_amdgcn_sched_barrier(0); } } }
    }
};

template <class Epi, class Sched, bool STAMP = false>
__device__ __forceinline__ void gemm_phase(PG8_LAS unsigned char* lds, const Gemm g, const Sched& S, const Epi& E, unsigned long long* stamps) {
    const int tid = ::tid_opq(), wid = __builtin_amdgcn_readfirstlane(tid >> 6), lane = tid & 63, wr = wid >> 2, wc = wid & 3, fr = lane & 15, fq = lane >> 4;
    const int K = g.K, nt = K / BK;
    int ts_lo = 0, ts_hi = 0, nts = 0; const unsigned long long rt_entry = STAMP ? (unsigned long long)wall_clock64() : 0ull;
#define PG8_STAMP() do { if (STAMP && wid == 0 && nts < 64) { const unsigned long long _c = (unsigned long long)clock64(); \
        ts_lo = (lane == nts) ? (int)(unsigned)_c : ts_lo; ts_hi = (lane == nts) ? (int)(unsigned)(_c >> 32) : ts_hi; ++nts; } } while (0)
    PG8_STAMP();
    unsigned voffA[2], voffB[2];
#pragma unroll
    for (int i = 0; i < 2; ++i) { int R, C; stage_rc(tid * 16 + i * 8192, R, C); const int Rb = Epi::PERM ? ((R & ~31) + perm32(R & 31)) : R;
        voffA[i] = (unsigned)(R * K + C) * 2u; voffB[i] = (unsigned)(Rb * K + C) * 2u; }
    const size_t kstep = (size_t)(BK * 2);
    const size_t hstep = (size_t)HALF * K * 2;
    const size_t tstep = 2 * hstep;
    const unsigned ldsw = (unsigned)wid * 1024u;
    const int aoff = lds_byte(wr * 64 + fr, fq * 8), boff = lds_byte(wc * 32 + fr, fq * 8);
#define PG8_SA(b, h) (((b) * 2 + (h)) * HTB)
#define PG8_SB(b, h) ((4 + (b) * 2 + (h)) * HTB)
#define PG8_STAGE(bufoff, gbase, voff) do { _Pragma("unroll") for (int _i = 0; _i < 2; ++_i) \
        __builtin_amdgcn_global_load_lds((const unsigned*)((const char*)(gbase) + (voff)[_i]), (PG8_LAS unsigned*)(lds + (bufoff) + ldsw + _i * 8192), 16, 0, 0); } while (0)
#define PG8_LDA(dst, b, h) do { _Pragma("unroll") for (int m = 0; m < 4; ++m) _Pragma("unroll") for (int k = 0; k < 2; ++k) dst[m][k] = *(const PG8_LAS bf16x8*)(lds + PG8_SA(b, h) + aoff + m * 2048 + k * 1024); } while (0)
#define PG8_LDB(dst, b, h) do { _Pragma("unroll") for (int n = 0; n < 2; ++n) _Pragma("unroll") for (int k = 0; k < 2; ++k) dst[n][k] = *(const PG8_LAS bf16x8*)(lds + PG8_SB(b, h) + boff + n * 2048 + k * 1024); } while (0)
#define PG8_MMA(ai, bj, At, Bt) do { __builtin_amdgcn_s_setprio(1); _Pragma("unroll") for (int m = 0; m < 4; ++m) _Pragma("unroll") for (int n = 0; n < 2; ++n) _Pragma("unroll") for (int k = 0; k < 2; ++k) \
        acc[ai][bj][m][n] = __builtin_amdgcn_mfma_f32_16x16x32_bf16(Bt[n][k], At[m][k], acc[ai][bj][m][n], 0, 0, 0); __builtin_amdgcn_s_setprio(0); } while (0)
#define PG8_WAIT_V(n) asm volatile("s_waitcnt vmcnt(" #n ")" ::: "memory")
#define PG8_WAIT_L(n) asm volatile("s_waitcnt lgkmcnt(" #n ")" ::: "memory")
#define PG8_BAR __builtin_amdgcn_s_barrier()
#define PG8_SCHED __builtin_amdgcn_sched_barrier(0)
    Unit cur, nxt; int ui = 0;
    if (!S.next(0, cur)) return;
    f32x4 acc[2][2][4][2];
#pragma unroll
    for (int a = 0; a < 2; ++a)
#pragma unroll
        for (int b = 0; b < 2; ++b)
#pragma unroll
            for (int m = 0; m < 4; ++m)
#pragma unroll
                for (int n = 0; n < 2; ++n) acc[a][b][m][n] = (f32x4){0.f, 0.f, 0.f, 0.f};
    bf16x8 At[4][2], B0[2][2], B1[2][2];
    const char* cA = (const char*)g.A + (size_t)cur.pm * tstep; const char* cB = (const char*)g.Bt + (size_t)cur.pn * tstep;
    S.a_ready(cur);
    PG8_STAGE(PG8_SB(0, 0), cB, voffB); PG8_STAGE(PG8_SA(0, 0), cA, voffA); PG8_STAGE(PG8_SB(0, 1), cB + hstep, voffB); PG8_STAGE(PG8_SA(0, 1), cA + hstep, voffA);
    if (wr == 1) PG8_BAR;
    PG8_WAIT_V(4); PG8_BAR;
    PG8_STAGE(PG8_SB(1, 0), cB + kstep, voffB); PG8_STAGE(PG8_SA(1, 0), cA + kstep, voffA); PG8_STAGE(PG8_SB(1, 1), cB + hstep + kstep, voffB);
    PG8_WAIT_V(6); PG8_BAR;
    PG8_STAMP();
    for (;;) {
        const bool has_next = S.next(ui + 1, nxt);
        const char* nA = has_next ? (const char*)g.A + (size_t)nxt.pm * tstep : cA; const char* nB = has_next ? (const char*)g.Bt + (size_t)nxt.pn * tstep : cB;
        for (int t = 0; t < nt; t += 2) {
            const bool last = (t == nt - 2);
            const char* a1 = cA + (size_t)(t + 1) * kstep;
            const char* a2 = last ? nA : cA + (size_t)(t + 2) * kstep; const char* b2 = last ? nB : cB + (size_t)(t + 2) * kstep;
            const char* a3 = a2 + kstep; const char* b3 = b2 + kstep;
            if (last && has_next) S.a_ready(nxt);
            PG8_LDB(B0, 0, 0); PG8_SCHED; PG8_LDA(At, 0, 0); PG8_STAGE(PG8_SA(1, 1), a1 + hstep, voffA);
            PG8_WAIT_L(8); PG8_BAR; PG8_WAIT_L(0); PG8_MMA(0, 0, At, B0); PG8_BAR; PG8_SCHED;
            PG8_LDB(B1, 0, 1); PG8_STAGE(PG8_SB(0, 0), b2, voffB);
            PG8_BAR; PG8_WAIT_L(0); PG8_MMA(0, 1, At, B1); PG8_BAR;
            PG8_LDA(At, 0, 1); PG8_STAGE(PG8_SA(0, 0), a2, voffA);
            PG8_BAR; PG8_WAIT_L(0); PG8_MMA(1, 0, At, B0); PG8_BAR; PG8_SCHED;
            PG8_STAGE(PG8_SB(0, 1), b2 + hstep, voffB);
            PG8_WAIT_V(6); PG8_BAR; PG8_MMA(1, 1, At, B1); PG8_BAR;
            PG8_LDB(B0, 1, 0); PG8_SCHED; PG8_LDA(At, 1, 0); PG8_STAGE(PG8_SA(0, 1), a2 + hstep, voffA);
            PG8_WAIT_L(8); PG8_BAR; PG8_WAIT_L(0); PG8_MMA(0, 0, At, B0); PG8_BAR; PG8_SCHED;
            PG8_LDB(B1, 1, 1); PG8_STAGE(PG8_SB(1, 0), b3, voffB);
            PG8_BAR; PG8_WAIT_L(0); PG8_MMA(0, 1, At, B1); PG8_BAR;
            PG8_LDA(At, 1, 1); PG8_STAGE(PG8_SA(1, 0), a3, voffA);
            PG8_BAR; PG8_WAIT_L(0); PG8_MMA(1, 0, At, B0); PG8_BAR; PG8_SCHED;
            PG8_STAGE(PG8_SB(1, 1), b3 + hstep, voffB);
            PG8_WAIT_V(6); PG8_BAR; PG8_MMA(1, 1, At, B1); PG8_BAR;
        }
        PG8_STAMP();
        if constexpr (!Epi::AFTER_DRAIN) { E(acc, cur, wr, wc, fr, fq); S.done(cur); }
        PG8_STAMP();
        if (!has_next) break;
#pragma unroll
        for (int a = 0; a < 2; ++a)
#pragma unroll
            for (int b = 0; b < 2; ++b)
#pragma unroll
                for (int m = 0; m < 4; ++m)
#pragma unroll
                    for (int n = 0; n < 2; ++n) acc[a][b][m][n] = (f32x4){0.f, 0.f, 0.f, 0.f};
        cur = nxt; cA = nA; cB = nB; ++ui;
    }
    PG8_WAIT_V(0);
    if (wr == 0) PG8_BAR;
    PG8_BAR;
    if constexpr (Epi::AFTER_DRAIN) { E.fused(acc, cur, wr, wc, fr, fq, lds, wid, lane); S.done(cur); }
    PG8_STAMP();
    if (STAMP && wid == 0) { stamps[lane] = lane < nts ? (((unsigned long long)(unsigned)ts_hi << 32) | (unsigned)ts_lo) : 0ull;
        if (lane == 62) stamps[62] = rt_entry; if (lane == 63) stamps[63] = (unsigned long long)wall_clock64(); }
#undef PG8_STAMP
#undef PG8_SA
#undef PG8_SB
#undef PG8_STAGE
#undef PG8_LDA
#undef PG8_LDB
#undef PG8_MMA
#undef PG8_WAIT_V
#undef PG8_WAIT_L
#undef PG8_BAR
#undef PG8_SCHED
}
}
#define XB_TMO      128
#define XB_XCNT(j)  (256  + 64 * (j))
#define XB_XSUB(j)  (1280 + 64 * (j))
#define XB_XGEN(j)  (2304 + 64 * (j))
#define XB_TOP      3328
#define XB_TOPGEN   3392
#define XCD_BAR_WORDS 3456
#define XB_SPIN_CAP (1u << 18)
#define LAS __attribute__((address_space(3)))

__device__ __forceinline__ unsigned xb_ld(unsigned* p)              { return __hip_atomic_load(p, __ATOMIC_RELAXED, __HIP_MEMORY_SCOPE_AGENT); }
__device__ __forceinline__ unsigned xb_add(unsigned* p, unsigned v) { return __hip_atomic_fetch_add(p, v, __ATOMIC_RELAXED, __HIP_MEMORY_SCOPE_AGENT); }
__device__ __forceinline__ unsigned xb_xcc_id() { return (unsigned)__builtin_amdgcn_s_getreg((3 << 11) | 20) & 0xFu; }
#define XB_SPIN(cond, bar) do { unsigned _sp = 0; while (cond) { __builtin_amdgcn_s_sleep(1); \
    if ((++_sp & 255u) == 0u) { if (xb_ld(&(bar)[XB_TMO])) break; if (_sp > XB_SPIN_CAP) { atomicAdd(&(bar)[XB_TMO], 1u); break; } } } } while (0)

struct XcdBarrier {
    unsigned* bar; unsigned x;
    volatile LAS unsigned* st;
};

__device__ __forceinline__ XcdBarrier xcd_barrier_post(unsigned* bar, volatile LAS unsigned* st) {
    XcdBarrier b; b.bar = bar; b.x = xb_xcc_id(); b.st = st;
    if (threadIdx.x == 0) (void)xb_add(&bar[XB_XCNT(b.x)], 1u);
    return b;
}
__device__ __forceinline__ void xcd_barrier_complete(unsigned* bar, unsigned x, unsigned& nloc, unsigned& nx) {
    const unsigned G = gridDim.x * gridDim.y * gridDim.z;
    unsigned sum, cnt, mine, sp = 0u;
    for (;;) {
        sum = 0u; cnt = 0u; mine = 0u;
#pragma unroll
        for (unsigned j = 0; j < 16; ++j) { const unsigned c = xb_ld(&bar[XB_XCNT(j)]); sum += c; cnt += (c > 0u) ? 1u : 0u; mine = (j == x) ? c : mine; }
        if (sum == G) break;
        __builtin_amdgcn_s_sleep(1);
        if ((++sp & 255u) == 0u) { if (xb_ld(&bar[XB_TMO])) break; if (sp > XB_SPIN_CAP) { atomicAdd(&bar[XB_TMO], 1u); break; } }
    }
    nloc = mine > 0u ? mine : 1u; nx = cnt > 0u ? cnt : 1u;
}

__device__ __forceinline__ void xcd_barrier(const XcdBarrier& b) {
    asm volatile("s_waitcnt vmcnt(0)" ::: "memory");
    __syncthreads();
    if (threadIdx.x == 0) {
        unsigned* bar = b.bar;
        __builtin_amdgcn_s_waitcnt(0);
        unsigned nloc = b.st[0], nx = b.st[1];
        if (nloc == 0u) { xcd_barrier_complete(bar, b.x, nloc, nx); b.st[0] = nloc; b.st[1] = nx; }
        const unsigned old = xb_add(&bar[XB_XSUB(b.x)], 1u);
        const unsigned gen = old / nloc;
        if (old + 1u == (gen + 1u) * nloc) {
            __builtin_amdgcn_fence(__ATOMIC_RELEASE, "agent");
            asm volatile("s_waitcnt vmcnt(0)" ::: "memory");
            const unsigned og = xb_add(&bar[XB_TOP], 1u);
            const unsigned tg = og / nx;
            if (og + 1u == (tg + 1u) * nx) xb_add(&bar[XB_TOPGEN], 1u);
            else XB_SPIN(xb_ld(&bar[XB_TOPGEN]) == tg, bar);
            __builtin_amdgcn_fence(__ATOMIC_ACQUIRE, "agent");
            xb_add(&bar[XB_XGEN(b.x)], 1u);
            asm volatile("s_waitcnt vmcnt(0)" ::: "memory");
        } else {
            XB_SPIN(xb_ld(&bar[XB_XGEN(b.x)]) == gen, bar);
            __builtin_amdgcn_fence(__ATOMIC_ACQUIRE, "agent");
            asm volatile("s_waitcnt vmcnt(0)" ::: "memory");
        }
    }
    __syncthreads();
}

using pg8::bf16_t; using pg8::f32x4; using pg8::u32x4; using pg8::u32x2; using pg8::bf16x8;
constexpr int D = 2048, MP = 8192, MSAMP = 512, MROWS = 8704, NINP = 6400, NIN = 6160, DFF = 5632;
constexpr int C_BG = 0, C_CG = 1024, C_VC = 2048, C_Q = 3072, C_K = 3584, C_V = 4096, C_R = 5120, C_G1 = 6144;
constexpr size_t al256(size_t x) { return (x + 255) & ~(size_t)255; }
constexpr size_t WS_WT_IN = 0;
constexpr size_t WS_WT_OUT = WS_WT_IN + al256((size_t)NINP * D * 2);
constexpr size_t WS_WT_XQ = WS_WT_OUT + al256((size_t)D * D * 2);
constexpr size_t WS_WT_XO = WS_WT_XQ + al256((size_t)D * D * 2);
constexpr size_t WS_WT_XKV = WS_WT_XO + al256((size_t)D * D * 2);
constexpr size_t WS_WT_FGU = WS_WT_XKV + al256((size_t)2 * D * D * 2);
constexpr size_t WS_WT_FD = WS_WT_FGU + al256((size_t)2 * DFF * D * 2);
constexpr size_t WS_XN = WS_WT_FD + al256((size_t)D * DFF * 2);
constexpr size_t WS_MEMN = WS_XN + al256((size_t)MROWS * D * 2);
constexpr size_t WS_PROJ = WS_MEMN + al256((size_t)1024 * D * 2);
constexpr size_t WS_MIXIN = WS_PROJ + al256((size_t)MROWS * NINP * 2);
constexpr size_t WS_H = WS_MIXIN + al256((size_t)MROWS * D * 2);
constexpr size_t WS_HG = WS_H + al256((size_t)MROWS * D * 4);
constexpr size_t WS_MKB = WS_HG + al256((size_t)MROWS * D * 2);
constexpr size_t WS_MVT = WS_MKB + al256((size_t)1024 * D * 2);
constexpr size_t WS_OG = WS_MVT + al256((size_t)1024 * D * 2);
constexpr size_t WS_GU = WS_OG + al256((size_t)MP * 1024 * 4);
constexpr size_t WS_SSQ1 = WS_GU + al256((size_t)MROWS * 2 * DFF * 2);
constexpr size_t WS_SSQ2 = WS_SSQ1 + al256((size_t)MROWS * 32 * 4);
constexpr size_t WS_SSQ3 = WS_SSQ2 + al256((size_t)MROWS * 32 * 4);
constexpr size_t WS_F = WS_SSQ3 + al256((size_t)MROWS * 32 * 4);
constexpr size_t WS_BAR = WS_F + al256((size_t)MROWS * 512 * 4);
constexpr size_t WS_END = WS_BAR + al256((size_t)(XCD_BAR_WORDS + 64) * 4);
constexpr size_t O_Y = 0, O_CONV_P = 17825792, O_GLA_P = 17833984, O_FFN_P = 18358272, O_MK = 18403328, O_MV = 20500480, O_CONV_S = 22597632, O_GLA_S = 22859776, O_FFN_S = 39636992;
constexpr int LDS_BYTES = 147456;
constexpr size_t GL_SST_OFF = 67108864, GL_EL_OFF = 67108864 + 33554432;

struct Args { const float* in[28]; float* out; unsigned char* ws; };
enum { I_XP = 0, I_XS, I_MEM, I_CCONV, I_SGLA, I_CFFN, I_CMK, I_CMV, I_NMIX, I_WIN, I_CONVW, I_WG2, I_BG, I_GLAN, I_WOUT, I_NX, I_NMEM, I_WXQ, I_WXK, I_WXV, I_WXO, I_NF, I_WFG, I_WFU, I_FCW, I_FCB, I_WFD, I_NFIN };

__device__ __forceinline__ float bflo(unsigned w) { return __uint_as_float(w << 16); }
__device__ __forceinline__ float bfhi(unsigned w) { return __uint_as_float(w & 0xffff0000u); }
__device__ __forceinline__ float bf2f(bf16_t b) { return __uint_as_float(((unsigned)b) << 16); }
__device__ __forceinline__ bf16_t f2bf(float f) { unsigned u = __float_as_uint(f); u += 0x7FFFu + ((u >> 16) & 1u); return (bf16_t)(u >> 16); }
__device__ __forceinline__ float silu_f(float x) { return x * __builtin_amdgcn_rcpf(1.0f + __expf(-x)); }
__device__ __forceinline__ float log_forget(float z) { const float ls = fminf(z, 0.f) - __logf(1.0f + __expf(-fabsf(z))); return ls * 0.0625f; }
template <int CTRL> __device__ __forceinline__ float dpp_f(float x) { return __int_as_float(__builtin_amdgcn_update_dpp(0, __float_as_int(x), CTRL, 0xf, 0xf, false)); }
__device__ __forceinline__ float rdl(float x, int l) { return __int_as_float(__builtin_amdgcn_readlane(__float_as_int(x), l)); }
__device__ __forceinline__ float wave_sum(float v) {
    v += dpp_f<0xB1>(v);
    v += dpp_f<0x4E>(v);
    v += dpp_f<0x141>(v);
    v += dpp_f<0x140>(v);
    return (rdl(v, 0) + rdl(v, 16)) + (rdl(v, 32) + rdl(v, 48)); }
__device__ __forceinline__ float wave_max(float v) {
    v = fmaxf(v, dpp_f<0xB1>(v)); v = fmaxf(v, dpp_f<0x4E>(v)); v = fmaxf(v, dpp_f<0x141>(v)); v = fmaxf(v, dpp_f<0x140>(v));
    return fmaxf(fmaxf(rdl(v, 0), rdl(v, 16)), fmaxf(rdl(v, 32), rdl(v, 48))); }
__device__ __forceinline__ void unpack8(const u32x4 w, float (&f)[8]) { f[0] = bflo(w.x); f[1] = bfhi(w.x); f[2] = bflo(w.y); f[3] = bfhi(w.y); f[4] = bflo(w.z); f[5] = bfhi(w.z); f[6] = bflo(w.w); f[7] = bfhi(w.w); }

constexpr int TT_WIN = 800, TT_SQ = 256, TT_FF = 704, TT_TOTAL = 800 + 5 * 256 + 3 * 704;
__device__ __forceinline__ void tr_decode(const Args& a, int gi, const float*& src, bf16_t*& dst, int& K, int& N, int& k0, int& n0, int& ilv) {
    unsigned char* ws = a.ws; int nkt; ilv = 0;
    if (gi < TT_WIN) { src = a.in[I_WIN]; dst = (bf16_t*)(ws + WS_WT_IN); K = D; N = NIN; nkt = 32; }
    else { gi -= TT_WIN;
        if (gi < 5 * TT_SQ) { const int j = gi >> 8; gi &= 255; K = D; N = D; nkt = 32;
            { const float* p0 = a.in[I_WXK]; const float* p1 = a.in[I_WXV]; const float* p2 = a.in[I_WOUT]; const float* p3 = a.in[I_WXQ]; const float* p4 = a.in[I_WXO];
              src = j == 0 ? p0 : j == 1 ? p1 : j == 2 ? p2 : j == 3 ? p3 : p4; }
            dst = (bf16_t*)(ws + (j <= 1 ? WS_WT_XKV : j == 2 ? WS_WT_OUT : j == 3 ? WS_WT_XQ : WS_WT_XO)) + (j == 1 ? (size_t)D * D : 0); }
        else { gi -= 5 * TT_SQ;
            if (gi < TT_FF) { src = a.in[I_WFG]; dst = (bf16_t*)(ws + WS_WT_FGU); K = D; N = DFF; nkt = 32; ilv = 1; }
            else if (gi < 2 * TT_FF) { gi -= TT_FF; src = a.in[I_WFU]; dst = (bf16_t*)(ws + WS_WT_FGU); K = D; N = DFF; nkt = 32; ilv = 2; }
            else { gi -= 2 * TT_FF; src = a.in[I_WFD]; dst = (bf16_t*)(ws + WS_WT_FD); K = DFF; N = D; nkt = 88; } } }
    k0 = (gi % nkt) * 64; n0 = (gi / nkt) * 256;
}
constexpr int TT_EARLY = TT_WIN + 2 * TT_SQ;
__device__ __forceinline__ void phase_transposes(const Args& a, float* tile, int lo, int hi, unsigned* ctr, volatile int* qslot) {
    const int tid = tid_opq(), r = tid >> 6, c4 = (tid & 63) * 4;
    int gi;
    if (ctr) { if (tid == 0) *qslot = lo + (int)atomicAdd(ctr, 1u); __syncthreads(); gi = *qslot; __syncthreads(); } else gi = lo + blockIdx.x;
    if (gi >= hi) return;
    const float* src; bf16_t* dst; int K, N, k0, n0, ilv; f32x4 v[8];
    tr_decode(a, gi, src, dst, K, N, k0, n0, ilv);
#pragma unroll
    for (int i = 0; i < 8; ++i) { v[i] = (f32x4){0.f, 0.f, 0.f, 0.f}; if (n0 + c4 < N) v[i] = __builtin_nontemporal_load((const f32x4*)(src + (size_t)(k0 + r + 8 * i) * N + n0 + c4)); }
    for (;;) {
#pragma unroll
        for (int i = 0; i < 8; ++i) *(f32x4*)(tile + (r + 8 * i) * 260 + c4) = v[i];
        if (ctr && tid == 0) *qslot = lo + (int)atomicAdd(ctr, 1u);
        __syncthreads();
        const int nrow = n0 + (tid >> 1);
        bf16_t* cdst = dst + (size_t)(ilv ? ((nrow >> 7) * 256 + (nrow & 127) + (ilv == 2 ? 128 : 0)) : nrow) * K + k0 + (tid & 1) * 32;
        gi = ctr ? *qslot : gi + (int)gridDim.x; const bool more = gi < hi;
        if (more) { tr_decode(a, gi, src, dst, K, N, k0, n0, ilv);
#pragma unroll
            for (int i = 0; i < 8; ++i) { v[i] = (f32x4){0.f, 0.f, 0.f, 0.f}; if (n0 + c4 < N) v[i] = __builtin_nontemporal_load((const f32x4*)(src + (size_t)(k0 + r + 8 * i) * N + n0 + c4)); } }
        { const float* tp = tile + ((tid & 1) * 32) * 260 + (tid >> 1);
#pragma unroll
            for (int q = 0; q < 4; ++q) { u32x4 w; w.x = pg8::cvt_pk_bf16(tp[(q * 8 + 0) * 260], tp[(q * 8 + 1) * 260]); w.y = pg8::cvt_pk_bf16(tp[(q * 8 + 2) * 260], tp[(q * 8 + 3) * 260]);
                w.z = pg8::cvt_pk_bf16(tp[(q * 8 + 4) * 260], tp[(q * 8 + 5) * 260]); w.w = pg8::cvt_pk_bf16(tp[(q * 8 + 6) * 260], tp[(q * 8 + 7) * 260]);
                *(u32x4*)(cdst + q * 8) = w; } }
        __syncthreads();
        if (!more) break;
    }
}
__device__ __forceinline__ const float* prep_row_src(const Args& a, int row) { return row < MP ? a.in[I_XP] + (size_t)row * D : row < MROWS ? a.in[I_XS] + (size_t)(row - MP) * D : a.in[I_MEM] + (size_t)(row - MROWS) * D; }
__device__ __forceinline__ void phase_prep(const Args& a, float* lds) {
    unsigned char* ws = a.ws;
    phase_transposes(a, lds, 0, TT_EARLY, nullptr, nullptr);
    const int lane = tid_opq() & 63, gw = blockIdx.x * 8 + (tid_opq() >> 6), nw = gridDim.x * 8;
    int row = gw; if (row >= MROWS + 1024) return;
    f32x4 v[8];
    { const float* x = prep_row_src(a, row);
#pragma unroll
      for (int i = 0; i < 8; ++i) v[i] = __builtin_nontemporal_load((const f32x4*)(x + (i * 64 + lane) * 4)); }
    for (;;) {
        const int nrow = row + nw; const bool more = nrow < MROWS + 1024;
        f32x4 nv[8];
        if (more) { const float* x = prep_row_src(a, nrow);
#pragma unroll
            for (int i = 0; i < 8; ++i) nv[i] = __builtin_nontemporal_load((const f32x4*)(x + (i * 64 + lane) * 4)); }
        float ss = 0.f;
#pragma unroll
        for (int i = 0; i < 8; ++i) ss += (v[i][0] * v[i][0] + v[i][1] * v[i][1]) + (v[i][2] * v[i][2] + v[i][3] * v[i][3]);
        ss = wave_sum(ss); const float rs = rsqrtf(ss * (1.0f / 2048.0f) + 1e-6f);
        const float* gain = row < MROWS ? a.in[I_NMIX] : a.in[I_NMEM];
        bf16_t* o = row < MROWS ? (bf16_t*)(ws + WS_XN) + (size_t)row * D : (bf16_t*)(ws + WS_MEMN) + (size_t)(row - MROWS) * D;
#pragma unroll
        for (int i = 0; i < 8; ++i) { const f32x4 g = *(const f32x4*)(gain + (i * 64 + lane) * 4); u32x2 w; w.x = pg8::cvt_pk_bf16(v[i][0] * rs * g[0], v[i][1] * rs * g[1]); w.y = pg8::cvt_pk_bf16(v[i][2] * rs * g[2], v[i][3] * rs * g[3]);
            *(u32x2*)(o + (i * 64 + lane) * 4) = w; }
        if (!more) break;
#pragma unroll
        for (int i = 0; i < 8; ++i) v[i] = nv[i];
        row = nrow;
    }
}


__device__ __forceinline__ void gla_prompt_item(const Args& a, int item, float* lds) {
    const int tid = tid_opq(), b = item >> 6, h = (item >> 4) & 3, sl = item & 15;
    float* qs = lds; float* ks = qs + 4096; float* fs = ks + 4096; float* vs = fs + 4096; float* opart = vs + 512;
    const bf16_t* proj = (const bf16_t*)(a.ws + WS_PROJ) + (size_t)(b * 2048) * NINP;
    const float* Fg = (const float*)(a.ws + WS_F) + (size_t)(b * 2048) * 512 + h * 128;
    float* og = (float*)(a.ws + WS_OG);
    const int tt = tid >> 4, sub = tid & 15;
    const int dv = tid & 15, dkg = tid >> 4;
    float s0 = 0.f, s1 = 0.f, s2 = 0.f, s3 = 0.f;
    u32x4 rq, rk; f32x4 rf0, rf1; bf16_t rv;
    { const bf16_t* row = proj + (size_t)tt * NINP; rq = *(const u32x4*)(row + C_Q + h * 128 + sub * 8); rk = *(const u32x4*)(row + C_K + h * 128 + sub * 8);
      rf0 = *(const f32x4*)(Fg + (size_t)tt * 512 + sub * 8); rf1 = *(const f32x4*)(Fg + (size_t)tt * 512 + sub * 8 + 4); rv = row[C_V + h * 256 + sl * 16 + sub]; }
    for (int n = 0; n < 64; ++n) {
        { float qf[8], kf[8]; unpack8(rq, qf); unpack8(rk, kf);
            float* fp = fs + tt * 128 + sub * 8; float* qp = qs + tt * 128 + sub * 8; float* kp = ks + tt * 128 + sub * 8;
            *(f32x4*)fp = rf0; *(f32x4*)(fp + 4) = rf1;
            *(f32x4*)qp = (f32x4){qf[0], qf[1], qf[2], qf[3]} * 0.08838834764831845f; *(f32x4*)(qp + 4) = (f32x4){qf[4], qf[5], qf[6], qf[7]} * 0.08838834764831845f;
            *(f32x4*)kp = (f32x4){kf[0], kf[1], kf[2], kf[3]}; *(f32x4*)(kp + 4) = (f32x4){kf[4], kf[5], kf[6], kf[7]};
            vs[tt * 16 + sub] = bf2f(rv); }
        __syncthreads();
        if (n + 1 < 64) { const bf16_t* row = proj + (size_t)((n + 1) * 32 + tt) * NINP; rq = *(const u32x4*)(row + C_Q + h * 128 + sub * 8); rk = *(const u32x4*)(row + C_K + h * 128 + sub * 8);
            const float* fr_ = Fg + (size_t)((n + 1) * 32 + tt) * 512 + sub * 8; rf0 = *(const f32x4*)fr_; rf1 = *(const f32x4*)(fr_ + 4); rv = row[C_V + h * 256 + sl * 16 + sub]; }
#pragma unroll 8
        for (int t = 0; t < 32; ++t) {
            const f32x4 f4 = *(const f32x4*)(fs + t * 128 + dkg * 4), k4 = *(const f32x4*)(ks + t * 128 + dkg * 4), q4 = *(const f32x4*)(qs + t * 128 + dkg * 4); const float v = vs[t * 16 + dv];
            s0 = f4[0] * s0 + k4[0] * v; s1 = f4[1] * s1 + k4[1] * v; s2 = f4[2] * s2 + k4[2] * v; s3 = f4[3] * s3 + k4[3] * v;
            opart[dkg * 528 + t * 16 + dv] = (q4[0] * s0 + q4[1] * s1) + (q4[2] * s2 + q4[3] * s3); }
        __syncthreads();
        { float o = 0.f;
#pragma unroll 8
            for (int g = 0; g < 32; ++g) o += opart[g * 528 + tid];
            og[(size_t)(b * 2048 + n * 32 + (tid >> 4)) * 1024 + h * 256 + sl * 16 + (tid & 15)] = o; }
    }
    float* so = a.out + O_GLA_P + ((size_t)((b * 4 + h) * 128 + dkg * 4)) * 256 + sl * 16 + dv;
    so[0] = s0; so[256] = s1; so[512] = s2; so[768] = s3;
    __syncthreads();
}

__device__ __forceinline__ void gla_sample_item(const Args& a, int it, float* lds) {
    const int tid = tid_opq(), b = it >> 2, h = it & 3, lane = tid & 63, wid = tid >> 6;
    float* qs = lds; float* ks = qs + 512; float* fs = ks + 512; float* vs = fs + 512; float* red = vs + 1024; float* rsum = red + 512;
    const bf16_t* proj = (const bf16_t*)(a.ws + WS_PROJ) + (size_t)(MP + b * 4) * NINP;
    { const int t = tid >> 7, dk = tid & 127; const bf16_t* row = proj + (size_t)t * NINP;
        fs[tid] = __expf(((const float*)(a.ws + WS_F))[(size_t)(MP + b * 4 + t) * 512 + h * 128 + dk]); qs[tid] = bf2f(row[C_Q + h * 128 + dk]) * 0.08838834764831845f; ks[tid] = bf2f(row[C_K + h * 128 + dk]); }
#pragma unroll
    for (int i = 0; i < 2; ++i) { const int idx = tid + i * 512, t = idx >> 8, d = idx & 255; vs[idx] = bf2f(proj[(size_t)t * NINP + C_V + h * 256 + d]); }
    const int dv = tid & 255, half = tid >> 8;
    float s[64];
    const float* sp = a.in[I_SGLA] + ((size_t)((b * 4 + h) * 128 + half * 64)) * 256 + dv;
#pragma unroll
    for (int j = 0; j < 64; ++j) s[j] = __builtin_nontemporal_load(sp + (size_t)j * 256);
    __syncthreads();
    float ov[4];
#pragma unroll
    for (int t = 0; t < 4; ++t) { const float v = vs[t * 256 + dv]; float po = 0.f;
#pragma unroll
        for (int j = 0; j < 64; j += 4) { const f32x4 f4 = *(const f32x4*)(fs + t * 128 + half * 64 + j), k4 = *(const f32x4*)(ks + t * 128 + half * 64 + j), q4 = *(const f32x4*)(qs + t * 128 + half * 64 + j);
#pragma unroll
            for (int e = 0; e < 4; ++e) { s[j + e] = f4[e] * s[j + e] + k4[e] * v; po += q4[e] * s[j + e]; } }
        red[t * 512 + half * 256 + dv] = po; ov[t] = po; }
    float* so = a.out + O_GLA_S + ((size_t)((b * 4 + h) * 128 + half * 64)) * 256 + dv;
#pragma unroll
    for (int j = 0; j < 64; ++j) __builtin_nontemporal_store(s[j], so + (size_t)j * 256);
    __syncthreads();
    float* rs2 = red + 2048;
#pragma unroll
    for (int t = 0; t < 4; ++t) { const float o = red[t * 512 + dv] + red[t * 512 + 256 + dv]; ov[t] = o; const float ss = wave_sum(o * o); if (lane == 0) rs2[t * 8 + wid] = ss; }
    __syncthreads();
    if (half == 0) {
#pragma unroll
        for (int t = 0; t < 4; ++t) { const float tot = (rs2[t * 8] + rs2[t * 8 + 1]) + (rs2[t * 8 + 2] + rs2[t * 8 + 3]); const float rstd = rsqrtf(tot * (1.0f / 256.0f) + 1e-6f);
            const float rg = bf2f(proj[(size_t)t * NINP + C_R + h * 256 + dv]);
            ((bf16_t*)(a.ws + WS_MIXIN))[(size_t)(MP + b * 4 + t) * D + 1024 + h * 256 + dv] = f2bf(ov[t] * rstd * a.in[I_GLAN][h * 256 + dv] * silu_f(rg)); } }
    __syncthreads();
}

struct RowRaw { u32x4 bg[2], c0[2], v0[2], c1[2], v1[2], c2[2], v2[2], g1a, g1b; };
__device__ __forceinline__ void rows_pre_load(const bf16_t* __restrict__ projb, int row, int lane, RowRaw& R) {
    const bool samp = row >= MP; const int t = samp ? ((row - MP) & 3) : (row & 2047);
    const bf16_t* pr = projb + (size_t)row * NINP; const int b1 = t >= 1 ? NINP : 0, b2 = t >= 2 ? 2 * NINP : 0;
#pragma unroll
    for (int i = 0; i < 2; ++i) { const int c = i * 512 + lane * 8;
        R.bg[i] = *(const u32x4*)(pr + C_BG + c); R.c2[i] = *(const u32x4*)(pr + C_CG + c); R.v2[i] = *(const u32x4*)(pr + C_VC + c);
        R.c1[i] = *(const u32x4*)(pr - b1 + C_CG + c); R.v1[i] = *(const u32x4*)(pr - b1 + C_VC + c);
        R.c0[i] = *(const u32x4*)(pr - b2 + C_CG + c); R.v0[i] = *(const u32x4*)(pr - b2 + C_VC + c); }
    R.g1a = *(const u32x4*)(pr + C_G1); R.g1b = *(const u32x4*)(pr + C_G1 + 8);
}
__device__ __forceinline__ void rows_pre_compute(const Args& a, int row, int lane, const RowRaw& R) {
    bf16_t* mix = (bf16_t*)(a.ws + WS_MIXIN); const float* cw = a.in[I_CONVW];
    const bool samp = row >= MP; const int t = samp ? ((row - MP) & 3) : (row & 2047), bi = samp ? ((row - MP) >> 2) : (row >> 11);
#pragma unroll
    for (int i = 0; i < 2; ++i) { const int c = i * 512 + lane * 8;
        float bg[8], cgv[8], vcv[8], u2[8], u1[8], u0[8];
        unpack8(R.bg[i], bg); unpack8(R.c2[i], cgv); unpack8(R.v2[i], vcv);
#pragma unroll
        for (int j = 0; j < 8; ++j) u2[j] = cgv[j] * vcv[j];
        if (t >= 1) { unpack8(R.c1[i], cgv); unpack8(R.v1[i], vcv);
#pragma unroll
            for (int j = 0; j < 8; ++j) u1[j] = cgv[j] * vcv[j]; }
        else if (samp) { const float* cp = a.in[I_CCONV] + (size_t)(bi * 2 + 1) * 1024 + c;
#pragma unroll
            for (int j = 0; j < 8; ++j) u1[j] = cp[j]; }
        else {
#pragma unroll
            for (int j = 0; j < 8; ++j) u1[j] = 0.f; }
        if (t >= 2) { unpack8(R.c0[i], cgv); unpack8(R.v0[i], vcv);
#pragma unroll
            for (int j = 0; j < 8; ++j) u0[j] = cgv[j] * vcv[j]; }
        else if (samp) { const float* cp = a.in[I_CCONV] + (size_t)(bi * 2 + t) * 1024 + c;
#pragma unroll
            for (int j = 0; j < 8; ++j) u0[j] = cp[j]; }
        else {
#pragma unroll
            for (int j = 0; j < 8; ++j) u0[j] = 0.f; }
        float o[8];
#pragma unroll
        for (int j = 0; j < 8; ++j) o[j] = bg[j] * (cw[c + j] * u0[j] + cw[1024 + c + j] * u1[j] + cw[2048 + c + j] * u2[j]);
        u32x4 w; w.x = pg8::cvt_pk_bf16(o[0], o[1]); w.y = pg8::cvt_pk_bf16(o[2], o[3]); w.z = pg8::cvt_pk_bf16(o[4], o[5]); w.w = pg8::cvt_pk_bf16(o[6], o[7]);
        *(u32x4*)(mix + (size_t)row * D + c) = w;
        float* cn = nullptr;
        if (!samp) { if (t >= 2046) cn = a.out + O_CONV_P + (size_t)(bi * 2 + (t - 2046)) * 1024 + c; }
        else { if (t >= 2) cn = a.out + O_CONV_S + (size_t)(bi * 2 + (t - 2)) * 1024 + c; }
        if (cn) {
#pragma unroll
            for (int j = 0; j < 8; ++j) cn[j] = u2[j]; }
    }
    {
        float g1[16]; { float t8[8]; unpack8(R.g1a, t8);
#pragma unroll
            for (int j = 0; j < 8; ++j) g1[j] = t8[j];
            unpack8(R.g1b, t8);
#pragma unroll
            for (int j = 0; j < 8; ++j) g1[8 + j] = t8[j]; }
        f32x4 z0 = *(const f32x4*)(a.in[I_BG] + lane * 8), z1 = *(const f32x4*)(a.in[I_BG] + lane * 8 + 4);
#pragma unroll
        for (int r = 0; r < 16; ++r) { z0 += *(const f32x4*)(a.in[I_WG2] + r * 512 + lane * 8) * g1[r]; z1 += *(const f32x4*)(a.in[I_WG2] + r * 512 + lane * 8 + 4) * g1[r]; }
        f32x4 f0, f1;
#pragma unroll
        for (int j = 0; j < 4; ++j) { f0[j] = log_forget(z0[j]); f1[j] = log_forget(z1[j]); }
        float* fo = (float*)(a.ws + WS_F) + (size_t)row * 512 + lane * 8; *(f32x4*)fo = f0; *(f32x4*)(fo + 4) = f1; }
}
__device__ __forceinline__ void phase_rows_pre(const Args& a) {
    const int lane = tid_opq() & 63, wid = tid_opq() >> 6;
    const bf16_t* projb = (const bf16_t*)(a.ws + WS_PROJ);
    const int per = (MROWS + (int)gridDim.x - 1) / (int)gridDim.x, base = blockIdx.x * per, lim = (base + per < MROWS) ? base + per : MROWS;
    int row = base + wid; if (row >= lim) return;
    RowRaw cur; rows_pre_load(projb, row, lane, cur);
    for (;;) {
        const int nrow = row + 8; const bool more = nrow < lim;
        RowRaw nxt; if (more) rows_pre_load(projb, nrow, lane, nxt); else nxt = cur;
        rows_pre_compute(a, row, lane, cur);
        if (!more) break;
        cur = nxt; row = nrow;
    }
}
__device__ __forceinline__ void phase_gla_norm(const Args& a) {
    const int lane = tid_opq() & 63, gw = blockIdx.x * 8 + (tid_opq() >> 6), nw = gridDim.x * 8;
    const bf16_t* projb = (const bf16_t*)(a.ws + WS_PROJ); bf16_t* mix = (bf16_t*)(a.ws + WS_MIXIN);
    for (int row = gw; row < MP; row += nw) {
        const bf16_t* pr = projb + (size_t)row * NINP;
        {
            const float* og = (const float*)(a.ws + WS_OG) + (size_t)row * 1024;
#pragma unroll
            for (int h = 0; h < 4; ++h) { const f32x4 o4 = *(const f32x4*)(og + h * 256 + lane * 4);
                const float ss = wave_sum((o4[0] * o4[0] + o4[1] * o4[1]) + (o4[2] * o4[2] + o4[3] * o4[3])); const float rstd = rsqrtf(ss * (1.0f / 256.0f) + 1e-6f);
                const f32x4 gn = *(const f32x4*)(a.in[I_GLAN] + h * 256 + lane * 4); const u32x2 rw = *(const u32x2*)(pr + C_R + h * 256 + lane * 4);
                const float r0 = bflo(rw.x), r1 = bfhi(rw.x), r2 = bflo(rw.y), r3 = bfhi(rw.y);
                u32x2 w; w.x = pg8::cvt_pk_bf16(o4[0] * rstd * gn[0] * silu_f(r0), o4[1] * rstd * gn[1] * silu_f(r1)); w.y = pg8::cvt_pk_bf16(o4[2] * rstd * gn[2] * silu_f(r2), o4[3] * rstd * gn[3] * silu_f(r3));
                *(u32x2*)(mix + (size_t)row * D + 1024 + h * 256 + lane * 4) = w; }
        }
    }
}

constexpr int GL_LDK = 72, GL_LDQ = 136;
__device__ __forceinline__ void gla_cum(const float* __restrict__ lf_base, int d, int qt, float* part, float (&cum)[16], float& Lval) {
    float run = 0.f;
#pragma unroll
    for (int jj = 0; jj < 16; ++jj) { run += lf_base[(size_t)(qt * 16 + jj) * 512 + d]; cum[jj] = run; }
    part[qt * 128 + d] = run;
    __syncthreads();
    const float p0 = part[d], p1 = part[128 + d], p2 = part[256 + d], p3 = part[384 + d];
    const float off = (qt > 0 ? p0 : 0.f) + (qt > 1 ? p1 : 0.f) + (qt > 2 ? p2 : 0.f);
#pragma unroll
    for (int jj = 0; jj < 16; ++jj) cum[jj] += off;
    Lval = (p0 + p1) + (p2 + p3);
}
__device__ __forceinline__ void gla_stage_vt(const bf16_t* __restrict__ proj_rows, int h, bf16_t* VT, int tid) {
    const int v = tid & 255, jh = tid >> 8; const bf16_t* src = proj_rows + (size_t)(jh * 32) * NINP + C_V + h * 256 + v;
#pragma unroll
    for (int q = 0; q < 4; ++q) { unsigned w[4];
#pragma unroll
        for (int e = 0; e < 4; ++e) { const unsigned lo = src[(size_t)(q * 8 + 2 * e) * NINP], hi = src[(size_t)(q * 8 + 2 * e + 1) * NINP]; w[e] = lo | (hi << 16); }
        u32x4 ww; ww.x = w[0]; ww.y = w[1]; ww.z = w[2]; ww.w = w[3]; *(u32x4*)(VT + v * GL_LDK + jh * 32 + q * 8) = ww; }
}
__device__ __forceinline__ void gla_pass_a(const Args& a, int item, unsigned char* ldsb) {
    const int tid = tid_opq(), lane = tid & 63, wid = tid >> 6, fr = lane & 15, fq = lane >> 4;
    const int b = item >> 7, h = (item >> 5) & 3, n = item & 31, row0 = b * 2048 + n * 64;
    bf16_t* KlT = (bf16_t*)ldsb; bf16_t* VT = KlT + 128 * GL_LDK; float* part = (float*)(VT + 256 * GL_LDK);
    const bf16_t* prow = (const bf16_t*)(a.ws + WS_PROJ) + (size_t)row0 * NINP;
    { const int d = tid & 127, qt = tid >> 7; float cum[16], Lv;
        gla_cum((const float*)(a.ws + WS_F) + (size_t)row0 * 512 + h * 128, d, qt, part, cum, Lv);
        const bf16_t* kp = prow + (size_t)(qt * 16) * NINP + C_K + h * 128 + d; unsigned w[8];
#pragma unroll
        for (int e = 0; e < 8; ++e) { const float k0 = bf2f(kp[(size_t)(2 * e) * NINP]) * __expf(Lv - cum[2 * e]), k1 = bf2f(kp[(size_t)(2 * e + 1) * NINP]) * __expf(Lv - cum[2 * e + 1]); w[e] = pg8::cvt_pk_bf16(k0, k1); }
        u32x4 w0, w1; w0.x = w[0]; w0.y = w[1]; w0.z = w[2]; w0.w = w[3]; w1.x = w[4]; w1.y = w[5]; w1.z = w[6]; w1.w = w[7];
        *(u32x4*)(KlT + d * GL_LDK + qt * 16) = w0; *(u32x4*)(KlT + d * GL_LDK + qt * 16 + 8) = w1;
        if (qt == 0) ((float*)(a.ws + WS_GU + GL_EL_OFF))[(size_t)item * 128 + d] = __expf(Lv); }
    gla_stage_vt(prow, h, VT, tid);
    __syncthreads();
    { const bf16x8 x0 = *(const bf16x8*)(KlT + (wid * 16 + fr) * GL_LDK + fq * 8), x1 = *(const bf16x8*)(KlT + (wid * 16 + fr) * GL_LDK + 32 + fq * 8);
        float* kc = (float*)(a.ws + WS_GU) + (size_t)item * 32768 + wid * 16 + 4 * fq;
#pragma unroll 4
        for (int vt = 0; vt < 16; ++vt) { const bf16x8 y0 = *(const bf16x8*)(VT + (vt * 16 + fr) * GL_LDK + fq * 8), y1 = *(const bf16x8*)(VT + (vt * 16 + fr) * GL_LDK + 32 + fq * 8);
            f32x4 acc = (f32x4){0.f, 0.f, 0.f, 0.f};
            acc = __builtin_amdgcn_mfma_f32_16x16x32_bf16(x0, y0, acc, 0, 0, 0); acc = __builtin_amdgcn_mfma_f32_16x16x32_bf16(x1, y1, acc, 0, 0, 0);
            *(f32x4*)(kc + (size_t)(vt * 16 + fr) * 128) = acc; } }
    __syncthreads();
}
__device__ __forceinline__ void gla_pass_b(const Args& a) {
    const float* KC = (const float*)(a.ws + WS_GU); const float* EL = (const float*)(a.ws + WS_GU + GL_EL_OFF); bf16_t* SST = (bf16_t*)(a.ws + WS_GU + GL_SST_OFF);
    for (int gid = blockIdx.x * 512 + tid_opq(); gid < 131072; gid += gridDim.x * 512) {
        const int bh = gid >> 13, v = (gid >> 5) & 255, d4 = (gid & 31) * 4;
        f32x4 s = (f32x4){0.f, 0.f, 0.f, 0.f};
#pragma unroll 8
        for (int n = 0; n < 32; ++n) { const int item = bh * 32 + n;
            const f32x4 kc = *(const f32x4*)(KC + (size_t)item * 32768 + v * 128 + d4), el = *(const f32x4*)(EL + (size_t)item * 128 + d4);
            u32x2 w; w.x = pg8::cvt_pk_bf16(s[0], s[1]); w.y = pg8::cvt_pk_bf16(s[2], s[3]); *(u32x2*)(SST + (size_t)item * 32768 + v * 128 + d4) = w;
            s = el * s + kc; }
        float* so = a.out + O_GLA_P + ((size_t)(bh * 128 + d4)) * 256 + v; so[0] = s[0]; so[256] = s[1]; so[512] = s[2]; so[768] = s[3];
    }
}
__device__ __forceinline__ void gla_pass_c(const Args& a, int item, unsigned char* ldsb) {
    const int tid = tid_opq(), lane = tid & 63, wid = tid >> 6, fr = lane & 15, fq = lane >> 4;
    const int b = item >> 7, h = (item >> 5) & 3, n = item & 31, row0 = b * 2048 + n * 64;
    bf16_t* Qd = (bf16_t*)ldsb; bf16_t* Kd = Qd + 64 * GL_LDQ; bf16_t* VT = Kd + 64 * GL_LDQ; bf16_t* SS = VT + 256 * GL_LDK; float* part = (float*)(SS + 256 * GL_LDQ); float* red = part + 512;
    const bf16_t* sst = (const bf16_t*)(a.ws + WS_GU + GL_SST_OFF) + (size_t)item * 32768;
    u32x4 sr[8];
#pragma unroll
    for (int i = 0; i < 8; ++i) sr[i] = *(const u32x4*)(sst + (size_t)(tid + 512 * i) * 8);
    const bf16_t* prow = (const bf16_t*)(a.ws + WS_PROJ) + (size_t)row0 * NINP;
    { const int d = tid & 127, qt = tid >> 7; float cum[16], Lv;
        const bf16_t* qp = prow + (size_t)(qt * 16) * NINP + C_Q + h * 128 + d; const bf16_t* kp = qp + (C_K - C_Q);
        bf16_t qraw[16], kraw[16];
#pragma unroll
        for (int jj = 0; jj < 16; ++jj) { qraw[jj] = qp[(size_t)jj * NINP]; kraw[jj] = kp[(size_t)jj * NINP]; }
        const int vv = tid & 255, jh = tid >> 8; const bf16_t* vsrc = prow + (size_t)(jh * 32) * NINP + C_V + h * 256 + vv; unsigned vw[16];
#pragma unroll
        for (int e = 0; e < 16; ++e) { const unsigned lo = vsrc[(size_t)(2 * e) * NINP], hi = vsrc[(size_t)(2 * e + 1) * NINP]; vw[e] = lo | (hi << 16); }
        gla_cum((const float*)(a.ws + WS_F) + (size_t)row0 * 512 + h * 128, d, qt, part, cum, Lv);
#pragma unroll
        for (int jj = 0; jj < 16; ++jj) { const float e = __expf(cum[jj]);
            const unsigned qk = pg8::cvt_pk_bf16(bf2f(qraw[jj]) * 0.08838834764831845f * e, bf2f(kraw[jj]) * __builtin_amdgcn_rcpf(e));
            Qd[(qt * 16 + jj) * GL_LDQ + d] = (bf16_t)(qk & 0xffffu); Kd[(qt * 16 + jj) * GL_LDQ + d] = (bf16_t)(qk >> 16); }
#pragma unroll
        for (int q = 0; q < 4; ++q) { u32x4 ww; ww.x = vw[4 * q]; ww.y = vw[4 * q + 1]; ww.z = vw[4 * q + 2]; ww.w = vw[4 * q + 3]; *(u32x4*)(VT + vv * GL_LDK + jh * 32 + q * 8) = ww; } }
#pragma unroll
    for (int i = 0; i < 8; ++i) { const int id = tid + 512 * i; *(u32x4*)(SS + (id >> 4) * GL_LDQ + (id & 15) * 8) = sr[i]; }
    __syncthreads();
    const int it = wid >> 1, vh = wid & 1;
    bf16x8 qf[4];
#pragma unroll
    for (int ks = 0; ks < 4; ++ks) qf[ks] = *(const bf16x8*)(Qd + (it * 16 + fr) * GL_LDQ + ks * 32 + fq * 8);
    f32x4 aa[4];
#pragma unroll
    for (int jt = 0; jt < 4; ++jt) { f32x4 acc = (f32x4){0.f, 0.f, 0.f, 0.f};
        if (jt <= it) {
#pragma unroll
            for (int ks = 0; ks < 4; ++ks) { const bf16x8 kf = *(const bf16x8*)(Kd + (jt * 16 + fr) * GL_LDQ + ks * 32 + fq * 8); acc = __builtin_amdgcn_mfma_f32_16x16x32_bf16(kf, qf[ks], acc, 0, 0, 0); }
            if (jt == it) {
#pragma unroll
                for (int e = 0; e < 4; ++e) if (4 * fq + e > fr) acc[e] = 0.f; } }
        aa[jt] = acc; }
    bf16x8 pa[2];
#pragma unroll
    for (int s = 0; s < 2; ++s) { const u32x4 w = pg8::pack8(aa[2 * s], aa[2 * s + 1]); pa[s] = __builtin_bit_cast(bf16x8, w); }
    f32x4 o[8]; float ss = 0.f;
#pragma unroll
    for (int vt = 0; vt < 8; ++vt) { const int vrow = (vh * 8 + vt) * 16 + fr; f32x4 acc = (f32x4){0.f, 0.f, 0.f, 0.f};
#pragma unroll
        for (int s = 0; s < 2; ++s) { const u32x2 lo = *(const u32x2*)(VT + vrow * GL_LDK + 32 * s + 4 * fq), hi = *(const u32x2*)(VT + vrow * GL_LDK + 32 * s + 16 + 4 * fq);
            u32x4 w; w.x = lo.x; w.y = lo.y; w.z = hi.x; w.w = hi.y; acc = __builtin_amdgcn_mfma_f32_16x16x32_bf16(__builtin_bit_cast(bf16x8, w), pa[s], acc, 0, 0, 0); }
#pragma unroll
        for (int ks = 0; ks < 4; ++ks) { const bf16x8 sf = *(const bf16x8*)(SS + vrow * GL_LDQ + ks * 32 + fq * 8); acc = __builtin_amdgcn_mfma_f32_16x16x32_bf16(sf, qf[ks], acc, 0, 0, 0); }
        o[vt] = acc; ss += (acc[0] * acc[0] + acc[1] * acc[1]) + (acc[2] * acc[2] + acc[3] * acc[3]); }
    ss += __shfl_xor(ss, 16); ss += __shfl_xor(ss, 32);
    if (fq == 0) red[(it * 16 + fr) * 2 + vh] = ss;
    __syncthreads();
    { const float tot = red[(it * 16 + fr) * 2] + red[(it * 16 + fr) * 2 + 1]; const float rstd = rsqrtf(tot * (1.0f / 256.0f) + 1e-6f);
        const int row = row0 + it * 16 + fr; const bf16_t* rg = prow + (size_t)(it * 16 + fr) * NINP + C_R + h * 256; bf16_t* mo = (bf16_t*)(a.ws + WS_MIXIN) + (size_t)row * D + 1024 + h * 256;
#pragma unroll
        for (int vt = 0; vt < 8; ++vt) { const int v0 = (vh * 8 + vt) * 16 + 4 * fq; const f32x4 gn = *(const f32x4*)(a.in[I_GLAN] + h * 256 + v0); const u32x2 rw = *(const u32x2*)(rg + v0);
            u32x2 w; w.x = pg8::cvt_pk_bf16(o[vt][0] * rstd * gn[0] * silu_f(bflo(rw.x)), o[vt][1] * rstd * gn[1] * silu_f(bfhi(rw.x)));
            w.y = pg8::cvt_pk_bf16(o[vt][2] * rstd * gn[2] * silu_f(bflo(rw.y)), o[vt][3] * rstd * gn[3] * silu_f(bfhi(rw.y)));
            *(u32x2*)(mo + v0) = w; } }
    __syncthreads();
}

constexpr int XA_LDK = 136, XA_LDV = 264, XA_BUF = 128 * 264;
__device__ __forceinline__ void xattn_prompt_item(const Args& a, int it, unsigned char* ldsb) {
    const int tid = tid_opq(), lane = tid & 63, wid = tid >> 6, fr = lane & 15, fq = lane >> 4;
    const int b = it >> 6, h = (it >> 4) & 3, tt = it & 15;
    const int r0 = b * 2048 + tt * 128 + wid * 16;
    bf16_t* buf0 = (bf16_t*)ldsb; bf16_t* buf1 = buf0 + 34816;
    const bf16_t* qp = (const bf16_t*)(a.ws + WS_XN) + (size_t)(r0 + fr) * D + h * 512 + fq * 8;
    const bf16_t* kg = (const bf16_t*)(a.ws + WS_MKB) + (size_t)(b * 256) * D + h * 512;
    const bf16_t* vg = (const bf16_t*)(a.ws + WS_MVT) + (size_t)(b * 2048 + h * 512) * 256;
    u32x4 rs[8];
#pragma unroll
    for (int i = 0; i < 8; ++i) { const int id = tid + 512 * i, row = id >> 4, sg = id & 15; rs[i] = *(const u32x4*)(kg + (size_t)row * D + sg * 8); }
#pragma unroll
    for (int i = 0; i < 8; ++i) { const int id = tid + 512 * i, row = id >> 4, sg = id & 15; *(u32x4*)(buf0 + row * XA_LDK + sg * 8) = rs[i]; }
    __syncthreads();
    f32x4 st[16];
#pragma unroll
    for (int n = 0; n < 16; ++n) st[n] = (f32x4){0.f, 0.f, 0.f, 0.f};
#pragma unroll
    for (int c = 0; c < 4; ++c) {
        bf16_t* cur = (c & 1) ? buf1 : buf0; bf16_t* nxt = (c & 1) ? buf0 : buf1;
        if (c < 3) {
#pragma unroll
            for (int i = 0; i < 8; ++i) { const int id = tid + 512 * i, row = id >> 4, sg = id & 15; rs[i] = *(const u32x4*)(kg + (size_t)row * D + (c + 1) * 128 + sg * 8); } }
        else {
#pragma unroll
            for (int i = 0; i < 8; ++i) { const int id = tid + 512 * i, row = id >> 5, sg = id & 31; rs[i] = *(const u32x4*)(vg + (size_t)row * 256 + sg * 8); } }
        bf16x8 qf[4];
#pragma unroll
        for (int ks = 0; ks < 4; ++ks) qf[ks] = *(const bf16x8*)(qp + c * 128 + ks * 32);
#pragma unroll
        for (int n = 0; n < 16; ++n) {
#pragma unroll
            for (int ks = 0; ks < 4; ++ks) { const bf16x8 kf = *(const bf16x8*)(cur + (n * 16 + fr) * XA_LDK + ks * 32 + fq * 8); st[n] = __builtin_amdgcn_mfma_f32_16x16x32_bf16(kf, qf[ks], st[n], 0, 0, 0); } }
        if (c < 3) {
#pragma unroll
            for (int i = 0; i < 8; ++i) { const int id = tid + 512 * i, row = id >> 4, sg = id & 15; *(u32x4*)(nxt + row * XA_LDK + sg * 8) = rs[i]; } }
        else {
#pragma unroll
            for (int i = 0; i < 8; ++i) { const int id = tid + 512 * i, row = id >> 5, sg = id & 31; *(u32x4*)(nxt + row * XA_LDV + sg * 8) = rs[i]; } }
        __syncthreads();
    }
    float mx = -3.0e38f;
#pragma unroll
    for (int n = 0; n < 16; ++n) mx = fmaxf(fmaxf(fmaxf(st[n][0], st[n][1]), fmaxf(st[n][2], st[n][3])), mx);
    mx = fmaxf(mx, __shfl_xor(mx, 16)); mx = fmaxf(mx, __shfl_xor(mx, 32));
    float sum = 0.f;
#pragma unroll
    for (int n = 0; n < 16; ++n) {
#pragma unroll
        for (int e = 0; e < 4; ++e) { const float p = __expf(st[n][e] - mx); st[n][e] = p; sum += p; } }
    sum += __shfl_xor(sum, 16); sum += __shfl_xor(sum, 32);
    const float inv = 1.0f / sum;
    bf16x8 pf[8];
#pragma unroll
    for (int i = 0; i < 8; ++i) { u32x4 w = pg8::pack8(st[2 * i], st[2 * i + 1]); pf[i] = __builtin_bit_cast(bf16x8, w); }
    bf16_t* op = (bf16_t*)(a.ws + WS_MIXIN) + (size_t)(r0 + fr) * D + h * 512 + 4 * fq;
#pragma unroll
    for (int c = 0; c < 4; ++c) {
        bf16_t* cur = (c & 1) ? buf1 : buf0; bf16_t* nxt = (c & 1) ? buf0 : buf1;
        if (c < 3) {
#pragma unroll
            for (int i = 0; i < 8; ++i) { const int id = tid + 512 * i, row = id >> 5, sg = id & 31; rs[i] = *(const u32x4*)(vg + (size_t)((c + 1) * 128 + row) * 256 + sg * 8); } }
#pragma unroll
        for (int dt = 0; dt < 8; ++dt) { f32x4 acc = (f32x4){0.f, 0.f, 0.f, 0.f};
#pragma unroll
            for (int i = 0; i < 8; ++i) { const bf16x8 vf = *(const bf16x8*)(cur + (dt * 16 + fr) * XA_LDV + i * 32 + fq * 8); acc = __builtin_amdgcn_mfma_f32_16x16x32_bf16(vf, pf[i], acc, 0, 0, 0); }
            u32x2 w; w.x = pg8::cvt_pk_bf16(acc[0] * inv, acc[1] * inv); w.y = pg8::cvt_pk_bf16(acc[2] * inv, acc[3] * inv);
            *(u32x2*)(op + c * 128 + dt * 16) = w; }
        if (c < 3) {
#pragma unroll
            for (int i = 0; i < 8; ++i) { const int id = tid + 512 * i, row = id >> 5, sg = id & 31; *(u32x4*)(nxt + row * XA_LDV + sg * 8) = rs[i]; } }
        __syncthreads();
    }
}
__device__ __forceinline__ void xattn_sample_item(const Args& a, int it, float* lds) {
    const int tid = tid_opq(), lane = tid & 63, wid = tid >> 6, fr = lane & 15, fq = lane >> 4, b = it >> 2, h = it & 3;
    float* sc = lds; float* pT = lds + 1024; float* red = lds + 2048;
    const float* Kc = a.in[I_CMK] + ((size_t)b * 1024 + h) * 512; const float* Vc = a.in[I_CMV] + ((size_t)b * 1024 + h) * 512;
    const bf16_t* qb = (const bf16_t*)(a.ws + WS_XN) + (size_t)(MP + b * 4 + (fr & 3)) * D + h * 512 + fq * 8;
    bf16x8 qf[16];
#pragma unroll
    for (int ks = 0; ks < 16; ++ks) { u32x4 w = *(const u32x4*)(qb + ks * 32); if (fr >= 4) w = (u32x4){0u, 0u, 0u, 0u}; qf[ks] = __builtin_bit_cast(bf16x8, w); }
#pragma unroll
    for (int n = 0; n < 2; ++n) { f32x4 acc = (f32x4){0.f, 0.f, 0.f, 0.f}; const float* kr = Kc + (size_t)(wid * 32 + n * 16 + fr) * 2048 + fq * 8;
#pragma unroll
        for (int ks = 0; ks < 16; ++ks) { const f32x4 k0 = __builtin_nontemporal_load((const f32x4*)(kr + ks * 32)), k1 = __builtin_nontemporal_load((const f32x4*)(kr + ks * 32 + 4));
            const u32x4 w = pg8::pack8(k0, k1); acc = __builtin_amdgcn_mfma_f32_16x16x32_bf16(__builtin_bit_cast(bf16x8, w), qf[ks], acc, 0, 0, 0); }
        if (fr < 4) {
#pragma unroll
            for (int e = 0; e < 4; ++e) sc[fr * 256 + wid * 32 + n * 16 + 4 * fq + e] = acc[e]; } }
    __syncthreads();
    if (wid < 4) { f32x4 s4 = *(const f32x4*)(sc + wid * 256 + lane * 4); const float mx = wave_max(fmaxf(fmaxf(s4[0], s4[1]), fmaxf(s4[2], s4[3])));
        s4[0] = __expf(s4[0] - mx); s4[1] = __expf(s4[1] - mx); s4[2] = __expf(s4[2] - mx); s4[3] = __expf(s4[3] - mx);
        const float inv = 1.0f / wave_sum((s4[0] + s4[1]) + (s4[2] + s4[3])); s4 = s4 * inv;
#pragma unroll
        for (int e = 0; e < 4; ++e) pT[(lane * 4 + e) * 4 + wid] = s4[e]; }
    __syncthreads();
    { const int dq = tid & 127, kq = tid >> 7; f32x4 acc[4];
#pragma unroll
        for (int t = 0; t < 4; ++t) acc[t] = (f32x4){0.f, 0.f, 0.f, 0.f};
#pragma unroll 16
        for (int kk = 0; kk < 64; ++kk) { const int key = kq * 64 + kk; const f32x4 v = __builtin_nontemporal_load((const f32x4*)(Vc + (size_t)key * 2048 + dq * 4)); const f32x4 p4 = *(const f32x4*)(pT + key * 4);
#pragma unroll
            for (int t = 0; t < 4; ++t) acc[t] += v * p4[t]; }
#pragma unroll
        for (int t = 0; t < 4; ++t) *(f32x4*)(red + (kq * 4 + t) * 512 + dq * 4) = acc[t]; }
    __syncthreads();
    { const int dq = tid & 127, t = tid >> 7; f32x4 o = *(const f32x4*)(red + t * 512 + dq * 4);
#pragma unroll
        for (int kq = 1; kq < 4; ++kq) o += *(const f32x4*)(red + (kq * 4 + t) * 512 + dq * 4);
        u32x2 w; w.x = pg8::cvt_pk_bf16(o[0], o[1]); w.y = pg8::cvt_pk_bf16(o[2], o[3]);
        *(u32x2*)((bf16_t*)(a.ws + WS_MIXIN) + (size_t)(MP + b * 4 + t) * D + h * 512 + dq * 4) = w; }
    __syncthreads();
}

__device__ __forceinline__ void phase_act(const Args& a) {
    const bf16_t* gu = (const bf16_t*)(a.ws + WS_GU); bf16_t* act = (bf16_t*)(a.ws + WS_PROJ);
    const float* cw = a.in[I_FCW]; const float* cb = a.in[I_FCB];
    const int total = (256 + MSAMP) * 704;
    for (int idx = blockIdx.x * 512 + tid_opq(); idx < total; idx += gridDim.x * 512) {
        const int ri = idx / 704, c = (idx - ri * 704) * 8, row = ri < 256 ? (ri >> 1) * 64 + (ri & 1) : MP + (ri - 256);
        const bool samp = row >= MP; const int t = samp ? ((row - MP) & 3) : (row & 2047), bi = samp ? ((row - MP) >> 2) : (row >> 11);
        const bf16_t* gr = gu + (size_t)row * (2 * DFF) + c;
        float g2[8], g1[8], g0[8], uu[8];
        unpack8(*(const u32x4*)gr, g2); unpack8(*(const u32x4*)(gr + DFF), uu);
        if (t >= 1) unpack8(*(const u32x4*)(gr - 2 * DFF), g1);
        else if (samp) { const float* cp = a.in[I_CFFN] + (size_t)(bi * 2 + 1) * DFF + c;
#pragma unroll
            for (int j = 0; j < 8; ++j) g1[j] = cp[j]; }
        else {
#pragma unroll
            for (int j = 0; j < 8; ++j) g1[j] = 0.f; }
        if (t >= 2) unpack8(*(const u32x4*)(gr - 4 * DFF), g0);
        else if (samp) { const float* cp = a.in[I_CFFN] + (size_t)(bi * 2 + t) * DFF + c;
#pragma unroll
            for (int j = 0; j < 8; ++j) g0[j] = cp[j]; }
        else {
#pragma unroll
            for (int j = 0; j < 8; ++j) g0[j] = 0.f; }
        float o[8];
#pragma unroll
        for (int j = 0; j < 8; ++j) { const float x = cw[c + j] * g0[j] + cw[DFF + c + j] * g1[j] + cw[2 * DFF + c + j] * g2[j] + cb[c + j]; o[j] = silu_f(x) * uu[j]; }
        u32x4 w; w.x = pg8::cvt_pk_bf16(o[0], o[1]); w.y = pg8::cvt_pk_bf16(o[2], o[3]); w.z = pg8::cvt_pk_bf16(o[4], o[5]); w.w = pg8::cvt_pk_bf16(o[6], o[7]);
        *(u32x4*)(act + (size_t)row * DFF + c) = w;
    }
}

__device__ __forceinline__ void phase_final(const Args& a) {
    const int lane = tid_opq() & 63, gw = blockIdx.x * 8 + (tid_opq() >> 6), nw = gridDim.x * 8;
    const float* ssq = (const float*)(a.ws + WS_SSQ3); const float* g = a.in[I_NFIN];
    int row = gw; if (row >= MROWS) return;
    f32x4 gg[8];
#pragma unroll
    for (int i = 0; i < 8; ++i) gg[i] = *(const f32x4*)(g + (i * 64 + lane) * 4);
    f32x4 v[8]; float sq = lane < 32 ? ssq[(size_t)row * 32 + lane] : 0.f;
#pragma unroll
    for (int i = 0; i < 8; ++i) v[i] = *(const f32x4*)(a.out + O_Y + (size_t)row * D + (i * 64 + lane) * 4);
    for (;;) {
        const int nrow = row + nw; const bool more = nrow < MROWS;
        f32x4 nv[8]; float nsq = 0.f;
        if (more) { nsq = lane < 32 ? ssq[(size_t)nrow * 32 + lane] : 0.f;
#pragma unroll
            for (int i = 0; i < 8; ++i) nv[i] = *(const f32x4*)(a.out + O_Y + (size_t)nrow * D + (i * 64 + lane) * 4); }
        const float rs = rsqrtf(wave_sum(sq) * (1.0f / 2048.0f) + 1e-6f);
        float* y = a.out + O_Y + (size_t)row * D;
#pragma unroll
        for (int i = 0; i < 8; ++i) __builtin_nontemporal_store(v[i] * rs * gg[i], (f32x4*)(y + (i * 64 + lane) * 4));
        if (!more) break;
#pragma unroll
        for (int i = 0; i < 8; ++i) v[i] = nv[i];
        sq = nsq; row = nrow;
    }
}

struct SmallEpi { const float* res; const bf16_t* resb; const float* rgain; float* hout; bf16_t* hg; const float* gain; float* ssq; bf16_t* O; const float* ssq_in; float scale; };
template <int MODE, bool HG, bool RESBF = false, bool OUTF = true> __device__ __forceinline__ void small_gemm(const bf16_t* __restrict__ A, const bf16_t* __restrict__ Bt, int K, int row_base, const SmallEpi& E, unsigned char* ldsb) {
    const int tid = tid_opq(), lane = tid & 63, wid = tid >> 6, fr = lane & 15, fq = lane >> 4;
    constexpr int LDP = 68;
    float* part = (float*)ldsb;
    const int kslice = K >> 3, npair = kslice >> 6;
    for (int tile = blockIdx.x; tile < 256; tile += gridDim.x) {
        const int tm = tile >> 5, tn = tile & 31;
        const bf16_t* ap = A + (size_t)(tm * 64 + fr) * K + wid * kslice + fq * 16; const bf16_t* bp = Bt + (size_t)(tn * 64 + fr) * K + wid * kslice + fq * 16;
        f32x4 acc[4][4];
#pragma unroll
        for (int mi = 0; mi < 4; ++mi)
#pragma unroll
            for (int ni = 0; ni < 4; ++ni) acc[mi][ni] = (f32x4){0.f, 0.f, 0.f, 0.f};
        bf16x8 af[4][2], bf[4][2];
#pragma unroll
        for (int i = 0; i < 4; ++i) { af[i][0] = *(const bf16x8*)(ap + (size_t)(i * 16) * K); af[i][1] = *(const bf16x8*)(ap + (size_t)(i * 16) * K + 8);
            bf[i][0] = *(const bf16x8*)(bp + (size_t)(i * 16) * K); bf[i][1] = *(const bf16x8*)(bp + (size_t)(i * 16) * K + 8); }
        for (int p = 0; p < npair; ++p) {
            bf16x8 an[4][2], bn[4][2];
            const int pn = (p + 1 < npair) ? p + 1 : p;
#pragma unroll
            for (int i = 0; i < 4; ++i) { an[i][0] = *(const bf16x8*)(ap + (size_t)(i * 16) * K + pn * 64); an[i][1] = *(const bf16x8*)(ap + (size_t)(i * 16) * K + pn * 64 + 8);
                bn[i][0] = *(const bf16x8*)(bp + (size_t)(i * 16) * K + pn * 64); bn[i][1] = *(const bf16x8*)(bp + (size_t)(i * 16) * K + pn * 64 + 8); }
#pragma unroll
            for (int hh = 0; hh < 2; ++hh)
#pragma unroll
                for (int mi = 0; mi < 4; ++mi)
#pragma unroll
                    for (int ni = 0; ni < 4; ++ni) acc[mi][ni] = __builtin_amdgcn_mfma_f32_16x16x32_bf16(bf[ni][hh], af[mi][hh], acc[mi][ni], 0, 0, 0);
#pragma unroll
            for (int i = 0; i < 4; ++i) { af[i][0] = an[i][0]; af[i][1] = an[i][1]; bf[i][0] = bn[i][0]; bf[i][1] = bn[i][1]; }
        }
#pragma unroll
        for (int mi = 0; mi < 4; ++mi)
#pragma unroll
            for (int ni = 0; ni < 4; ++ni) *(f32x4*)(part + (size_t)wid * 64 * LDP + (mi * 16 + fr) * LDP + ni * 16 + 4 * fq) = acc[mi][ni];
        __syncthreads();
        const int rloc = tid >> 3, cc = (tid & 7) * 8, rl = tm * 64 + rloc, r = row_base + rl, c0 = tn * 64 + cc;
        f32x4 v0 = *(const f32x4*)(part + rloc * LDP + cc), v1 = *(const f32x4*)(part + rloc * LDP + cc + 4);
#pragma unroll
        for (int w = 1; w < 8; ++w) { v0 += *(const f32x4*)(part + (size_t)w * 64 * LDP + rloc * LDP + cc); v1 += *(const f32x4*)(part + (size_t)w * 64 * LDP + rloc * LDP + cc + 4); }
        if (MODE == 0) {
            f32x4 h0, h1;
            if (RESBF) { const u32x4 w = *(const u32x4*)(E.resb + (size_t)r * 2048 + c0); f32x4 q0 = *(const f32x4*)(E.rgain + c0), q1 = *(const f32x4*)(E.rgain + c0 + 4);
#pragma unroll
                for (int j = 0; j < 4; ++j) { q0[j] = __builtin_amdgcn_rcpf(q0[j]); q1[j] = __builtin_amdgcn_rcpf(q1[j]); }
                h0 = (f32x4){__uint_as_float(w.x << 16), __uint_as_float(w.x & 0xffff0000u), __uint_as_float(w.y << 16), __uint_as_float(w.y & 0xffff0000u)} * q0 + v0;
                h1 = (f32x4){__uint_as_float(w.z << 16), __uint_as_float(w.z & 0xffff0000u), __uint_as_float(w.w << 16), __uint_as_float(w.w & 0xffff0000u)} * q1 + v1; }
            else { const float* rp = E.res + (size_t)rl * 2048 + c0; h0 = *(const f32x4*)rp + v0; h1 = *(const f32x4*)(rp + 4) + v1; }
            if (OUTF) { float* hp = E.hout + (size_t)r * 2048 + c0; *(f32x4*)hp = h0; *(f32x4*)(hp + 4) = h1; }
            float ss = (h0[0] * h0[0] + h0[1] * h0[1]) + (h0[2] * h0[2] + h0[3] * h0[3]) + (h1[0] * h1[0] + h1[1] * h1[1]) + (h1[2] * h1[2] + h1[3] * h1[3]);
            if (HG) { const f32x4 g0 = *(const f32x4*)(E.gain + c0), g1 = *(const f32x4*)(E.gain + c0 + 4); *(u32x4*)(E.hg + (size_t)r * 2048 + c0) = pg8::pack8(h0 * g0, h1 * g1); }
            ss += dpp_f<0xB1>(ss); ss += dpp_f<0x4E>(ss); ss += dpp_f<0x141>(ss);
            if ((tid & 7) == 0) E.ssq[(size_t)r * 32 + tn] = ss;
        } else {
            const f32x4 pq = *(const f32x4*)(E.ssq_in + (size_t)r * 32 + (tid & 7) * 4); float sm = (pq[0] + pq[1]) + (pq[2] + pq[3]);
            sm += dpp_f<0xB1>(sm); sm += dpp_f<0x4E>(sm); sm += dpp_f<0x141>(sm);
            const float rs = rsqrtf(sm * (1.0f / 2048.0f) + 1e-6f) * E.scale;
            *(u32x4*)(E.O + (size_t)r * 2048 + c0) = pg8::pack8(v0 * rs, v1 * rs);
        }
        __syncthreads();
    }
}


template <class Epi> __device__ __forceinline__ void run_gemm(PG8_LAS unsigned char* lds, const bf16_t* A, const bf16_t* Bt, int M, int N, int K, int cshift, const Epi& E) {
    pg8::Gemm g; g.A = A; g.Bt = Bt; g.M = M; g.N = N; g.K = K;
    pg8::StaticOrder S; S.init(M, N, (int)gridDim.x, (int)((blockIdx.x + gridDim.x - (cshift % gridDim.x)) % gridDim.x));
    pg8::gemm_phase<Epi, pg8::StaticOrder, false>(lds, g, S, E, nullptr);
}

#ifndef REP_SYNC
#define REP_SYNC 0
#endif
#ifndef REP_P0
#define REP_P0 0
#endif
#ifndef REP_P4
#define REP_P4 0
#endif
#ifndef REP_P9
#define REP_P9 0
#endif
#ifndef REP_P1
#define REP_P1 0
#endif
#ifndef REP_P3
#define REP_P3 0
#endif
#ifndef REP_SM
#define REP_SM 0
#endif
#ifndef REP_GA
#define REP_GA 0
#endif
#ifndef REP_GS
#define REP_GS 0
#endif
#ifndef REP_GB
#define REP_GB 0
#endif
#ifndef REP_GC
#define REP_GC 0
#endif
#ifndef REP_P1B
#define REP_P1B 0
#endif
#ifndef REP_P5
#define REP_P5 0
#endif
#ifndef REP_P7
#define REP_P7 0
#endif
#define GSYNC() do { xcd_barrier(xbar); if (REP_SYNC) xcd_barrier(xbar); } while (0)
__global__ void __launch_bounds__(512, 2) mk_fwd(Args a) {
    extern __shared__ __attribute__((aligned(16))) unsigned char shm[];
    cg::grid_group grid = cg::this_grid();
    PG8_LAS unsigned char* lds = (PG8_LAS unsigned char*)shm;
    float* ldsf = (float*)shm;
    unsigned char* ws = a.ws;
    volatile LAS unsigned* xst = (volatile LAS unsigned*)(lds + LDS_BYTES - 16);
    if (threadIdx.x < 4) xst[threadIdx.x] = 0u;
    __syncthreads();
    XcdBarrier xbar = xcd_barrier_post((unsigned*)(ws + WS_BAR), xst);
    for (int rep = 0; rep <= REP_P0; ++rep) { phase_prep(a, ldsf); if (REP_P0) __syncthreads(); }
    if (a.ws == nullptr) grid.sync();
    GSYNC();
    for (int rep1 = 0; rep1 <= REP_P1; ++rep1)
    { pg8::EpiProj E; E.O = (bf16_t*)(ws + WS_PROJ); E.ldc = NINP;
      run_gemm(lds, (const bf16_t*)(ws + WS_XN), (const bf16_t*)(ws + WS_WT_IN), MROWS, NINP, D, 0, E); }
    { pg8::EpiKV E; E.outk = a.out + O_MK; E.outv = a.out + O_MV; E.mkb = (bf16_t*)(ws + WS_MKB); E.mvt = (bf16_t*)(ws + WS_MVT);
      run_gemm(lds, (const bf16_t*)(ws + WS_MEMN), (const bf16_t*)(ws + WS_WT_XKV), 1024, 4096, D, (MROWS / 256) * (NINP / 256), E); }
    __syncthreads();
    phase_transposes(a, ldsf, TT_EARLY, TT_TOTAL, (unsigned*)(ws + WS_BAR) + XCD_BAR_WORDS + 1, (volatile int*)(ldsf + 64 * 260 + 8));
    GSYNC();
    for (int rep = 0; rep <= REP_P1B; ++rep) phase_rows_pre(a);
    GSYNC();
    for (int rep = 0; rep <= REP_GA; ++rep)
    for (int it = blockIdx.x; it < 512; it += gridDim.x) gla_pass_a(a, it, shm);
    for (int rep = 0; rep <= REP_GS; ++rep)
    for (int it = blockIdx.x; it < 512; it += gridDim.x) gla_sample_item(a, it, ldsf);
    GSYNC();
    for (int rep = 0; rep <= REP_GB; ++rep) { gla_pass_b(a); if (REP_GB) __syncthreads(); }
    GSYNC();
    for (int rep = 0; rep <= REP_GC; ++rep)
    for (int it = blockIdx.x; it < 512; it += gridDim.x) gla_pass_c(a, it, shm);
    GSYNC();
    for (int rep3 = 0; rep3 <= REP_P3; ++rep3)
    { pg8::EpiRes<false, true, false> E{}; E.res0 = a.in[I_XP]; E.res1 = a.in[I_XS]; E.split = MP; E.hg = (bf16_t*)(ws + WS_HG); E.gain = a.in[I_NX]; E.ssq = (float*)(ws + WS_SSQ1);
      run_gemm(lds, (const bf16_t*)(ws + WS_MIXIN), (const bf16_t*)(ws + WS_WT_OUT), MP, D, D, 0, E);
      SmallEpi SE{}; SE.res = a.in[I_XS]; SE.hg = E.hg; SE.gain = E.gain; SE.ssq = E.ssq;
      small_gemm<0, true, false, false>((const bf16_t*)(ws + WS_MIXIN) + (size_t)MP * D, (const bf16_t*)(ws + WS_WT_OUT), D, MP, SE, shm); }
    GSYNC();
    for (int rep4 = 0; rep4 <= REP_P4; ++rep4)
    { pg8::EpiScale<false> E; E.O = (bf16_t*)(ws + WS_XN); E.ldc = D; E.ssq = (const float*)(ws + WS_SSQ1); E.scale = 0.044194173824159216f; E.ffn_p = nullptr; E.ffn_s = nullptr;
      run_gemm(lds, (const bf16_t*)(ws + WS_HG), (const bf16_t*)(ws + WS_WT_XQ), MP, D, D, 0, E);
      SmallEpi SE{}; SE.O = E.O; SE.ssq_in = E.ssq; SE.scale = E.scale;
      for (int rep = 0; rep <= REP_SM; ++rep) small_gemm<1, false>((const bf16_t*)(ws + WS_HG) + (size_t)MP * D, (const bf16_t*)(ws + WS_WT_XQ), D, MP, SE, shm); }
    GSYNC();
    for (int rep = 0; rep <= REP_P5; ++rep) {
    for (int it = blockIdx.x; it < 256; it += gridDim.x) { const int x = it & 7, j = it >> 3; xattn_prompt_item(a, (gridDim.x == 256) ? ((x * 2 + (j >> 4)) * 16 + (j & 15)) : it, shm); }
    for (int it = blockIdx.x; it < 512; it += gridDim.x) xattn_sample_item(a, it, ldsf); }
    GSYNC();
    { pg8::EpiRes<true, true, false> E{}; E.resb = (const bf16_t*)(ws + WS_HG); E.rgain = a.in[I_NX]; E.hg = (bf16_t*)(ws + WS_HG); E.gain = a.in[I_NF]; E.ssq = (float*)(ws + WS_SSQ2);
      run_gemm(lds, (const bf16_t*)(ws + WS_MIXIN), (const bf16_t*)(ws + WS_WT_XO), MP, D, D, 0, E);
      SmallEpi SE{}; SE.resb = E.resb; SE.rgain = E.rgain; SE.hg = E.hg; SE.gain = E.gain; SE.ssq = E.ssq;
      small_gemm<0, true, true, false>((const bf16_t*)(ws + WS_MIXIN) + (size_t)MP * D, (const bf16_t*)(ws + WS_WT_XO), D, MP, SE, shm); }
    GSYNC();
    for (int rep = 0; rep <= REP_P7; ++rep)
    { pg8::EpiFfn E; E.act = (bf16_t*)(ws + WS_PROJ); E.GU = (bf16_t*)(ws + WS_GU); E.ssq = (const float*)(ws + WS_SSQ2); E.cw = a.in[I_FCW]; E.cb = a.in[I_FCB]; E.ffn_p = a.out + O_FFN_P; E.ffn_s = a.out + O_FFN_S;
      run_gemm(lds, (const bf16_t*)(ws + WS_HG), (const bf16_t*)(ws + WS_WT_FGU), MROWS, 2 * DFF, D, 0, E); }
    GSYNC();
    phase_act(a);
    GSYNC();
    for (int rep9 = 0; rep9 <= REP_P9; ++rep9)
    { pg8::EpiRes<true, false, true> E{}; E.resb = (const bf16_t*)(ws + WS_HG); E.rgain = a.in[I_NF]; E.hout = a.out + O_Y; E.ssq = (float*)(ws + WS_SSQ3);
      run_gemm(lds, (const bf16_t*)(ws + WS_PROJ), (const bf16_t*)(ws + WS_WT_FD), MP, D, DFF, 0, E);
      SmallEpi SE{}; SE.resb = E.resb; SE.rgain = E.rgain; SE.hout = E.hout; SE.ssq = E.ssq;
      small_gemm<0, false, true, true>((const bf16_t*)(ws + WS_PROJ) + (size_t)MP * DFF, (const bf16_t*)(ws + WS_WT_FD), DFF, MP, SE, shm); }
    GSYNC();
    phase_final(a);
}

extern "C" void kernel_launch(void* const* d_in, const int* in_sizes, int n_in, void* d_out, int out_size, void* d_ws, size_t ws_size, hipStream_t stream) {
    static int grid = 0;
    if (grid == 0) {
        if (n_in != 28 || ws_size < WS_END) { fprintf(stderr, "kernel_launch: unexpected n_in %d or ws_size %zu (< %zu)\n", n_in, ws_size, (size_t)WS_END); grid = -1; return; }
        int dev = 0, cus = 0, per_cu = 0;
        (void)hipGetDevice(&dev); (void)hipDeviceGetAttribute(&cus, hipDeviceAttributeMultiprocessorCount, dev);
        (void)hipFuncSetAttribute((const void*)mk_fwd, hipFuncAttributeMaxDynamicSharedMemorySize, LDS_BYTES);
        (void)hipOccupancyMaxActiveBlocksPerMultiprocessor(&per_cu, (const void*)mk_fwd, 512, LDS_BYTES);
        if (per_cu < 1) { fprintf(stderr, "kernel_launch: occupancy query says %d blocks/CU\n", per_cu); grid = -1; return; }
        grid = cus;
    }
    if (grid < 0) return;
    Args a{};
    for (int i = 0; i < 28; ++i) a.in[i] = (const float*)d_in[i];
    a.out = (float*)d_out; a.ws = (unsigned char*)d_ws;
    if (hipMemsetAsync((unsigned char*)d_ws + WS_BAR, 0, (size_t)(XCD_BAR_WORDS + 64) * 4, stream) != hipSuccess) { fprintf(stderr, "kernel_launch: memset of barrier words failed\n"); return; }
    void* args[] = {&a};
    hipError_t e = hipLaunchCooperativeKernel((const void*)mk_fwd, dim3(grid), dim3(512), args, LDS_BYTES, stream);
    if (e != hipSuccess) fprintf(stderr, "cooperative launch failed: %s (grid %d)\n", hipGetErrorString(e), grid);
}
```
